# Optimizing an MI355X kernel written in HIP

```python
import jax, jax.numpy as jnp
from jax import lax
import numpy as np

D_MODEL = 1024
BATCH = 8
SEQ = 2048
DEPTH = 4

GRID_W = 64
CTX_LEN = 256
EPS = 1e-6
N_Q_HEADS = 8
N_KV_HEADS = 2
HEAD_DIM = 64
WINDOW = 128
BLOCK = 128
ROPE_BASE = 10000.0
SCONV_DIM = 512
SCONV_WIDTH = 3
POOL_DIM = 512
N_POOL_GROUPS = 4
POOL_GROUP = POOL_DIM // N_POOL_GROUPS
POOL_WINDOWS = (2, 4, 8, 16)
FFT_DIM = 512
N_FFT_GROUPS = 4
FFT_GROUP = FFT_DIM // N_FFT_GROUPS
D_FF = 2816
FFN_CONV_WIDTH = 3

Q_DIM = N_Q_HEADS * HEAD_DIM
KV_DIM = N_KV_HEADS * HEAD_DIM
ATT_IN = Q_DIM + 2 * KV_DIM + 3 * SCONV_DIM
EVEN_SPLITS = (Q_DIM, Q_DIM + KV_DIM, Q_DIM + 2 * KV_DIM, Q_DIM + 2 * KV_DIM + SCONV_DIM, Q_DIM + 2 * KV_DIM + 2 * SCONV_DIM)
MIX_OUT_EVEN = Q_DIM + SCONV_DIM
MIX_IN_ODD = POOL_DIM + FFT_DIM
N_EVEN = (DEPTH + 1) // 2
N_ODD = DEPTH // 2

kernel_name = 'hybrid_swa_sconv_pool_fourier_dit'


def rmsnorm(x, g):
    xf = x.astype(jnp.float32)
    y = xf * lax.rsqrt(jnp.mean(xf * xf, axis=-1, keepdims=True) + EPS)
    return (y * g.astype(jnp.float32)).astype(x.dtype)


def dwconv_centred(u, w):
    k = w.shape[0]
    half = k // 2
    t = u.shape[1]
    up = jnp.pad(u, ((0, 0), (half, k - 1 - half), (0, 0)))
    return sum(up[:, j:j + t] * w[j] for j in range(k))


def _rotate(x, ang):
    f = ang.shape[-1]
    cos = jnp.cos(ang)[:, None, :].astype(x.dtype)
    sin = jnp.sin(ang)[:, None, :].astype(x.dtype)
    x1, x2 = x[..., :f], x[..., f:]
    return jnp.concatenate([x1 * cos - x2 * sin, x2 * cos + x1 * sin], axis=-1)


def rope_2d(x, row, col):
    half = HEAD_DIM // 2
    nf = half // 2
    inv = ROPE_BASE ** (-jnp.arange(nf, dtype=jnp.float32) / nf)
    ang_r = row.astype(jnp.float32)[:, None] * inv
    ang_c = col.astype(jnp.float32)[:, None] * inv
    return jnp.concatenate([_rotate(x[..., :half], ang_r), _rotate(x[..., half:], ang_c)], axis=-1)


def sink_softmax(logits, sink_b):
    m = jnp.maximum(jnp.max(logits, axis=-1, keepdims=True), sink_b)
    e = jnp.exp(logits - m)
    return e / (jnp.sum(e, axis=-1, keepdims=True) + jnp.exp(sink_b - m))


def window_attention(q, k, v, kc, vc, sink):
    b, s = q.shape[:2]
    nb = s // BLOCK
    g = N_Q_HEADS // N_KV_HEADS
    scale = HEAD_DIM ** -0.5
    qb = q.reshape(b, nb, BLOCK, N_KV_HEADS, g, HEAD_DIM)

    def band(t):
        tp = jnp.pad(t, ((0, 0), (BLOCK, BLOCK), (0, 0), (0, 0))).reshape(b, nb + 2, BLOCK, N_KV_HEADS, HEAD_DIM)
        return jnp.concatenate([tp[:, :-2], tp[:, 1:-1], tp[:, 2:]], axis=2)

    kb, vb = band(k), band(v)
    s_win = jnp.einsum('bnqhgd,bnkhd->bnhgqk', qb, kb).astype(jnp.float32) * scale
    qpos = jnp.arange(nb)[:, None] * BLOCK + jnp.arange(BLOCK)[None, :]
    kpos = jnp.arange(nb)[:, None] * BLOCK - BLOCK + jnp.arange(3 * BLOCK)[None, :]
    valid = (jnp.abs(qpos[:, :, None] - kpos[:, None, :]) <= WINDOW) & (kpos[:, None, :] >= 0) & (kpos[:, None, :] < s)
    s_win = jnp.where(valid[None, :, None, None, :, :], s_win, -jnp.inf)
    s_ctx = jnp.einsum('bnqhgd,blhd->bnhgql', qb, kc).astype(jnp.float32) * scale
    sink_b = sink.astype(jnp.float32).reshape(1, 1, N_KV_HEADS, g, 1, 1)
    p = sink_softmax(jnp.concatenate([s_win, s_ctx], axis=-1), sink_b).astype(v.dtype)
    o = (jnp.einsum('bnhgqk,bnkhd->bnqhgd', p[..., :3 * BLOCK], vb)
         + jnp.einsum('bnhgql,blhd->bnqhgd', p[..., 3 * BLOCK:], vc))
    return o.reshape(b, s, Q_DIM)


def context_attention(q, k, v, sink):
    b, l = q.shape[:2]
    g = N_Q_HEADS // N_KV_HEADS
    qg = q.reshape(b, l, N_KV_HEADS, g, HEAD_DIM)
    s = jnp.einsum('blhgd,bmhd->bhglm', qg, k).astype(jnp.float32) * (HEAD_DIM ** -0.5)
    sink_b = sink.astype(jnp.float32).reshape(1, N_KV_HEADS, g, 1, 1)
    p = sink_softmax(s, sink_b).astype(v.dtype)
    o = jnp.einsum('bhglm,bmhd->blhgd', p, v)
    return o.reshape(b, l, Q_DIM)


def even_mixer(hx, hc, w_in, sink, conv_w, w_out, row, col, ctx_out):
    b, s = hx.shape[:2]
    l = hc.shape[1]
    qx, kx, vx, bx, cx, zx = jnp.split(hx @ w_in, EVEN_SPLITS, axis=-1)
    qx = rope_2d(qx.reshape(b, s, N_Q_HEADS, HEAD_DIM), row, col)
    kx = rope_2d(kx.reshape(b, s, N_KV_HEADS, HEAD_DIM), row, col)
    vx = vx.reshape(b, s, N_KV_HEADS, HEAD_DIM)
    if ctx_out:
        qc, kc, vc, bc, cc, zc = jnp.split(hc @ w_in, EVEN_SPLITS, axis=-1)
    else:
        kc, vc = jnp.split(hc @ w_in[:, Q_DIM:Q_DIM + 2 * KV_DIM], 2, axis=-1)
    kc = kc.reshape(b, l, N_KV_HEADS, HEAD_DIM)
    vc = vc.reshape(b, l, N_KV_HEADS, HEAD_DIM)
    ax = window_attention(qx, kx, vx, kc, vc, sink)
    sx = bx * dwconv_centred(cx * zx, conv_w)
    yx = jnp.concatenate([ax, sx], axis=-1) @ w_out
    if not ctx_out:
        return yx, None
    ac = context_attention(qc.reshape(b, l, N_Q_HEADS, HEAD_DIM), kc, vc, sink)
    s_c = bc * dwconv_centred(cc * zc, conv_w)
    yc = jnp.concatenate([ac, s_c], axis=-1) @ w_out
    return yx, yc


def pool_mix(u, w_grp, scale):
    b, t = u.shape[:2]
    uf = u.astype(jnp.float32)
    cs = jnp.pad(jnp.cumsum(uf, axis=1), ((0, 0), (1, 0), (0, 0)))
    pos = jnp.arange(t)
    outs = []
    for gi, w in enumerate(POOL_WINDOWS):
        lo = jnp.clip(pos - w // 2, 0, t)
        hi = jnp.clip(pos + w - w // 2, 0, t)
        sl = slice(gi * POOL_GROUP, (gi + 1) * POOL_GROUP)
        seg = cs[:, :, sl]
        mean = (seg[:, hi] - seg[:, lo]) / (hi - lo).astype(jnp.float32)[:, None]
        outs.append(mean - uf[:, :, sl])
    p = jnp.stack(outs, axis=2).astype(u.dtype)
    y = jnp.einsum('btgc,gcd->btgd', p, w_grp).reshape(b, t, POOL_DIM)
    return y * scale


def fourier_mix(u):
    b, t = u.shape[:2]
    ug = u.astype(jnp.float32).reshape(b, t, N_FFT_GROUPS, FFT_GROUP)
    f = jnp.fft.fftn(ug, axes=(1, 3), norm='ortho').real
    return f.reshape(b, t, FFT_DIM).astype(u.dtype)


def odd_mixer(h, w_in, w_grp, scale, w_out):
    u = h @ w_in
    y = jnp.concatenate([pool_mix(u[..., :POOL_DIM], w_grp, scale), fourier_mix(u[..., POOL_DIM:])], axis=-1)
    return y @ w_out


def conv_ffn(h, w_up, conv_w, w_down):
    gate, val = jnp.split(h @ w_up, 2, axis=-1)
    return (jax.nn.silu(dwconv_centred(gate, conv_w)) * val) @ w_down


def setup_inputs(seed: int = 0) -> dict:
    key = jax.random.key(seed)
    ks = jax.random.split(key, 18)

    def nrm(k, shape, s):
        return jax.random.normal(k, shape, jnp.float32) * s

    return {
        'x': nrm(ks[0], (BATCH, SEQ, D_MODEL), 1.0),
        'c': nrm(ks[1], (BATCH, D_MODEL), 1.0),
        'ctx': nrm(ks[2], (BATCH, CTX_LEN, D_MODEL), 1.0),
        'c_ctx': nrm(ks[3], (D_MODEL,), 1.0),
        'mod_w': nrm(ks[4], (DEPTH, D_MODEL, 6 * D_MODEL), 0.5 * D_MODEL ** -0.5),
        'mod_b': nrm(ks[5], (DEPTH, 6 * D_MODEL), 0.01),
        'norm_g': 1.0 + nrm(ks[6], (DEPTH, 4, D_MODEL), 0.05),
        'att_w_in': nrm(ks[7], (N_EVEN, D_MODEL, ATT_IN), D_MODEL ** -0.5),
        'att_sink': nrm(ks[8], (N_EVEN, N_Q_HEADS), 0.5),
        'sconv_w': nrm(ks[9], (N_EVEN, SCONV_WIDTH, SCONV_DIM), SCONV_WIDTH ** -0.5),
        'att_w_out': nrm(ks[10], (N_EVEN, MIX_OUT_EVEN, D_MODEL), MIX_OUT_EVEN ** -0.5),
        'mix_w_in': nrm(ks[11], (N_ODD, D_MODEL, MIX_IN_ODD), D_MODEL ** -0.5),
        'pool_w_grp': nrm(ks[12], (N_ODD, N_POOL_GROUPS, POOL_GROUP, POOL_GROUP), POOL_GROUP ** -0.5),
        'pool_scale': 1.0 + nrm(ks[13], (N_ODD, POOL_DIM), 0.1),
        'mix_w_out': nrm(ks[14], (N_ODD, MIX_IN_ODD, D_MODEL), MIX_IN_ODD ** -0.5),
        'ffn_w_up': nrm(ks[15], (DEPTH, D_MODEL, 2 * D_FF), D_MODEL ** -0.5),
        'ffn_conv': nrm(ks[16], (DEPTH, FFN_CONV_WIDTH, D_FF), FFN_CONV_WIDTH ** -0.5),
        'ffn_w_down': nrm(ks[17], (DEPTH, D_FF, D_MODEL), D_FF ** -0.5),
    }


def reference(x, c, ctx, c_ctx, mod_w, mod_b, norm_g, att_w_in, att_sink, sconv_w, att_w_out,
              mix_w_in, pool_w_grp, pool_scale, mix_w_out, ffn_w_up, ffn_conv, ffn_w_down):
    s = x.shape[1]
    rows = s // GRID_W
    row = jnp.repeat(jnp.arange(rows), GRID_W)
    col = jnp.tile(jnp.arange(GRID_W), rows)
    silu_c = jax.nn.silu(c)
    silu_cc = jax.nn.silu(c_ctx)
    hctx = ctx
    for i in range(DEPTH):
        even = i % 2 == 0
        ctx_live = any(j % 2 == 0 for j in range(i + 1, DEPTH))
        gains = norm_g[i]
        mod_x = (silu_c @ mod_w[i] + mod_b[i])[:, None, :]
        sh1, sc1, g1, sh2, sc2, g2 = jnp.split(mod_x, 6, axis=-1)
        hx = rmsnorm(x, gains[0]) * (1.0 + sc1) + sh1
        if even or ctx_live:
            mod_c = silu_cc @ mod_w[i] + mod_b[i]
            csh1, csc1, cg1, csh2, csc2, cg2 = jnp.split(mod_c, 6, axis=-1)
            hc = rmsnorm(hctx, gains[0]) * (1.0 + csc1) + csh1
        if even:
            e = i // 2
            yx, yc = even_mixer(hx, hc, att_w_in[e], att_sink[e], sconv_w[e], att_w_out[e], row, col, ctx_live)
        else:
            o = i // 2
            yx = odd_mixer(hx, mix_w_in[o], pool_w_grp[o], pool_scale[o], mix_w_out[o])
            yc = odd_mixer(hc, mix_w_in[o], pool_w_grp[o], pool_scale[o], mix_w_out[o]) if ctx_live else None
        x = x + g1 * rmsnorm(yx, gains[1])
        hx2 = rmsnorm(x, gains[2]) * (1.0 + sc2) + sh2
        x = x + g2 * rmsnorm(conv_ffn(hx2, ffn_w_up[i], ffn_conv[i], ffn_w_down[i]), gains[3])
        if ctx_live:
            hctx = hctx + cg1 * rmsnorm(yc, gains[1])
            hc2 = rmsnorm(hctx, gains[2]) * (1.0 + csc2) + csh2
            hctx = hctx + cg2 * rmsnorm(conv_ffn(hc2, ffn_w_up[i], ffn_conv[i], ffn_w_down[i]), gains[3])
    return x
```

```cpp
#include <hip/hip_runtime.h>
#include <cstdio>
#include <cstdint>

#ifndef MK_PER_PHASE
#define MK_PER_PHASE 0
#endif

#ifndef PROBE_CLASS
#define PROBE_CLASS 0
#endif
#define PROBE_REPS 3
#define GAS __attribute__((address_space(1)))
#define LAS __attribute__((address_space(3)))
typedef unsigned short bf16_t;
typedef short bf16x8 __attribute__((ext_vector_type(8)));
typedef float f32x4 __attribute__((ext_vector_type(4)));
typedef float f32x16 __attribute__((ext_vector_type(16)));
typedef unsigned u32x4 __attribute__((ext_vector_type(4)));
typedef unsigned u32x2 __attribute__((ext_vector_type(2)));
typedef GAS unsigned gu32;
#define RLX_AGENT __ATOMIC_RELAXED, __HIP_MEMORY_SCOPE_AGENT
#define LDS_WAIT() asm volatile("s_waitcnt lgkmcnt(0)" ::: "memory")
#define VM_WAIT() asm volatile("s_waitcnt vmcnt(0)" ::: "memory")

constexpr int DM = 1024, NBATCH = 8, SEQ = 2048, CTXL = 256, DEPTH = 4;
constexpr int MX = NBATCH * SEQ, MC = NBATCH * CTXL, MT = MX + MC;
constexpr int ATT_IN = 2304, DFF = 2816, NUP = 2 * DFF, KMO = 1536;
constexpr float EPS = 1e-6f;
constexpr float QSCALE = 0.125f * 1.4426950408889634f;
constexpr float LOG2E = 1.4426950408889634f;
constexpr int NWAVES = 8, NTHR = 512;

constexpr size_t MiB = 1u << 20;
constexpr size_t WS_CTL = 0, CTL_ZERO_BYTES = 1 * MiB;
constexpr size_t WS_MODX = 1 * MiB, WS_MODC = WS_MODX + (size_t)4 * 8 * 6144 * 4;
constexpr size_t WS_TAB = 2 * MiB;
constexpr size_t WS_WIN = 4 * MiB, SZ_WIN = (size_t)ATT_IN * DM * 2;
constexpr size_t WS_WOUT = 13 * MiB, SZ_WOUT = (size_t)DM * DM * 2;
constexpr size_t WS_WMI = 17 * MiB, SZ_WMI = (size_t)1536 * DM * 2;
constexpr size_t WS_WMO = 23 * MiB, SZ_WMO = (size_t)DM * KMO * 2;
constexpr size_t WS_WUP = 29 * MiB, SZ_WUP = (size_t)NUP * DM * 2;
constexpr size_t WS_WDN = 73 * MiB, SZ_WDN = (size_t)DM * DFF * 2;
constexpr size_t WS_FMAT = 96 * MiB;
constexpr size_t WS_FC = 112 * MiB;
constexpr size_t WS_HCTX = 113 * MiB;
constexpr size_t WS_HX = 122 * MiB;
constexpr size_t WS_Y = 158 * MiB;
constexpr size_t WS_BIG = 194 * MiB;
constexpr size_t WS_UPOOL = WS_BIG, WS_VT = WS_BIG + 20 * MiB, WS_VTC = WS_BIG + 52 * MiB;
constexpr size_t WS_MIX = 293 * MiB;
constexpr size_t WS_SIDE = 348 * MiB;
constexpr size_t WS_END = 368 * MiB;
constexpr int CW_BAR = 4096;
constexpr int SL_OUT = 4, SL_DN = 6;

constexpr int RING_BYTES = 131072, LDSCTL_OFF = RING_BYTES, MISC_OFF = LDSCTL_OFF + 320, LDS_BYTES = 147456;
constexpr int LDS_COSTAB = 122880;

__device__ __forceinline__ unsigned cvt_pk_bf16(float lo, float hi) { unsigned r; asm("v_cvt_pk_bf16_f32 %0, %1, %2" : "=v"(r) : "v"(lo), "v"(hi)); return r; }
__device__ __forceinline__ float bf_lo(unsigned w) { return __uint_as_float(w << 16); }
__device__ __forceinline__ float bf_hi(unsigned w) { return __uint_as_float(w & 0xffff0000u); }
__device__ __forceinline__ float wave_sum(float v) {
#pragma unroll
    for (int o = 1; o < 64; o <<= 1) v += __shfl_xor(v, o);
    return v;
}
__device__ __forceinline__ float silu_f(float x) { return x * __builtin_amdgcn_rcpf(1.0f + __builtin_amdgcn_exp2f(-x * LOG2E)); }

#define XB_TMO      128
#define XB_XCNT(j)  (256  + 64 * (j))
#define XB_XSUB(j)  (1280 + 64 * (j))
#define XB_XGEN(j)  (2304 + 64 * (j))
#define XB_TOP      3328
#define XB_TOPGEN   3392
#define XCD_BAR_WORDS 3456
#define XB_SPIN_CAP (1u << 18)
__device__ __forceinline__ unsigned xb_ld(unsigned* p)              { return __hip_atomic_load(p, __ATOMIC_RELAXED, __HIP_MEMORY_SCOPE_AGENT); }
__device__ __forceinline__ unsigned xb_add(unsigned* p, unsigned v) { return __hip_atomic_fetch_add(p, v, __ATOMIC_RELAXED, __HIP_MEMORY_SCOPE_AGENT); }
__device__ __forceinline__ unsigned xb_xcc_id() { return (unsigned)__builtin_amdgcn_s_getreg((3 << 11) | 20) & 0xFu; }
#define XB_SPIN(cond, bar) do { unsigned _sp = 0; while (cond) { __builtin_amdgcn_s_sleep(1); \
    if ((++_sp & 255u) == 0u) { if (xb_ld(&(bar)[XB_TMO])) break; if (_sp > XB_SPIN_CAP) { atomicAdd(&(bar)[XB_TMO], 1u); break; } } } } while (0)
struct XcdBarrier { unsigned* bar; unsigned x; volatile LAS unsigned* st; };
__device__ __forceinline__ XcdBarrier xcd_barrier_post(unsigned* bar, volatile LAS unsigned* st) {
    XcdBarrier b; b.bar = bar; b.x = xb_xcc_id(); b.st = st;
    if (threadIdx.x == 0) (void)xb_add(&bar[XB_XCNT(b.x)], 1u);
    return b;
}
__device__ __forceinline__ void xcd_barrier_complete(unsigned* bar, unsigned x, unsigned& nloc, unsigned& nx) {
    const unsigned G = gridDim.x * gridDim.y * gridDim.z;
    unsigned sum, cnt, mine, sp = 0u;
    for (;;) {
        sum = 0u; cnt = 0u; mine = 0u;
#pragma unroll
        for (unsigned j = 0; j < 16; ++j) { const unsigned c = xb_ld(&bar[XB_XCNT(j)]); sum += c; cnt += (c > 0u) ? 1u : 0u; mine = (j == x) ? c : mine; }
        if (sum == G) break;
        __builtin_amdgcn_s_sleep(1);
        if ((++sp & 255u) == 0u) { if (xb_ld(&bar[XB_TMO])) break; if (sp > XB_SPIN_CAP) { atomicAdd(&bar[XB_TMO], 1u); break; } }
    }
    nloc = mine > 0u ? mine : 1u; nx = cnt > 0u ? cnt : 1u;
}
__device__ __forceinline__ void xcd_barrier(const XcdBarrier& b) {
    asm volatile("s_waitcnt vmcnt(0)" ::: "memory");
    __syncthreads();
    if (threadIdx.x == 0) {
        unsigned* bar = b.bar; asm volatile("" : "+s"(bar));
        __builtin_amdgcn_s_waitcnt(0);
        unsigned nloc = b.st[0], nx = b.st[1];
        if (nloc == 0u) { xcd_barrier_complete(bar, b.x, nloc, nx); b.st[0] = nloc; b.st[1] = nx; }
        const unsigned old = xb_add(&bar[XB_XSUB(b.x)], 1u);
        const unsigned gen = old / nloc;
        if (old + 1u == (gen + 1u) * nloc) {
            __builtin_amdgcn_fence(__ATOMIC_RELEASE, "agent");
            asm volatile("s_waitcnt vmcnt(0)" ::: "memory");
            const unsigned og = xb_add(&bar[XB_TOP], 1u);
            const unsigned tg = og / nx;
            if (og + 1u == (tg + 1u) * nx) xb_add(&bar[XB_TOPGEN], 1u);
            else XB_SPIN(xb_ld(&bar[XB_TOPGEN]) == tg, bar);
            __builtin_amdgcn_fence(__ATOMIC_ACQUIRE, "agent");
            xb_add(&bar[XB_XGEN(b.x)], 1u);
            asm volatile("s_waitcnt vmcnt(0)" ::: "memory");
        } else {
            XB_SPIN(xb_ld(&bar[XB_XGEN(b.x)]) == gen, bar);
            __builtin_amdgcn_fence(__ATOMIC_ACQUIRE, "agent");
            asm volatile("s_waitcnt vmcnt(0)" ::: "memory");
        }
    }
    __syncthreads();
}

namespace gm {
constexpr int BM = 256, BK = 64, HALF = 128, HTB = HALF * BK * 2, NXCD = 8, WGM = 8;
__device__ __forceinline__ int lds_byte(int r, int c) { const int st = (r >> 4) * 2 + (c >> 5), rr = r & 15, cc = c & 31, ob = rr * 64 + cc * 2; return st * 1024 + (ob ^ (((ob >> 9) & 1) << 5)); }
__device__ __forceinline__ void stage_rc(int b, int& R, int& C) { const int st = b / 1024, sb = b % 1024, swz = sb ^ (((sb >> 9) & 1) << 5); R = (st >> 1) * 16 + swz / 64; C = (st & 1) * 32 + (swz % 64) / 2; }
__device__ __forceinline__ int perm32(int rho) { const int n = rho >> 4, i = rho & 15; return 8 * (i >> 2) + 4 * n + (i & 3); }

enum { K_PLAIN = 0, K_DFT = 1, K_ROPE = 2, K_VT = 3, K_FFN = 4 };
struct Job { const bf16_t* A; const bf16_t* B; void* out; const float* aux; void* out2; int nM, nN, kind, ldc, row0, col0, p0; int cM, S; float* slab; };
struct Call { int K, lda, ldb, G, c; Job j0; };
struct Unit { int pm, pn, kp0, np, slice; };

__device__ __forceinline__ void next_unit(const Call& C, int i, int& pm, int& pn, int& kp0, int& np, int& slice) {
    const long L = (long)i * C.G + C.c;
    const int nM = C.j0.nM, nN = C.j0.nN, nwg = nM * nN, P = C.K / (2 * BK);
    const int S = C.j0.S, nsl = C.j0.cM * nN * S;
    pm = -1; pn = 0; kp0 = 0; np = P; slice = -1;
    if (L < nwg) {
        int wgid = (int)L; { const int q = nwg / NXCD, r = nwg % NXCD, xcd = wgid % NXCD, off = wgid / NXCD; wgid = (xcd < r ? xcd * (q + 1) : r * (q + 1) + (xcd - r) * q) + off; }
        const int nig = WGM * nN, gid = wgid / nig, fm = gid * WGM, gsz = (nM - fm) < WGM ? (nM - fm) : WGM;
        pm = fm + ((wgid % nig) % gsz); pn = (wgid % nig) / gsz;
    } else if (L < (long)nwg + nsl) {
        const int Ls = (int)(L - nwg);
        const int tile = Ls / S, sl = Ls - tile * S, base = P / S, rem = P - base * S;
        pm = nM + tile / nN; pn = tile % nN; slice = sl; np = base + (sl < rem ? 1 : 0); kp0 = sl * base + (sl < rem ? sl : rem);
    }
}

__device__ __forceinline__ u32x4 pack8(const f32x4& a, const f32x4& b) { u32x4 w; w.x = cvt_pk_bf16(a[0], a[1]); w.y = cvt_pk_bf16(a[2], a[3]); w.z = cvt_pk_bf16(b[0], b[1]); w.w = cvt_pk_bf16(b[2], b[3]); return w; }

__device__ __forceinline__ void epi_plain(const f32x4 (&acc)[2][2][4][2], const Job& J, int rowt, int colb, int wr, int wc, int fr, int fq) {
    bf16_t* O = (bf16_t*)J.out;
#pragma unroll
    for (int ai = 0; ai < 2; ++ai)
#pragma unroll
        for (int m = 0; m < 4; ++m) {
            bf16_t* rowp = O + (size_t)(rowt + ai * HALF + wr * 64 + m * 16 + fr) * J.ldc + colb + wc * 32 + 8 * fq;
#pragma unroll
            for (int bj = 0; bj < 2; ++bj) *(u32x4*)(rowp + bj * HALF) = pack8(acc[ai][bj][m][0], acc[ai][bj][m][1]);
        }
}
__device__ __forceinline__ void epi_rope(const f32x4 (&acc)[2][2][4][2], const Job& J, int rowt, int colb, int wr, int wc, int fr, int fq) {
    bf16_t* O = (bf16_t*)J.out; const float* TC = J.aux; const float* TS = J.aux + 1024;
    const bool anyrope = (rowt < MX) && (colb < 640); const int half = wc & 1, j0 = 8 * (fq & 1); const float sgn = fq < 2 ? -1.f : 1.f;
#pragma unroll
    for (int ai = 0; ai < 2; ++ai)
#pragma unroll
        for (int m = 0; m < 4; ++m) {
            const int grow = rowt + ai * HALF + wr * 64 + m * 16 + fr;
            f32x4 c0 = {1.f, 1.f, 1.f, 1.f}, c1 = c0, s0 = {0.f, 0.f, 0.f, 0.f}, s1 = s0;
            if (anyrope) {
                const int t = grow & (SEQ - 1), pos = half ? (t & 63) : (t >> 6);
                c0 = *(const f32x4*)(TC + pos * 16 + j0); c1 = *(const f32x4*)(TC + pos * 16 + j0 + 4);
                s0 = *(const f32x4*)(TS + pos * 16 + j0); s1 = *(const f32x4*)(TS + pos * 16 + j0 + 4);
            }
#pragma unroll
            for (int bj = 0; bj < 2; ++bj) {
                const int cs = colb + bj * HALF; const bool isq = cs < 512, isk = (cs >= 512) && (cs < 640);
                f32x4 v0 = acc[ai][bj][m][0], v1 = acc[ai][bj][m][1];
                if ((isq || isk) && anyrope) {
                    f32x4 p0, p1;
#pragma unroll
                    for (int e = 0; e < 4; ++e) { p0[e] = __shfl_xor(v0[e], 32); p1[e] = __shfl_xor(v1[e], 32); }
                    v0 = v0 * c0 + (p0 * sgn) * s0; v1 = v1 * c1 + (p1 * sgn) * s1;
                }
                if (isq) { v0 = v0 * QSCALE; v1 = v1 * QSCALE; }
                *(u32x4*)(O + (size_t)grow * J.ldc + cs + wc * 32 + 8 * fq) = pack8(v0, v1);
            }
            asm volatile("" ::: "memory");
        }
}
__device__ __forceinline__ void epi_vt(const f32x4 (&acc)[2][2][4][2], const Job& J, int pm, int pn, int wr, int wc, int fr, int fq) {
    const int s = pm >> 1, c0 = (pm & 1) * 256;
    bf16_t* base; size_t cstride;
    if (pn < MX / 256) { const int b = pn >> 3, t0 = (pn & 7) * 256; base = (bf16_t*)J.out + ((size_t)(b * 512) * 2 + s) * SEQ + t0; cstride = 2 * SEQ; }
    else { const int b = pn - MX / 256; base = (bf16_t*)J.out2 + ((size_t)(b * 512) * 2 + s) * CTXL; cstride = 2 * CTXL; }
#pragma unroll
    for (int ai = 0; ai < 2; ++ai)
#pragma unroll
        for (int m = 0; m < 4; ++m) {
            bf16_t* rowp = base + (size_t)(c0 + ai * HALF + wr * 64 + m * 16 + fr) * cstride + wc * 32 + 8 * fq;
#pragma unroll
            for (int bj = 0; bj < 2; ++bj) *(u32x4*)(rowp + bj * HALF) = pack8(acc[ai][bj][m][0], acc[ai][bj][m][1]);
        }
}
__device__ __forceinline__ void epi_ffn(const f32x4 (&acc)[2][2][4][2], const Job& J, int rowt, int pn, int wr, int wc, int fr, int fq, int lane) {
    bf16_t* O = (bf16_t*)J.out; float* SIDE = (float*)J.out2; const float* cw = J.aux;
    const int col = 128 * pn + 32 * wc + 8 * fq;
    f32x4 w0[2], w1[2], w2[2];
#pragma unroll
    for (int n = 0; n < 2; ++n) { w0[n] = *(const f32x4*)(cw + col + 4 * n); w1[n] = *(const f32x4*)(cw + DFF + col + 4 * n); w2[n] = *(const f32x4*)(cw + 2 * DFF + col + 4 * n); }
    const int srcdn = (lane & 48) | ((fr + 15) & 15), srcup = (lane & 48) | ((fr + 1) & 15);
#pragma unroll
    for (int ai = 0; ai < 2; ++ai) {
        const int blk = (rowt + ai * HALF + wr * 64) >> 6;
        f32x4 cv[4][2];
#pragma unroll
        for (int n = 0; n < 2; ++n)
#pragma unroll
            for (int e = 0; e < 4; ++e) {
                float g[4], dn[4], up[4];
#pragma unroll
                for (int m = 0; m < 4; ++m) { g[m] = acc[ai][0][m][n][e]; dn[m] = __shfl(g[m], srcdn); up[m] = __shfl(g[m], srcup); }
#pragma unroll
                for (int m = 0; m < 4; ++m) {
                    const float pv = fr > 0 ? dn[m] : (m > 0 ? dn[m - 1] : 0.f);
                    const float nx = fr < 15 ? up[m] : (m < 3 ? up[m + 1] : 0.f);
                    cv[m][n][e] = w0[n][e] * pv + w1[n][e] * g[m] + w2[n][e] * nx;
                }
            }
#pragma unroll
        for (int m = 0; m < 4; ++m) {
            const int grow = rowt + ai * HALF + wr * 64 + m * 16 + fr;
            const bool first = (m == 0 && fr == 0), last = (m == 3 && fr == 15);
            if (first || last) {
                float* sp = SIDE + ((size_t)(blk * 2 + (last ? 1 : 0)) * 3) * DFF + col;
#pragma unroll
                for (int n = 0; n < 2; ++n) { *(f32x4*)(sp + 4 * n) = cv[m][n]; *(f32x4*)(sp + DFF + 4 * n) = acc[ai][0][m][n]; *(f32x4*)(sp + 2 * DFF + 4 * n) = acc[ai][1][m][n]; }
            } else {
                f32x4 a0, a1;
#pragma unroll
                for (int e = 0; e < 4; ++e) { a0[e] = silu_f(cv[m][0][e]) * acc[ai][1][m][0][e]; a1[e] = silu_f(cv[m][1][e]) * acc[ai][1][m][1][e]; }
                *(u32x4*)(O + (size_t)grow * DFF + col) = pack8(a0, a1);
            }
        }
    }
}
__device__ __forceinline__ void epi_slab(const f32x4 (&acc)[2][2][4][2], const Job& J, const Unit& u, int wr, int wc, int fr, int fq) {
    const int ld = J.nN * BM;
    float* O = J.slab + ((size_t)u.slice * J.cM * BM + (size_t)(u.pm - J.nM) * BM) * ld + u.pn * BM;
#pragma unroll
    for (int ai = 0; ai < 2; ++ai)
#pragma unroll
        for (int m = 0; m < 4; ++m) {
            float* rowp = O + (size_t)(ai * HALF + wr * 64 + m * 16 + fr) * ld + wc * 32 + 8 * fq;
#pragma unroll
            for (int bj = 0; bj < 2; ++bj) { *(f32x4*)(rowp + bj * HALF) = acc[ai][bj][m][0]; *(f32x4*)(rowp + bj * HALF + 4) = acc[ai][bj][m][1]; }
        }
}
__device__ __forceinline__ void epilogue(const f32x4 (&acc)[2][2][4][2], const Call& C, const Unit& u, int wr, int wc, int fr_, int fq_, int lane) {
    asm volatile("" : "+v"(lane));
    const int fr = lane & 15, fq = lane >> 4;
    const Job& J = C.j0;
    if (u.slice >= 0) epi_slab(acc, J, u, wr, wc, fr, fq);
    else if (J.kind == K_PLAIN) epi_plain(acc, J, J.row0 + u.pm * BM, J.col0 + u.pn * BM, wr, wc, fr, fq);
    else if (J.kind == K_DFT) epi_plain(acc, J, J.row0 + ((u.pn >> 1) * J.p0 + u.pm) * BM, J.col0 + (u.pn & 1) * BM, wr, wc, fr, fq);
    else if (J.kind == K_ROPE) epi_rope(acc, J, J.row0 + u.pm * BM, J.col0 + u.pn * BM, wr, wc, fr, fq);
    else if (J.kind == K_VT) epi_vt(acc, J, u.pm, u.pn, wr, wc, fr, fq);
    else epi_ffn(acc, J, J.row0 + u.pm * BM, u.pn, wr, wc, fr, fq, lane);
}

__device__ __forceinline__ void gemm_phase(LAS unsigned char* lds, const Call& C, const int tid) {
    const int wid = __builtin_amdgcn_readfirstlane(tid >> 6), lane = tid & 63, wr = wid >> 2, wc = wid & 3, fr = lane & 15, fq = lane >> 4;
    unsigned voffA[2], voffB[2];
#pragma unroll
    for (int i = 0; i < 2; ++i) { int R, Cc; stage_rc(tid * 16 + i * 8192, R, Cc); const int Rb = (R & ~31) + perm32(R & 31);
        voffA[i] = (unsigned)(R * C.lda + Cc) * 2u; voffB[i] = (unsigned)(Rb * C.ldb + Cc) * 2u; }
    const size_t kstep = (size_t)(BK * 2);
    const size_t hstepA = (size_t)HALF * C.lda * 2, hstepB = (size_t)HALF * C.ldb * 2;
    const unsigned ldsw = (unsigned)wid * 1024u;
    const int aoff = lds_byte(wr * 64 + fr, fq * 8), boff = lds_byte(wc * 32 + fr, fq * 8);
#define PG8_SA(b, h) (((b) * 2 + (h)) * HTB)
#define PG8_SB(b, h) ((4 + (b) * 2 + (h)) * HTB)
#define PG8_STAGE(bufoff, gbase, voff) do { _Pragma("unroll") for (int _i = 0; _i < 2; ++_i) { unsigned _vo = (voff)[_i]; asm volatile("" : "+v"(_vo));   \
        __builtin_amdgcn_global_load_lds((const unsigned*)((const char*)(gbase) + _vo), (LAS unsigned*)(lds + (bufoff) + ldsw + _i * 8192), 16, 0, 0); } } while (0)
#define PG8_LDA(dst, b, h) do { _Pragma("unroll") for (int m = 0; m < 4; ++m) _Pragma("unroll") for (int k = 0; k < 2; ++k) dst[m][k] = *(const LAS bf16x8*)(lds + PG8_SA(b, h) + aoff + m * 2048 + k * 1024); } while (0)
#define PG8_LDB(dst, b, h) do { _Pragma("unroll") for (int n = 0; n < 2; ++n) _Pragma("unroll") for (int k = 0; k < 2; ++k) dst[n][k] = *(const LAS bf16x8*)(lds + PG8_SB(b, h) + boff + n * 2048 + k * 1024); } while (0)
#define PG8_MMA(ai, bj, At, Bt) do { __builtin_amdgcn_s_setprio(1); _Pragma("unroll") for (int m = 0; m < 4; ++m) _Pragma("unroll") for (int n = 0; n < 2; ++n) _Pragma("unroll") for (int k = 0; k < 2; ++k) \
        acc[ai][bj][m][n] = __builtin_amdgcn_mfma_f32_16x16x32_bf16(Bt[n][k], At[m][k], acc[ai][bj][m][n], 0, 0, 0); __builtin_amdgcn_s_setprio(0); } while (0)
#define PG8_WAIT_V(n) asm volatile("s_waitcnt vmcnt(" #n ")" ::: "memory")
#define PG8_WAIT_L(n) asm volatile("s_waitcnt lgkmcnt(" #n ")" ::: "memory")
#define PG8_BAR __builtin_amdgcn_s_barrier()
#define PG8_SCHED __builtin_amdgcn_sched_barrier(0)
#define PG8_APTR(u) ((const char*)C.j0.A + (size_t)(u).pm * 2 * hstepA + (size_t)(u).kp0 * (4 * BK))
#define PG8_BPTR(u) ((const char*)C.j0.B + (size_t)(u).pn * 2 * hstepB + (size_t)(u).kp0 * (4 * BK))
    Unit cur, nxt; int ui = 0;
    next_unit(C, 0, cur.pm, cur.pn, cur.kp0, cur.np, cur.slice);
    if (cur.pm < 0) return;
    f32x4 acc[2][2][4][2];
#pragma unroll
    for (int a = 0; a < 2; ++a)
#pragma unroll
        for (int b = 0; b < 2; ++b)
#pragma unroll
            for (int m = 0; m < 4; ++m)
#pragma unroll
                for (int n = 0; n < 2; ++n) acc[a][b][m][n] = (f32x4){0.f, 0.f, 0.f, 0.f};
    bf16x8 At[4][2], B0[2][2], B1[2][2];
    const char* cA = PG8_APTR(cur); const char* cB = PG8_BPTR(cur);
    PG8_STAGE(PG8_SB(0, 0), cB, voffB); PG8_STAGE(PG8_SB(0, 1), cB + hstepB, voffB); PG8_STAGE(PG8_SA(0, 0), cA, voffA); PG8_STAGE(PG8_SA(0, 1), cA + hstepA, voffA);
    if (wr == 1) PG8_BAR;
    PG8_WAIT_V(2); PG8_BAR;
    PG8_STAGE(PG8_SB(1, 0), cB + kstep, voffB); PG8_STAGE(PG8_SA(1, 0), cA + kstep, voffA); PG8_STAGE(PG8_SB(1, 1), cB + hstepB + kstep, voffB);
    PG8_WAIT_V(6); PG8_BAR;
    for (;;) {
        next_unit(C, ui + 1, nxt.pm, nxt.pn, nxt.kp0, nxt.np, nxt.slice);
        const bool has_next = nxt.pm >= 0;
        const char* nA = has_next ? PG8_APTR(nxt) : cA; const char* nB = has_next ? PG8_BPTR(nxt) : cB;
        const int nt = 2 * cur.np;
        for (int t = 0; t < nt; t += 2) {
            const bool last = (t == nt - 2);
            const char* a1 = cA + (size_t)(t + 1) * kstep;
            const char* a2 = last ? nA : cA + (size_t)(t + 2) * kstep; const char* b2 = last ? nB : cB + (size_t)(t + 2) * kstep;
            const char* a3 = a2 + kstep; const char* b3 = b2 + kstep;
            PG8_LDB(B0, 0, 0); PG8_LDB(B1, 0, 1); PG8_SCHED; PG8_LDA(At, 0, 0); PG8_STAGE(PG8_SA(1, 1), a1 + hstepA, voffA);
            PG8_WAIT_V(8); PG8_WAIT_L(0); PG8_BAR; PG8_MMA(0, 0, At, B0); PG8_MMA(0, 1, At, B1); PG8_BAR; PG8_SCHED;
            PG8_LDA(At, 0, 1); PG8_STAGE(PG8_SB(0, 0), b2, voffB); PG8_STAGE(PG8_SB(0, 1), b2 + hstepB, voffB); PG8_STAGE(PG8_SA(0, 0), a2, voffA);
            PG8_WAIT_V(8); PG8_WAIT_L(0); PG8_BAR; PG8_MMA(1, 0, At, B0); PG8_MMA(1, 1, At, B1); PG8_BAR; PG8_SCHED;
            PG8_LDB(B0, 1, 0); PG8_LDB(B1, 1, 1); PG8_SCHED; PG8_LDA(At, 1, 0); PG8_STAGE(PG8_SA(0, 1), a2 + hstepA, voffA);
            PG8_WAIT_V(8); PG8_WAIT_L(0); PG8_BAR; PG8_MMA(0, 0, At, B0); PG8_MMA(0, 1, At, B1); PG8_BAR; PG8_SCHED;
            PG8_LDA(At, 1, 1); PG8_STAGE(PG8_SB(1, 0), b3, voffB); PG8_STAGE(PG8_SB(1, 1), b3 + hstepB, voffB); PG8_STAGE(PG8_SA(1, 0), a3, voffA);
            PG8_WAIT_V(8); PG8_WAIT_L(0); PG8_BAR; PG8_MMA(1, 0, At, B0); PG8_MMA(1, 1, At, B1); PG8_BAR; PG8_SCHED;
        }
        if (wr == 0) PG8_BAR;
        epilogue(acc, C, cur, wr, wc, fr, fq, lane);
        if (!has_next) break;
#pragma unroll
        for (int a = 0; a < 2; ++a)
#pragma unroll
            for (int b = 0; b < 2; ++b)
#pragma unroll
                for (int m = 0; m < 4; ++m)
#pragma unroll
                    for (int n = 0; n < 2; ++n) acc[a][b][m][n] = (f32x4){0.f, 0.f, 0.f, 0.f};
        cur.pm = nxt.pm; cur.pn = nxt.pn; cur.kp0 = nxt.kp0; cur.np = nxt.np; cur.slice = nxt.slice; cA = nA; cB = nB; ++ui;
        if (wr == 1) PG8_BAR;
    }
    PG8_WAIT_V(0);
    PG8_BAR;
#undef PG8_SA
#undef PG8_SB
#undef PG8_STAGE
#undef PG8_LDA
#undef PG8_LDB
#undef PG8_MMA
#undef PG8_WAIT_V
#undef PG8_WAIT_L
#undef PG8_BAR
#undef PG8_SCHED
#undef PG8_APTR
#undef PG8_BPTR
}
}

__device__ __forceinline__ void tr_item(const float* src, int ldn, bf16_t* dst, bf16_t* dst2, int ldk, LAS float* scr, int lane) {
    f32x4 v[8]; const int r8 = lane >> 3, c4 = lane & 7;
#pragma unroll
    for (int i = 0; i < 8; ++i) v[i] = *(const f32x4*)(src + (size_t)(8 * i + r8) * ldn + 4 * c4);
#pragma unroll
    for (int i = 0; i < 8; ++i) { LAS float* w = scr + (8 * i + r8) * 33 + 4 * c4; w[0] = v[i][0]; w[1] = v[i][1]; w[2] = v[i][2]; w[3] = v[i][3]; }
    LDS_WAIT(); asm volatile("" ::: "memory");
    const int c = lane & 7;
#pragma unroll
    for (int j = 0; j < 4; ++j) { const int n = (lane >> 3) + 8 * j; const LAS float* sp = scr + (8 * c) * 33 + n;
        u32x4 o; o.x = cvt_pk_bf16(sp[0 * 33], sp[1 * 33]); o.y = cvt_pk_bf16(sp[2 * 33], sp[3 * 33]); o.z = cvt_pk_bf16(sp[4 * 33], sp[5 * 33]); o.w = cvt_pk_bf16(sp[6 * 33], sp[7 * 33]);
        *(u32x4*)(dst + (size_t)n * ldk + 8 * c) = o; if (dst2) *(u32x4*)(dst2 + (size_t)n * ldk + 8 * c) = o; }
    LDS_WAIT(); asm volatile("" ::: "memory");
}

struct Args { const float* in[18]; float* out; unsigned char* ws; int ph_lo, ph_hi, dry, pad; };

__device__ __forceinline__ void mod_item(LAS unsigned char* lds, const Args& a, int item, int tid) {
    const int l = item >> 6, n0 = 96 * (item & 63);
    const float* cv = a.in[1]; const float* cc = a.in[3]; const float* mw = a.in[4] + (size_t)l * DM * 6144; const float* mb = a.in[5] + l * 6144;
    LAS float* sv = (LAS float*)lds; LAS float* red = (LAS float*)(lds + 40960);
    for (int i = tid; i < 9 * DM; i += NTHR) { const int r = i >> 10, k = i & 1023; const float v = r < 8 ? cv[r * DM + k] : cc[k]; sv[i] = v / (1.0f + __expf(-v)); }
    __syncthreads();
    const int col4 = tid % 24, kg = tid / 24;
    if (kg < 21) {
        f32x4 acc[9];
#pragma unroll
        for (int r = 0; r < 9; ++r) acc[r] = (f32x4){0.f, 0.f, 0.f, 0.f};
#pragma unroll 7
        for (int k = kg; k < DM; k += 21) {
            const f32x4 w = *(const f32x4*)(mw + (size_t)k * 6144 + n0 + 4 * col4);
#pragma unroll
            for (int r = 0; r < 9; ++r) acc[r] += w * sv[r * DM + k];
        }
#pragma unroll
        for (int r = 0; r < 9; ++r)
#pragma unroll
            for (int e = 0; e < 4; ++e) red[(kg * 9 + r) * 96 + 4 * col4 + e] = acc[r][e];
    }
    __syncthreads();
    float* modx = (float*)(a.ws + WS_MODX); float* modc = (float*)(a.ws + WS_MODC);
    for (int idx = tid; idx < 9 * 96; idx += NTHR) {
        const int r = idx / 96, n = idx % 96; float s = mb[n0 + n];
        for (int g = 0; g < 21; ++g) s += red[(g * 9 + r) * 96 + n];
        if (r < 8) modx[((size_t)(l * 8 + r)) * 6144 + n0 + n] = s; else modc[(size_t)l * 6144 + n0 + n] = s;
    }
    __syncthreads();
}

__device__ __forceinline__ void fold_in_item(LAS unsigned char* lds, const Args& a, int item, int tid) {
    const int o = item >> 8, g = (item >> 6) & 3, kc = item & 63;
    const float* W = a.in[11] + (size_t)o * DM * DM; bf16_t* WMI = (bf16_t*)(a.ws + WS_WMI + o * SZ_WMI);
    LAS float* Wl = (LAS float*)lds; const LAS float* tab = (const LAS float*)(lds + LDS_COSTAB);
    LAS float* tc = (LAS float*)(lds + 8192); LAS float* ts = tc + 128;
    if (tid < 128) { tc[tid] = tab[16 * tid]; ts[tid] = tab[(16 * tid - 512) & 2047]; }
#pragma unroll
    for (int i = 0; i < 4; ++i) { const int idx = tid + NTHR * i, kk = idx >> 7, j = idx & 127; Wl[idx] = W[(size_t)(16 * kc + kk) * DM + 512 + 128 * g + j]; }
    __syncthreads();
    const int jp = tid & 127, kq = tid >> 7;
    float ac[4] = {0.f, 0.f, 0.f, 0.f}, as[4] = {0.f, 0.f, 0.f, 0.f};
#pragma unroll 4
    for (int j = 0; j < 128; ++j) {
        const int ph = (j * jp) & 127; const float cvv = tc[ph], svv = ts[ph];
#pragma unroll
        for (int q = 0; q < 4; ++q) { const float w = Wl[(4 * kq + q) * 128 + j]; ac[q] += w * cvv; as[q] += w * svv; }
    }
    u32x2 oc, os; oc.x = cvt_pk_bf16(ac[0], ac[1]); oc.y = cvt_pk_bf16(ac[2], ac[3]); os.x = cvt_pk_bf16(as[0], as[1]); os.y = cvt_pk_bf16(as[2], as[3]);
    *(u32x2*)(WMI + (size_t)(512 + 128 * g + jp) * DM + 16 * kc + 4 * kq) = oc;
    *(u32x2*)(WMI + (size_t)(1024 + 128 * g + jp) * DM + 16 * kc + 4 * kq) = os;
    __syncthreads();
}
__device__ __forceinline__ void fold_out_item(LAS unsigned char* lds, const Args& a, int item, int tid) {
    const int o = item >> 7, g = (item >> 5) & 3, nc = item & 31;
    const float* WG = a.in[12] + (size_t)(o * 4 + g) * 128 * 128; const float* SC = a.in[13] + o * 512 + 128 * g; const float* WO = a.in[14] + (size_t)o * DM * DM + (size_t)(128 * g) * DM + 32 * nc;
    bf16_t* WMO = (bf16_t*)(a.ws + WS_WMO + o * SZ_WMO);
    LAS float* Wg = (LAS float*)lds; LAS float* Wo = (LAS float*)(lds + 66560);
    {
        f32x4 t[8];
#pragma unroll
        for (int i = 0; i < 8; ++i) t[i] = *(const f32x4*)(WG + 4 * (tid + NTHR * i));
        float wo[8];
#pragma unroll
        for (int i = 0; i < 8; ++i) { const int idx = tid + NTHR * i, d = idx >> 5, nn = idx & 31; wo[i] = SC[d] * WO[(size_t)d * DM + nn]; }
#pragma unroll
        for (int i = 0; i < 8; ++i) { const int idx = 4 * (tid + NTHR * i), c = idx >> 7, d = idx & 127; LAS float* w = Wg + c * 129 + d; w[0] = t[i][0]; w[1] = t[i][1]; w[2] = t[i][2]; w[3] = t[i][3]; }
#pragma unroll
        for (int i = 0; i < 8; ++i) Wo[tid + NTHR * i] = wo[i];
    }
    __syncthreads();
    const int c = tid & 127, nq = tid >> 7;
    float acc[8];
#pragma unroll
    for (int e = 0; e < 8; ++e) acc[e] = 0.f;
    for (int d = 0; d < 128; ++d) { const float wg = Wg[c * 129 + d];
#pragma unroll
        for (int e = 0; e < 8; ++e) acc[e] += wg * Wo[d * 32 + 8 * nq + e]; }
#pragma unroll
    for (int e = 0; e < 8; ++e) WMO[(size_t)(32 * nc + 8 * nq + e) * KMO + 128 * g + c] = (bf16_t)(cvt_pk_bf16(acc[e], 0.f) & 0xffffu);
    __syncthreads();
}

__device__ __forceinline__ void tr_layer(LAS unsigned char* lds, const Args& a, int l, int wr, int nw, int lane, int wave) {
    LAS float* scr = (LAS float*)(lds + wave * 8448);
    constexpr int I_WIN = 16 * 72, I_WOUT = 16 * 32, I_WMI = 16 * 16, I_WMO = 8 * 32, I_WUP = 16 * 176, I_WDN = 44 * 32;
    const bool even = (l & 1) == 0; const int eo = l >> 1;
    const int n1 = even ? I_WIN : I_WMI, n2 = even ? I_WOUT : I_WMO, NIT = n1 + n2 + I_WUP + I_WDN;
    for (int it = wr; it < NIT; it += nw) {
        int r = it;
        if (r < n1) {
            if (even) { const int kb = r / 72, nb = r % 72;
                tr_item(a.in[7] + (size_t)eo * DM * ATT_IN + (size_t)(64 * kb) * ATT_IN + 32 * nb, ATT_IN, (bf16_t*)(a.ws + WS_WIN + eo * SZ_WIN) + (size_t)(32 * nb) * DM + 64 * kb, nullptr, DM, scr, lane); }
            else { const int kb = r / 16, nb = r % 16;
                tr_item(a.in[11] + (size_t)eo * DM * DM + (size_t)(64 * kb) * DM + 32 * nb, DM, (bf16_t*)(a.ws + WS_WMI + eo * SZ_WMI) + (size_t)(32 * nb) * DM + 64 * kb, nullptr, DM, scr, lane); }
            continue; }
        r -= n1;
        if (r < n2) {
            const int kb = r / 32, nb = r % 32;
            if (even) tr_item(a.in[10] + (size_t)eo * DM * DM + (size_t)(64 * kb) * DM + 32 * nb, DM, (bf16_t*)(a.ws + WS_WOUT + eo * SZ_WOUT) + (size_t)(32 * nb) * DM + 64 * kb, nullptr, DM, scr, lane);
            else { bf16_t* d1 = (bf16_t*)(a.ws + WS_WMO + eo * SZ_WMO) + (size_t)(32 * nb) * KMO + 512 + 64 * kb;
                tr_item(a.in[14] + (size_t)eo * DM * DM + (size_t)(512 + 64 * kb) * DM + 32 * nb, DM, d1, d1 + 512, KMO, scr, lane); }
            continue; }
        r -= n2;
        if (r < I_WUP) { const int kb = r / 176, nb = r % 176, j = nb >> 3, sub = nb & 7;
            const int scol = sub < 4 ? 128 * j + 32 * sub : DFF + 128 * j + 32 * (sub - 4);
            tr_item(a.in[15] + (size_t)l * DM * NUP + (size_t)(64 * kb) * NUP + scol, NUP, (bf16_t*)(a.ws + WS_WUP + l * SZ_WUP) + (size_t)(32 * nb) * DM + 64 * kb, nullptr, DM, scr, lane); continue; }
        r -= I_WUP;
        { const int kb = r / 32, nb = r % 32;
            tr_item(a.in[17] + (size_t)l * DFF * DM + (size_t)(64 * kb) * DM + 32 * nb, DM, (bf16_t*)(a.ws + WS_WDN + l * SZ_WDN) + (size_t)(32 * nb) * DFF + 64 * kb, nullptr, DFF, scr, lane); }
    }
}
__device__ __forceinline__ void fold_layer(LAS unsigned char* lds, const Args& a, int o, int rk, int n, int tid) {
    { LAS float* tab = (LAS float*)(lds + LDS_COSTAB); for (int i = tid; i < 2048; i += NTHR) tab[i] = cospif((float)i * (1.0f / 1024.0f)); }
    __syncthreads();
    for (int it = rk; it < 256; it += n) fold_in_item(lds, a, o * 256 + it, tid);
    for (int it = rk; it < 128; it += n) fold_out_item(lds, a, o * 128 + it, tid);
    if (o == 0) {
        const LAS float* tab = (const LAS float*)(lds + LDS_COSTAB);
        const int gt = rk * NTHR + tid, NT = n * NTHR;
        bf16_t* FM = (bf16_t*)(a.ws + WS_FMAT);
        for (int idx = gt; idx < 2048 * 512; idx += NT) {
            const int k = idx >> 9, ch = idx & 511, s = ch >> 8, t0 = (ch & 255) * 8; float v[8];
#pragma unroll
            for (int e = 0; e < 8; ++e) { const int ph = (k * (t0 + e)) & 2047; v[e] = s ? -tab[(ph - 512) & 2047] * (1.0f / 512.0f) : tab[ph] * (1.0f / 512.0f); }
            u32x4 w; w.x = cvt_pk_bf16(v[0], v[1]); w.y = cvt_pk_bf16(v[2], v[3]); w.z = cvt_pk_bf16(v[4], v[5]); w.w = cvt_pk_bf16(v[6], v[7]);
            *(u32x4*)(FM + (size_t)k * 4096 + ch * 8) = w;
        }
        bf16_t* FC = (bf16_t*)(a.ws + WS_FC); const float nc = 0.005524271728019903f;
        for (int idx = gt; idx < 256 * 64; idx += NT) {
            const int k = idx >> 6, ch = idx & 63, s = ch >> 5, t0 = (ch & 31) * 8; float v[8];
#pragma unroll
            for (int e = 0; e < 8; ++e) { const int ph = ((k * (t0 + e)) & 255) * 8; v[e] = s ? -tab[(ph - 512) & 2047] * nc : tab[ph] * nc; }
            u32x4 w; w.x = cvt_pk_bf16(v[0], v[1]); w.y = cvt_pk_bf16(v[2], v[3]); w.z = cvt_pk_bf16(v[4], v[5]); w.w = cvt_pk_bf16(v[6], v[7]);
            *(u32x4*)(FC + (size_t)k * 512 + ch * 8) = w;
        }
    }
    __syncthreads();
}
__device__ __forceinline__ void prologue_a(LAS unsigned char* lds, const Args& a, int tid, int lane, int wave, int G) {
    const int bx = blockIdx.x;
    for (int it = bx; it < 256; it += G) mod_item(lds, a, it, tid);
    tr_layer(lds, a, 0, bx * NWAVES + wave, G * NWAVES, lane, wave);
    { const int gt = bx * NTHR + tid, NT = G * NTHR; float* TC = (float*)(a.ws + WS_TAB); float* TS = TC + 1024;
      for (int idx = gt; idx < 1024; idx += NT) { const int pos = idx >> 4, j = idx & 15; const float inv = powf(10000.0f, -(float)j / 16.0f); const float ang = (float)pos * inv; TC[idx] = cosf(ang); TS[idx] = sinf(ang); } }
    __syncthreads();
}

__device__ __forceinline__ void ld_row_f32(const float* p, int lane, f32x4 (&v)[4]) {
#pragma unroll
    for (int j = 0; j < 4; ++j) v[j] = *(const f32x4*)(p + 4 * lane + 256 * j);
}
__device__ __forceinline__ float row_rs(const f32x4 (&v)[4]) {
    float s = 0.f;
#pragma unroll
    for (int j = 0; j < 4; ++j) s += (v[j][0] * v[j][0] + v[j][1] * v[j][1]) + (v[j][2] * v[j][2] + v[j][3] * v[j][3]);
    return __builtin_amdgcn_rsqf(wave_sum(s) * (1.0f / DM) + EPS);
}
__device__ __forceinline__ void norm_mod_store(const f32x4 (&x)[4], const float* gain, const float* sc, const float* sh, bf16_t* hrow, int lane) {
    const float rs = row_rs(x);
#pragma unroll
    for (int j = 0; j < 4; ++j) {
        const int c = 4 * lane + 256 * j;
        const f32x4 g = *(const f32x4*)(gain + c), s1 = *(const f32x4*)(sc + c), s0 = *(const f32x4*)(sh + c);
        const f32x4 h = (x[j] * rs * g) * (s1 + 1.0f) + s0;
        u32x2 w; w.x = cvt_pk_bf16(h[0], h[1]); w.y = cvt_pk_bf16(h[2], h[3]);
        *(u32x2*)(hrow + c) = w;
    }
}
typedef GAS const float* gcf;
struct RowRegs { f32x4 x[4], y[4], gt[4], sc[4], sh[4]; };
struct RowCtx { gcf xsX, xsC, modx, modc, slab; GAS const bf16_t* Y; int layer, which, ns, lane; bool do_norm; };
__device__ __forceinline__ void row_load(RowRegs& R, const RowCtx& c, int row) {
    const bool isx = row < MX; const int b = row >> 11, lane = c.lane;
    gcf xi = isx ? c.xsX + (size_t)row * DM : c.xsC + (size_t)(row - MX) * DM;
#pragma unroll
    for (int j = 0; j < 4; ++j) R.x[j] = *(const GAS f32x4*)(xi + 4 * lane + 256 * j);
    gcf mod = isx ? c.modx + (size_t)(c.layer * 8 + b) * 6144 : c.modc + (size_t)c.layer * 6144;
    gcf modn = (c.which == 2) ? mod + (isx ? 8 * 6144 : 6144) : mod;
    const int so = c.which == 1 ? 4096 : 1024, ho = c.which == 1 ? 3072 : 0;
    if (c.do_norm) {
#pragma unroll
        for (int j = 0; j < 4; ++j) { R.sc[j] = *(const GAS f32x4*)(modn + so + 4 * lane + 256 * j); R.sh[j] = *(const GAS f32x4*)(modn + ho + 4 * lane + 256 * j); }
    }
    if (c.which != 0) {
        gcf gate = mod + (c.which == 1 ? 2048 : 5120);
#pragma unroll
        for (int j = 0; j < 4; ++j) R.gt[j] = *(const GAS f32x4*)(gate + 4 * lane + 256 * j);
        if (isx) {
#pragma unroll
            for (int j = 0; j < 4; ++j) { const u32x2 w = *(const GAS u32x2*)(c.Y + (size_t)row * DM + 4 * lane + 256 * j); R.y[j] = (f32x4){bf_lo(w.x), bf_hi(w.x), bf_lo(w.y), bf_hi(w.y)}; }
        } else {
            gcf sl = c.slab + (size_t)(row - MX) * DM;
#pragma unroll
            for (int j = 0; j < 4; ++j) R.y[j] = *(const GAS f32x4*)(sl + 4 * lane + 256 * j);
            for (int k = 1; k < c.ns; ++k)
#pragma unroll
                for (int j = 0; j < 4; ++j) R.y[j] += *(const GAS f32x4*)(sl + (size_t)k * MC * DM + 4 * lane + 256 * j);
        }
    }
}
__device__ __forceinline__ void row_finish(RowRegs& R, const RowCtx& c, int row, const f32x4 (&gA)[4], const f32x4 (&gB)[4], GAS float* xo, GAS bf16_t* ho) {
    const int lane = c.lane;
    if (c.which != 0) {
        const float rsy = row_rs(R.y);
#pragma unroll
        for (int j = 0; j < 4; ++j) { R.x[j] = R.x[j] + R.gt[j] * (R.y[j] * rsy * gA[j]); *(GAS f32x4*)(xo + 4 * lane + 256 * j) = R.x[j]; }
    }
    if (c.do_norm) {
        const float rs = row_rs(R.x);
#pragma unroll
        for (int j = 0; j < 4; ++j) {
            const f32x4 h = (R.x[j] * rs * gB[j]) * (R.sc[j] + 1.0f) + R.sh[j];
            u32x2 w; w.x = cvt_pk_bf16(h[0], h[1]); w.y = cvt_pk_bf16(h[2], h[3]);
            *(GAS u32x2*)(ho + 4 * lane + 256 * j) = w;
        }
    }
}
__device__ __forceinline__ void row_phase(const Args& a, int layer, int which, int nrows, int lane, int gw, int NGW) {
    RowCtx c; c.layer = layer; c.which = which; c.lane = lane; c.do_norm = !(which == 2 && layer == DEPTH - 1);
    c.modx = (gcf)(a.ws + WS_MODX); c.modc = (gcf)(a.ws + WS_MODC); c.Y = (GAS const bf16_t*)(a.ws + WS_Y);
    c.slab = (gcf)(a.ws + (which == 1 ? WS_BIG : WS_MIX)); c.ns = which == 1 ? SL_OUT : SL_DN;
    GAS float* hctx = (GAS float*)(a.ws + WS_HCTX); GAS float* xoX = a.dry ? (GAS float*)(a.ws + WS_BIG) : (GAS float*)a.out; GAS bf16_t* HX = (GAS bf16_t*)(a.ws + WS_HX);
    const bool first = layer == 0 && which < 2;
    c.xsX = first ? (gcf)a.in[0] : (gcf)a.out; c.xsC = first ? (gcf)a.in[2] : (gcf)hctx;
    gcf gains = (gcf)a.in[6];
    f32x4 gA[4], gB[4];
    { gcf pa = gains + (layer * 4 + (which == 1 ? 1 : 3)) * DM; gcf pb = gains + ((which == 2 ? layer + 1 : layer) * 4 + (which == 1 ? 2 : 0)) * DM;
      if (!c.do_norm) pb = pa;
#pragma unroll
      for (int j = 0; j < 4; ++j) { gA[j] = *(const GAS f32x4*)(pa + 4 * lane + 256 * j); gB[j] = *(const GAS f32x4*)(pb + 4 * lane + 256 * j); } }
    const int nX = (MX + NGW - 1) / NGW, nC = nrows > MX ? (nrows - MX + NGW - 1) / NGW : 0;
    for (int i = 0; i < nX + nC; i += 2) {
        int rowA = i < nX ? gw * nX + i : MX + gw * nC + (i - nX); const int lim = i < nX ? MX : nrows;
        int rowB = i + 1 < nX ? gw * nX + i + 1 : MX + gw * nC + (i + 1 - nX); const int limB = i + 1 < nX ? MX : nrows;
        const bool okA = rowA < lim, two = okA && (i + 1 < nX + nC) && rowB < limB;
        if (!okA) { if (i + 1 < nX + nC && rowB < limB) { rowA = rowB; } else continue; }
        if (!two) rowB = rowA;
        RowRegs A, B;
        row_load(A, c, rowA); row_load(B, c, rowB);
        row_finish(A, c, rowA, gA, gB, rowA < MX ? xoX + (size_t)rowA * DM : hctx + (size_t)(rowA - MX) * DM, HX + (size_t)rowA * DM);
        if (two) row_finish(B, c, rowB, gA, gB, rowB < MX ? xoX + (size_t)rowB * DM : hctx + (size_t)(rowB - MX) * DM, HX + (size_t)rowB * DM);
    }
}

typedef short v4i16_t __attribute__((ext_vector_type(4)));
constexpr int AT_KP = 144, AT_VP = 192;
constexpr int AT_KB = 128 * AT_KP, AT_VB = 128 * AT_VP, AT_BUF = AT_KB + AT_VB, AT_STG = 2 * AT_BUF, AT_STGW = 32 * 144, AT_SCR = AT_STG + 8 * AT_STGW;
static_assert(AT_SCR + 8 * 256 <= RING_BYTES, "attention LDS map");
constexpr float AT_THR = 8.0f;
__device__ __forceinline__ int crow(int r, int hi) { return (r & 3) + 8 * (r >> 2) + 4 * hi; }

__device__ __forceinline__ void attn_unit(LAS unsigned char* lds, const bf16_t* U, bf16_t* MIXo, const float* sink8, int b, int hk, int qrow0, int qpos0, bool latent, int tid) {
    const int lane = tid & 63, r32 = lane & 31, hi = lane >> 5, wid = __builtin_amdgcn_readfirstlane(tid >> 6);
    const int hq = 4 * hk + (wid >> 1), rowoff = 32 * (wid & 1), qa = qpos0 + rowoff;
    const int ctxrow0 = MX + b * CTXL, nst = latent ? 5 : 2;
    bf16x8 qf[4];
#pragma unroll
    for (int d0 = 0; d0 < 4; ++d0) qf[d0] = *(const bf16x8*)(U + (size_t)(qrow0 + rowoff + r32) * ATT_IN + hq * 64 + 16 * d0 + 8 * hi);
    const float sink2 = sink8[hq] * LOG2E;
    float mref = sink2, lsum = hi == 0 ? 1.f : 0.f;
    f32x16 o0, o1, negm;
#pragma unroll
    for (int r = 0; r < 16; ++r) { o0[r] = 0.f; o1[r] = 0.f; negm[r] = -sink2; }
    volatile LAS float* scr = (volatile LAS float*)(lds + AT_SCR) + wid * 64;
    const int skey = tid >> 3, sch = tid & 7;
    u32x4 kr0, kr1, vr0, vr1;
#define AT_ROW(st, key) ((st) < 2 ? ctxrow0 + 128 * (st) + (key) : b * SEQ + min(max(qpos0 - 128 + 128 * ((st) - 2) + (key), 0), SEQ - 1))
#define AT_LOAD(st) do { const bf16_t* p0_ = U + (size_t)AT_ROW(st, skey) * ATT_IN + 512 + hk * 64 + 8 * sch; const bf16_t* p1_ = U + (size_t)AT_ROW(st, skey + 64) * ATT_IN + 512 + hk * 64 + 8 * sch; \
        kr0 = *(const u32x4*)p0_; vr0 = *(const u32x4*)(p0_ + 128); kr1 = *(const u32x4*)p1_; vr1 = *(const u32x4*)(p1_ + 128); } while (0)
#define AT_WRITE(bufi) do { LAS unsigned char* kb_ = lds + (bufi) * AT_BUF; LAS unsigned char* vb_ = kb_ + AT_KB; \
        *(LAS u32x4*)(kb_ + skey * AT_KP + sch * 16) = kr0; *(LAS u32x4*)(kb_ + (skey + 64) * AT_KP + sch * 16) = kr1; \
        *(LAS u32x4*)(vb_ + skey * AT_VP + sch * 16) = vr0; *(LAS u32x4*)(vb_ + (skey + 64) * AT_VP + sch * 16) = vr1; } while (0)
    AT_LOAD(0); AT_WRITE(0);
    __syncthreads();
    for (int st = 0; st < nst; ++st) {
        if (st + 1 < nst) AT_LOAD(st + 1);
        const LAS unsigned char* kbuf = lds + (st & 1) * AT_BUF; const LAS unsigned char* vbuf = kbuf + AT_KB;
        const bool win = st >= 2;
#pragma unroll
        for (int h = 0; h < 2; ++h) {
            const int kp = qpos0 - 128 + 128 * (st - 2) + 64 * h;
            if (win && (kp < 0 || kp >= SEQ || kp > qa + 159 || kp + 63 < qa - 128)) continue;
            const bool needmask = win && !(qa + 31 - kp <= 128 && kp + 63 - qa <= 128);
            const LAS unsigned char* kb = kbuf + (64 * h + r32) * AT_KP + 16 * hi;
            f32x16 p0 = negm, p1 = negm;
#pragma unroll
            for (int d0 = 0; d0 < 4; ++d0) {
                const bf16x8 k0 = *(const LAS bf16x8*)(kb + 32 * d0), k1 = *(const LAS bf16x8*)(kb + 32 * AT_KP + 32 * d0);
                p0 = __builtin_amdgcn_mfma_f32_32x32x16_bf16(k0, qf[d0], p0, 0, 0, 0); p1 = __builtin_amdgcn_mfma_f32_32x32x16_bf16(k1, qf[d0], p1, 0, 0, 0);
            }
            if (needmask) {
                const int qpos = qa + r32;
#pragma unroll
                for (int r = 0; r < 16; ++r) { const int kq = kp + crow(r, hi); int d0_ = qpos - kq; d0_ = d0_ < 0 ? -d0_ : d0_; int d1_ = qpos - (kq + 32); d1_ = d1_ < 0 ? -d1_ : d1_;
                    if (d0_ > 128) p0[r] = -INFINITY; if (d1_ > 128) p1[r] = -INFINITY; }
            }
            float mx = fmaxf(fmaxf(p0[0], p0[1]), p1[0]);
#pragma unroll
            for (int r = 2; r < 16; r += 2) mx = fmaxf(fmaxf(mx, p0[r]), p0[r + 1]);
#pragma unroll
            for (int r = 1; r < 15; r += 2) mx = fmaxf(fmaxf(mx, p1[r]), p1[r + 1]);
            mx = fmaxf(mx, p1[15]);
            mx = fmaxf(mx, __shfl_xor(mx, 32));
            if (__any(mx > AT_THR)) {
                const float dl = fmaxf(mx, 0.f), f = __builtin_amdgcn_exp2f(-dl);
                mref += dl; lsum *= f;
#pragma unroll
                for (int r = 0; r < 16; ++r) { p0[r] -= dl; p1[r] -= dl; negm[r] = -mref; }
                if (hi == 0) scr[r32] = f;
                LDS_WAIT();
#pragma unroll
                for (int r = 0; r < 16; ++r) { const float al = scr[crow(r, hi)]; o0[r] *= al; o1[r] *= al; }
                LDS_WAIT();
            }
            float rsum = 0.f;
#pragma unroll
            for (int r = 0; r < 16; ++r) { p0[r] = __builtin_amdgcn_exp2f(p0[r]); p1[r] = __builtin_amdgcn_exp2f(p1[r]); rsum += p0[r] + p1[r]; }
            lsum += rsum;
            bf16x8 pa[4];
#pragma unroll
            for (int s2 = 0; s2 < 2; ++s2) {
                u32x4 w0, w1;
                w0.x = cvt_pk_bf16(p0[8 * s2 + 0], p0[8 * s2 + 1]); w0.y = cvt_pk_bf16(p0[8 * s2 + 2], p0[8 * s2 + 3]); w0.z = cvt_pk_bf16(p0[8 * s2 + 4], p0[8 * s2 + 5]); w0.w = cvt_pk_bf16(p0[8 * s2 + 6], p0[8 * s2 + 7]);
                w1.x = cvt_pk_bf16(p1[8 * s2 + 0], p1[8 * s2 + 1]); w1.y = cvt_pk_bf16(p1[8 * s2 + 2], p1[8 * s2 + 3]); w1.z = cvt_pk_bf16(p1[8 * s2 + 4], p1[8 * s2 + 5]); w1.w = cvt_pk_bf16(p1[8 * s2 + 6], p1[8 * s2 + 7]);
                pa[s2] = __builtin_bit_cast(bf16x8, w0); pa[2 + s2] = __builtin_bit_cast(bf16x8, w1);
            }
            const LAS unsigned char* vb = vbuf + (64 * h + 4 * hi + ((lane & 15) >> 2)) * AT_VP + ((lane >> 4) & 1) * 32 + (lane & 3) * 8;
#pragma unroll
            for (int s = 0; s < 4; ++s) {
#pragma unroll
                for (int d = 0; d < 2; ++d) {
                    const v4i16_t lo = __builtin_amdgcn_ds_read_tr16_b64_v4i16((LAS v4i16_t*)(vb + 16 * s * AT_VP + 64 * d));
                    const v4i16_t hh = __builtin_amdgcn_ds_read_tr16_b64_v4i16((LAS v4i16_t*)(vb + (16 * s + 8) * AT_VP + 64 * d));
                    const bf16x8 vf = (bf16x8){lo[0], lo[1], lo[2], lo[3], hh[0], hh[1], hh[2], hh[3]};
                    if (d == 0) o0 = __builtin_amdgcn_mfma_f32_32x32x16_bf16(pa[s], vf, o0, 0, 0, 0); else o1 = __builtin_amdgcn_mfma_f32_32x32x16_bf16(pa[s], vf, o1, 0, 0, 0);
                }
            }
        }
        if (st + 1 < nst) AT_WRITE((st + 1) & 1);
        __syncthreads();
    }
    {
        const float lt = lsum + __shfl_xor(lsum, 32);
        if (hi == 0) scr[r32] = 1.0f / lt;
        LDS_WAIT();
        LAS unsigned short* stg = (LAS unsigned short*)(lds + AT_STG + wid * AT_STGW);
#pragma unroll
        for (int r = 0; r < 16; ++r) { const int q = crow(r, hi); const float il = scr[q];
            stg[q * 72 + r32] = (unsigned short)(cvt_pk_bf16(o0[r] * il, 0.f) & 0xffffu); stg[q * 72 + 32 + r32] = (unsigned short)(cvt_pk_bf16(o1[r] * il, 0.f) & 0xffffu); }
        LDS_WAIT();
#pragma unroll
        for (int i = 0; i < 4; ++i) { const int row = i * 8 + (lane >> 3), ch = lane & 7; const u32x4 v = *(const LAS u32x4*)((const LAS unsigned char*)stg + row * 144 + ch * 16);
            *(u32x4*)(MIXo + (size_t)(qrow0 + rowoff + row) * KMO + hq * 64 + 8 * ch) = v; }
        LDS_WAIT();
    }
#undef AT_ROW
#undef AT_LOAD
#undef AT_WRITE
}

__device__ __forceinline__ u32x4 ld16(const bf16_t* p) { return *(const u32x4*)p; }
__device__ __forceinline__ void unpack8(const u32x4& w, float (&f)[8]) { f[0] = bf_lo(w.x); f[1] = bf_hi(w.x); f[2] = bf_lo(w.y); f[3] = bf_hi(w.y); f[4] = bf_lo(w.z); f[5] = bf_hi(w.z); f[6] = bf_lo(w.w); f[7] = bf_hi(w.w); }

__device__ __forceinline__ void sconv_pass(const Args& a, int e, int nrows, int gt, int NT) {
    const bf16_t* U = (const bf16_t*)(a.ws + WS_BIG); bf16_t* MIXo = (bf16_t*)(a.ws + WS_MIX); const float* cw = a.in[9] + (size_t)e * 3 * 512;
    for (int idx = gt; idx < nrows * 64; idx += NT) {
        const int row = idx >> 6, ch = idx & 63;
        const int t = row < MX ? (row & (SEQ - 1)) : ((row - MX) & (CTXL - 1)), T = row < MX ? SEQ : CTXL;
        const bf16_t* up = U + (size_t)row * ATT_IN + 8 * ch;
        float bv[8], acc[8];
        unpack8(ld16(up + 768), bv);
#pragma unroll
        for (int q = 0; q < 8; ++q) acc[q] = 0.f;
#pragma unroll
        for (int j = 0; j < 3; ++j) {
            const int tt = t + j - 1;
            if (tt >= 0 && tt < T) {
                float cvv[8], zv[8];
                unpack8(ld16(up + (ptrdiff_t)(j - 1) * ATT_IN + 1280), cvv); unpack8(ld16(up + (ptrdiff_t)(j - 1) * ATT_IN + 1792), zv);
                const f32x4 w0 = *(const f32x4*)(cw + j * 512 + 8 * ch), w1 = *(const f32x4*)(cw + j * 512 + 8 * ch + 4);
#pragma unroll
                for (int q = 0; q < 4; ++q) { acc[q] += w0[q] * (cvv[q] * zv[q]); acc[4 + q] += w1[q] * (cvv[4 + q] * zv[4 + q]); }
            }
        }
        u32x4 w; w.x = cvt_pk_bf16(bv[0] * acc[0], bv[1] * acc[1]); w.y = cvt_pk_bf16(bv[2] * acc[2], bv[3] * acc[3]); w.z = cvt_pk_bf16(bv[4] * acc[4], bv[5] * acc[5]); w.w = cvt_pk_bf16(bv[6] * acc[6], bv[7] * acc[7]);
        *(u32x4*)(MIXo + (size_t)row * KMO + 512 + 8 * ch) = w;
    }
}
__device__ __forceinline__ void pool_pass(const Args& a, int nrows, int gt, int NT) {
    const bf16_t* UP = (const bf16_t*)(a.ws + WS_UPOOL); bf16_t* MIXo = (bf16_t*)(a.ws + WS_MIX);
    for (int idx = gt; idx < nrows * 64; idx += NT) {
        const int row = idx >> 6, ch = idx & 63, g = ch >> 4, hw = 1 << g;
        const int t = row < MX ? (row & (SEQ - 1)) : ((row - MX) & (CTXL - 1)), T = row < MX ? SEQ : CTXL;
        const int lo = t - hw < 0 ? 0 : t - hw, hi = t + hw > T ? T : t + hw;
        const bf16_t* up = UP + (size_t)row * 512 + 8 * ch;
        float acc[8], f[8];
#pragma unroll
        for (int q = 0; q < 8; ++q) acc[q] = 0.f;
        for (int s = lo; s < hi; ++s) { unpack8(ld16(up + (ptrdiff_t)(s - t) * 512), f);
#pragma unroll
            for (int q = 0; q < 8; ++q) acc[q] += f[q]; }
        unpack8(ld16(up), f);
        const float inv = 1.0f / (float)(hi - lo);
#pragma unroll
        for (int q = 0; q < 8; ++q) acc[q] = acc[q] * inv - f[q];
        u32x4 w; w.x = cvt_pk_bf16(acc[0], acc[1]); w.y = cvt_pk_bf16(acc[2], acc[3]); w.z = cvt_pk_bf16(acc[4], acc[5]); w.w = cvt_pk_bf16(acc[6], acc[7]);
        *(u32x4*)(MIXo + (size_t)row * KMO + 8 * ch) = w;
    }
}
__device__ __forceinline__ void ffn_fixup(const Args& a, int layer, int nrows, int gt, int NT) {
    const float* SIDE = (const float*)(a.ws + WS_SIDE); bf16_t* ACT = (bf16_t*)(a.ws + WS_BIG); const float* cw = a.in[16] + (size_t)layer * 3 * DFF;
    const int nblk = nrows >> 6;
    for (int idx = gt; idx < nblk * 2 * (DFF / 4); idx += NT) {
        const int c4 = idx % (DFF / 4), bw = idx / (DFF / 4), blk = bw >> 1, which = bw & 1, col = 4 * c4;
        const int row = blk * 64 + (which ? 63 : 0);
        const int sb = row < MX ? (blk & 31) : ((blk - MX / 64) & 3), nsb = row < MX ? 32 : 4;
        const float* sp = SIDE + ((size_t)(blk * 2 + which) * 3) * DFF + col;
        f32x4 cv = *(const f32x4*)sp; const f32x4 vv = *(const f32x4*)(sp + 2 * DFF);
        if (which == 0 && sb > 0) { const f32x4 gl = *(const f32x4*)(SIDE + ((size_t)((blk - 1) * 2 + 1) * 3 + 1) * DFF + col); cv += *(const f32x4*)(cw + col) * gl; }
        if (which == 1 && sb < nsb - 1) { const f32x4 gf = *(const f32x4*)(SIDE + ((size_t)((blk + 1) * 2 + 0) * 3 + 1) * DFF + col); cv += *(const f32x4*)(cw + 2 * DFF + col) * gf; }
        u32x2 w; w.x = cvt_pk_bf16(silu_f(cv[0]) * vv[0], silu_f(cv[1]) * vv[1]); w.y = cvt_pk_bf16(silu_f(cv[2]) * vv[2], silu_f(cv[3]) * vv[3]);
        *(u32x2*)(ACT + (size_t)row * DFF + col) = w;
    }
}

constexpr int STEPS_PER_LAYER = 13, N_STEPS = 2 + STEPS_PER_LAYER * DEPTH;
enum { ST_NOP = 0, ST_PRO, ST_ROW, ST_GEMM, ST_ATT, ST_POOL, ST_FIX };

__global__ void __launch_bounds__(NTHR, 2) dit_fwd(Args args) {
    extern __shared__ __attribute__((aligned(16))) unsigned char lds_raw[];
    LAS unsigned char* lds = (LAS unsigned char*)lds_raw;
    for (int u = threadIdx.x; u < (LDS_BYTES - LDSCTL_OFF) / 4; u += NTHR) ((LAS unsigned*)(lds + LDSCTL_OFF))[u] = 0u;
    __syncthreads();
    XcdBarrier bar; bar.bar = (unsigned*)(args.ws + WS_CTL) + CW_BAR; bar.x = 0; bar.st = nullptr;
    if (!MK_PER_PHASE) bar = xcd_barrier_post((unsigned*)(args.ws + WS_CTL) + CW_BAR, (volatile LAS unsigned*)(lds + MISC_OFF) + 8);

    for (int st = args.ph_lo; st < args.ph_hi; ++st) {
        int tid = threadIdx.x; asm volatile("" : "+v"(tid));
        int G = gridDim.x, bx = blockIdx.x; asm volatile("" : "+s"(G), "+s"(bx));
        unsigned char* ws = args.ws; asm volatile("" : "+s"(ws));
        const int lane = tid & 63, wave = __builtin_amdgcn_readfirstlane(tid >> 6);
        bf16_t* HX = (bf16_t*)(ws + WS_HX); bf16_t* Yb = (bf16_t*)(ws + WS_Y); bf16_t* MIXb = (bf16_t*)(ws + WS_MIX); bf16_t* BIG = (bf16_t*)(ws + WS_BIG);
        int kind = ST_NOP, l = 0, sub = -1, rw = 0, coff = 0; bool seam = false;
        if (st == 0) { kind = ST_PRO; seam = true; }
        else if (st == 1) { kind = ST_ROW; rw = 0; seam = true; }
        else if (st >= N_STEPS) { seam = true; }
        else { l = (st - 2) / STEPS_PER_LAYER; sub = (st - 2) % STEPS_PER_LAYER; }
        const bool even = (l & 1) == 0; const int eo = l >> 1;
        const bool ctx_live = l < 2;
        const int nrows = ctx_live ? MT : MX, nMt = nrows / 256;
        gm::Call C{}; C.G = G;
        if (sub == 0) {
            kind = ST_GEMM; C.K = DM; C.lda = DM; C.ldb = DM;
            if (even) C.j0 = gm::Job{HX, (const bf16_t*)(ws + WS_WIN + eo * SZ_WIN), BIG, (const float*)(ws + WS_TAB), nullptr, nMt, ATT_IN / 256, gm::K_ROPE, ATT_IN, 0, 0, 0, 0, 1, nullptr};
            else C.j0 = gm::Job{(const bf16_t*)(ws + WS_WMI + eo * SZ_WMI) + (size_t)512 * DM, HX, ws + WS_VT, nullptr, ws + WS_VTC, 4, nMt, gm::K_VT, 0, 0, 0, 0, 0, 1, nullptr};
        } else if (sub == 1) {
            seam = true; C.K = DM; C.lda = DM; C.ldb = DM;
            if (!even) { kind = ST_GEMM; coff = (4 * nMt) % G; C.j0 = gm::Job{HX, (const bf16_t*)(ws + WS_WMI + eo * SZ_WMI), ws + WS_UPOOL, nullptr, nullptr, nMt, 2, gm::K_PLAIN, 512, 0, 0, 0, 0, 1, nullptr}; }
            else if (l == 2) { kind = ST_GEMM; coff = (64 * 9) % G;
                C.j0 = gm::Job{HX + (size_t)MX * DM, (const bf16_t*)(ws + WS_WIN + eo * SZ_WIN) + (size_t)512 * DM, BIG, (const float*)(ws + WS_TAB), nullptr, MC / 256, 1, gm::K_ROPE, ATT_IN, MX, 512, 0, 0, 1, nullptr}; }
        } else if (sub == 2) {
            if (even) { kind = ST_ATT; seam = true; }
            else { kind = ST_GEMM; C.K = SEQ; C.lda = 2 * SEQ; C.ldb = 2 * SEQ;
                C.j0 = gm::Job{(const bf16_t*)(ws + WS_FMAT), (const bf16_t*)(ws + WS_VT), MIXb, nullptr, nullptr, 8, 16, gm::K_DFT, KMO, 0, 512, 8, 0, 1, nullptr}; }
        } else if (sub == 3) {
            if (!even) { kind = ST_GEMM; coff = 128 % G; C.K = SEQ; C.lda = 2 * SEQ; C.ldb = 2 * SEQ;
                C.j0 = gm::Job{(const bf16_t*)(ws + WS_FMAT) + SEQ, (const bf16_t*)(ws + WS_VT) + SEQ, MIXb, nullptr, nullptr, 8, 16, gm::K_DFT, KMO, 0, 1024, 8, 0, 1, nullptr}; }
        } else if (sub == 4) {
            if (!even && ctx_live) { kind = ST_GEMM; C.K = CTXL; C.lda = 2 * CTXL; C.ldb = 2 * CTXL;
                C.j0 = gm::Job{(const bf16_t*)(ws + WS_FC), (const bf16_t*)(ws + WS_VTC), MIXb, nullptr, nullptr, 1, 16, gm::K_DFT, KMO, MX, 512, 1, 0, 1, nullptr}; }
        } else if (sub == 5) {
            if (!even && ctx_live) { kind = ST_GEMM; coff = 16 % G; C.K = CTXL; C.lda = 2 * CTXL; C.ldb = 2 * CTXL;
                C.j0 = gm::Job{(const bf16_t*)(ws + WS_FC) + CTXL, (const bf16_t*)(ws + WS_VTC) + CTXL, MIXb, nullptr, nullptr, 1, 16, gm::K_DFT, KMO, MX, 1024, 1, 0, 1, nullptr}; }
        } else if (sub == 6) {
            if (!even) { kind = ST_POOL; seam = true; }
        } else if (sub == 7) {
            kind = ST_GEMM; seam = true; C.lda = KMO;
            if (even) { C.K = DM; C.ldb = DM; C.j0 = gm::Job{MIXb, (const bf16_t*)(ws + WS_WOUT + eo * SZ_WOUT), Yb, nullptr, nullptr, MX / 256, 4, gm::K_PLAIN, DM, 0, 0, 0, nMt - MX / 256, SL_OUT, (float*)(ws + WS_BIG)}; }
            else { C.K = KMO; C.ldb = KMO; C.j0 = gm::Job{MIXb, (const bf16_t*)(ws + WS_WMO + eo * SZ_WMO), Yb, nullptr, nullptr, MX / 256, 4, gm::K_PLAIN, DM, 0, 0, 0, nMt - MX / 256, SL_OUT, (float*)(ws + WS_BIG)}; }
        } else if (sub == 8) { kind = ST_ROW; rw = 1; seam = true; }
        else if (sub == 9) {
            kind = ST_GEMM; seam = true; C.K = DM; C.lda = DM; C.ldb = DM;
            C.j0 = gm::Job{HX, (const bf16_t*)(ws + WS_WUP + l * SZ_WUP), BIG, args.in[16] + (size_t)l * 3 * DFF, ws + WS_SIDE, nMt, NUP / 256, gm::K_FFN, DFF, 0, 0, 0, 0, 1, nullptr};
        } else if (sub == 10) { kind = ST_FIX; seam = true; }
        else if (sub == 11) {
            kind = ST_GEMM; seam = true; C.K = DFF; C.lda = DFF; C.ldb = DFF;
            C.j0 = gm::Job{BIG, (const bf16_t*)(ws + WS_WDN + l * SZ_WDN), Yb, nullptr, nullptr, MX / 256, 4, gm::K_PLAIN, DM, 0, 0, 0, nMt - MX / 256, SL_DN, (float*)(ws + WS_MIX)};
        } else if (sub == 12) { kind = ST_ROW; rw = 2; seam = true; }
        C.c = bx >= coff ? bx - coff : bx - coff + G;

        if (kind == ST_GEMM) {
            gm::gemm_phase(lds, C, tid);
            const bool hostA = (sub == 0 && even && l + 1 < DEPTH), hostB = (sub == 9 && l + 1 < DEPTH);
            if (hostA || hostB) {
                const int total = C.j0.nM * C.j0.nN, rem = total % G;
                const int rk = rem ? C.c - rem : C.c, n = rem ? G - rem : G;
                if (rk >= 0) { if (hostA) fold_layer(lds, args, l >> 1, rk, n, tid); else tr_layer(lds, args, l + 1, rk * NWAVES + wave, n * NWAVES, lane, wave); __syncthreads(); }
            }
        }
        else if (kind == ST_PRO) prologue_a(lds, args, tid, lane, wave, G);
        else if (kind == ST_ROW) row_phase(args, l, rw, rw == 0 ? MT : nrows, lane, bx * NWAVES + wave, G * NWAVES);
        else if (kind == ST_ATT) {
            const float* sink = args.in[8] + eo * 8;
            for (int u = bx; u < 512 + (l == 0 ? 64 : 0); u += G) {
                if (u < 512) { const int bh = u >> 5, i = u & 31, b = bh >> 1, hk = bh & 1; attn_unit(lds, BIG, MIXb, sink, b, hk, b * SEQ + 64 * i, 64 * i, true, tid); }
                else { const int v = u - 512, bh = v >> 2, i = v & 3, b = bh >> 1, hk = bh & 1; attn_unit(lds, BIG, MIXb, sink, b, hk, MX + b * CTXL + 64 * i, 0, false, tid); }
            }
            sconv_pass(args, eo, nrows, bx * NTHR + tid, G * NTHR);
        }
        else if (kind == ST_POOL) pool_pass(args, nrows, bx * NTHR + tid, G * NTHR);
        else if (kind == ST_FIX) ffn_fixup(args, l, nrows, bx * NTHR + tid, G * NTHR);
        if (!MK_PER_PHASE && seam && st + 1 < args.ph_hi) xcd_barrier(bar);
    }
}

extern "C" void kernel_launch(void* const* d_in, const int* in_sizes, int n_in, void* d_out, int out_size, void* d_ws, size_t ws_size, hipStream_t stream) {
    static int grid = 0;
    if (grid == 0) {
        if (n_in != 18 || out_size != MX * DM || ws_size < WS_END) { fprintf(stderr, "kernel_launch: unexpected shapes (n_in %d, out %d, ws %zu)\n", n_in, out_size, ws_size); grid = -1; return; }
        int dev = 0, cus = 0;
        if (hipGetDevice(&dev) != hipSuccess || hipDeviceGetAttribute(&cus, hipDeviceAttributeMultiprocessorCount, dev) != hipSuccess) { grid = -1; return; }
        if (hipFuncSetAttribute((const void*)dit_fwd, hipFuncAttributeMaxDynamicSharedMemorySize, LDS_BYTES) != hipSuccess) { grid = -1; return; }
        (void)hipGetLastError();
        grid = cus;
    }
    if (grid < 0) return;
    if (hipMemsetAsync((char*)d_ws + WS_CTL, 0, CTL_ZERO_BYTES, stream) != hipSuccess) return;
    Args a{};
    for (int i = 0; i < 18; ++i) a.in[i] = (const float*)d_in[i];
    a.out = (float*)d_out; a.ws = (unsigned char*)d_ws;
#if MK_PER_PHASE
    for (int p = 0; p < N_STEPS; ++p) { a.ph_lo = p; a.ph_hi = p + 1; hipLaunchKernelGGL(dit_fwd, dim3(grid), dim3(NTHR), LDS_BYTES, stream, a); }
#else
    a.ph_lo = 0; a.ph_hi = N_STEPS;
    hipLaunchKernelGGL(dit_fwd, dim3(grid), dim3(NTHR), LDS_BYTES, stream, a);
#if PROBE_CLASS
    for (int r = 0; r < PROBE_REPS; ++r)
        for (int l = 0; l < DEPTH; ++l) {
            const int base = 2 + STEPS_PER_LAYER * l; const bool ev = (l & 1) == 0;
            int lo = -1, hi = -1;
            switch (PROBE_CLASS) {
                case 1: lo = base + 9; hi = lo + 1; break;
                case 2: lo = base + 11; hi = lo + 1; break;
                case 3: lo = base + 0; hi = base + 2; break;
                case 4: lo = base + 7; hi = lo + 1; break;
                case 5: if (ev) { lo = base + 2; hi = lo + 1; } break;
                case 6: if (!ev) { lo = base + 2; hi = base + 7; } break;
                case 7: if (l == 0) { lo = 0; hi = 1; } break;
                case 8: lo = 1; hi = 2; break;
                case 9: lo = base + 10; hi = lo + 1; break;
                case 10: lo = 2 + 3; hi = lo + 1; break;
                case 11: lo = base + 8; hi = lo + 1; a.dry = 1; break;
                case 12: lo = base + 12; hi = lo + 1; a.dry = 1; break;
                case 13: lo = N_STEPS; hi = N_STEPS + 9; break;
            }
            if (lo >= 0) { a.ph_lo = lo; a.ph_hi = hi; hipLaunchKernelGGL(dit_fwd, dim3(grid), dim3(NTHR), LDS_BYTES, stream, a); }
        }
#endif
#endif
}
```

```cpp
#include <hip/hip_runtime.h>
#include <cstdio>
#include <cstdint>

#ifndef MK_PER_PHASE
#define MK_PER_PHASE 0
#endif

#ifndef PROBE_CLASS
#define PROBE_CLASS 0
#endif
#define PROBE_REPS 3
#define GAS __attribute__((address_space(1)))
#define LAS __attribute__((address_space(3)))
typedef unsigned short bf16_t;
typedef short bf16x8 __attribute__((ext_vector_type(8)));
typedef float f32x4 __attribute__((ext_vector_type(4)));
typedef float f32x16 __attribute__((ext_vector_type(16)));
typedef unsigned u32x4 __attribute__((ext_vector_type(4)));
typedef unsigned u32x2 __attribute__((ext_vector_type(2)));
typedef GAS unsigned gu32;
#define RLX_AGENT __ATOMIC_RELAXED, __HIP_MEMORY_SCOPE_AGENT
#define LDS_WAIT() asm volatile("s_waitcnt lgkmcnt(0)" ::: "memory")
#define VM_WAIT() asm volatile("s_waitcnt vmcnt(0)" ::: "memory")

constexpr int DM = 1024, NBATCH = 8, SEQ = 2048, CTXL = 256, DEPTH = 4;
constexpr int MX = NBATCH * SEQ, MC = NBATCH * CTXL, MT = MX + MC;
constexpr int ATT_IN = 2304, DFF = 2816, NUP = 2 * DFF, KMO = 1536;
constexpr float EPS = 1e-6f;
constexpr float QSCALE = 0.125f * 1.4426950408889634f;
constexpr float LOG2E = 1.4426950408889634f;
constexpr int NWAVES = 8, NTHR = 512;

constexpr size_t MiB = 1u << 20;
constexpr size_t WS_CTL = 0, CTL_ZERO_BYTES = 1 * MiB;
constexpr size_t WS_MODX = 1 * MiB, WS_MODC = WS_MODX + (size_t)4 * 8 * 6144 * 4;
constexpr size_t WS_TAB = 2 * MiB;
constexpr size_t WS_WIN = 4 * MiB, SZ_WIN = (size_t)ATT_IN * DM * 2;
constexpr size_t WS_WOUT = 13 * MiB, SZ_WOUT = (size_t)DM * DM * 2;
constexpr size_t WS_WMI = 17 * MiB, SZ_WMI = (size_t)1536 * DM * 2;
constexpr size_t WS_WMO = 23 * MiB, SZ_WMO = (size_t)DM * KMO * 2;
constexpr size_t WS_WUP = 29 * MiB, SZ_WUP = (size_t)NUP * DM * 2;
constexpr size_t WS_WDN = 73 * MiB, SZ_WDN = (size_t)DM * DFF * 2;
constexpr size_t WS_FMAT = 96 * MiB;
constexpr size_t WS_FC = 112 * MiB;
constexpr size_t WS_HCTX = 113 * MiB;
constexpr size_t WS_HX = 122 * MiB;
constexpr size_t WS_Y = 158 * MiB;
constexpr size_t WS_BIG = 194 * MiB;
constexpr size_t WS_UPOOL = WS_BIG, WS_VT = WS_BIG + 20 * MiB, WS_VTC = WS_BIG + 52 * MiB;
constexpr size_t WS_MIX = 293 * MiB;
constexpr size_t WS_SIDE = 348 * MiB;
constexpr size_t WS_END = 368 * MiB;
constexpr int CW_BAR = 4096;
constexpr int SL_OUT = 4, SL_DN = 6;

constexpr int RING_BYTES = 131072, LDSCTL_OFF = RING_BYTES, MISC_OFF = LDSCTL_OFF + 320, LDS_BYTES = 147456;
constexpr int LDS_COSTAB = 122880;

__device__ __forceinline__ unsigned cvt_pk_bf16(float lo, float hi) { unsigned r; asm("v_cvt_pk_bf16_f32 %0, %1, %2" : "=v"(r) : "v"(lo), "v"(hi)); return r; }
__device__ __forceinline__ float bf_lo(unsigned w) { return __uint_as_float(w << 16); }
__device__ __forceinline__ float bf_hi(unsigned w) { return __uint_as_float(w & 0xffff0000u); }
__device__ __forceinline__ float wave_sum(float v) {
#pragma unroll
    for (int o = 1; o < 64; o <<= 1) v += __shfl_xor(v, o);
    return v;
}
__device__ __forceinline__ float silu_f(float x) { return x * __builtin_amdgcn_rcpf(1.0f + __builtin_amdgcn_exp2f(-x * LOG2E)); }

#define XB_TMO      128
#define XB_XCNT(j)  (256  + 64 * (j))
#define XB_XSUB(j)  (1280 + 64 * (j))
#define XB_XGEN(j)  (2304 + 64 * (j))
#define XB_TOP      3328
#define XB_TOPGEN   3392
#define XCD_BAR_WORDS 3456
#define XB_SPIN_CAP (1u << 18)
__device__ __forceinline__ unsigned xb_ld(unsigned* p)              { return __hip_atomic_load(p, __ATOMIC_RELAXED, __HIP_MEMORY_SCOPE_AGENT); }
__device__ __forceinline__ unsigned xb_add(unsigned* p, unsigned v) { return __hip_atomic_fetch_add(p, v, __ATOMIC_RELAXED, __HIP_MEMORY_SCOPE_AGENT); }
__device__ __forceinline__ unsigned xb_xcc_id() { return (unsigned)__builtin_amdgcn_s_getreg((3 << 11) | 20) & 0xFu; }
#define XB_SPIN(cond, bar) do { unsigned _sp = 0; while (cond) { __builtin_amdgcn_s_sleep(1); \
    if ((++_sp & 255u) == 0u) { if (xb_ld(&(bar)[XB_TMO])) break; if (_sp > XB_SPIN_CAP) { atomicAdd(&(bar)[XB_TMO], 1u); break; } } } } while (0)
struct XcdBarrier { unsigned* bar; unsigned x; volatile LAS unsigned* st; };
__device__ __forceinline__ XcdBarrier xcd_barrier_post(unsigned* bar, volatile LAS unsigned* st) {
    XcdBarrier b; b.bar = bar; b.x = xb_xcc_id(); b.st = st;
    if (threadIdx.x == 0) (void)xb_add(&bar[XB_XCNT(b.x)], 1u);
    return b;
}
__device__ __forceinline__ void xcd_barrier_complete(unsigned* bar, unsigned x, unsigned& nloc, unsigned& nx) {
    const unsigned G = gridDim.x * gridDim.y * gridDim.z;
    unsigned sum, cnt, mine, sp = 0u;
    for (;;) {
        sum = 0u; cnt = 0u; mine = 0u;
#pragma unroll
        for (unsigned j = 0; j < 16; ++j) { const unsigned c = xb_ld(&bar[XB_XCNT(j)]); sum += c; cnt += (c > 0u) ? 1u : 0u; mine = (j == x) ? c : mine; }
        if (sum == G) break;
        __builtin_amdgcn_s_sleep(1);
        if ((++sp & 255u) == 0u) { if (xb_ld(&bar[XB_TMO])) break; if (sp > XB_SPIN_CAP) { atomicAdd(&bar[XB_TMO], 1u); break; } }
    }
    nloc = mine > 0u ? mine : 1u; nx = cnt > 0u ? cnt : 1u;
}
__device__ __forceinline__ void xcd_barrier(const XcdBarrier& b) {
    asm volatile("s_waitcnt vmcnt(0)" ::: "memory");
    __syncthreads();
    if (threadIdx.x == 0) {
        unsigned* bar = b.bar; asm volatile("" : "+s"(bar));
        __builtin_amdgcn_s_waitcnt(0);
        unsigned nloc = b.st[0], nx = b.st[1];
        if (nloc == 0u) { xcd_barrier_complete(bar, b.x, nloc, nx); b.st[0] = nloc; b.st[1] = nx; }
        const unsigned old = xb_add(&bar[XB_XSUB(b.x)], 1u);
        const unsigned gen = old / nloc;
        if (old + 1u == (gen + 1u) * nloc) {
            __builtin_amdgcn_fence(__ATOMIC_RELEASE, "agent");
            asm volatile("s_waitcnt vmcnt(0)" ::: "memory");
            const unsigned og = xb_add(&bar[XB_TOP], 1u);
            const unsigned tg = og / nx;
            if (og + 1u == (tg + 1u) * nx) xb_add(&bar[XB_TOPGEN], 1u);
            else XB_SPIN(xb_ld(&bar[XB_TOPGEN]) == tg, bar);
            __builtin_amdgcn_fence(__ATOMIC_ACQUIRE, "agent");
            xb_add(&bar[XB_XGEN(b.x)], 1u);
            asm volatile("s_waitcnt vmcnt(0)" ::: "memory");
        } else {
            XB_SPIN(xb_ld(&bar[XB_XGEN(b.x)]) == gen, bar);
            __builtin_amdgcn_fence(__ATOMIC_ACQUIRE, "agent");
            asm volatile("s_waitcnt vmcnt(0)" ::: "memory");
        }
    }
    __syncthreads();
}

namespace gm {
constexpr int BM = 256, BK = 64, HALF = 128, HTB = HALF * BK * 2, NXCD = 8, WGM = 8;
__device__ __forceinline__ int lds_byte(int r, int c) { const int st = (r >> 4) * 2 + (c >> 5), rr = r & 15, cc = c & 31, ob = rr * 64 + cc * 2; return st * 1024 + (ob ^ (((ob >> 9) & 1) << 5)); }
__device__ __forceinline__ void stage_rc(int b, int& R, int& C) { const int st = b / 1024, sb = b % 1024, swz = sb ^ (((sb >> 9) & 1) << 5); R = (st >> 1) * 16 + swz / 64; C = (st & 1) * 32 + (swz % 64) / 2; }
__device__ __forceinline__ int perm32(int rho) { const int n = rho >> 4, i = rho & 15; return 8 * (i >> 2) + 4 * n + (i & 3); }

enum { K_PLAIN = 0, K_DFT = 1, K_ROPE = 2, K_VT = 3, K_FFN = 4 };
struct Job { const bf16_t* A; const bf16_t* B; void* out; const float* aux; void* out2; int nM, nN, kind, ldc, row0, col0, p0; int cM, S; float* slab; };
struct Call { int K, lda, ldb, G, c; Job j0; };
struct Unit { int pm, pn, kp0, np, slice; };

__device__ __forceinline__ void next_unit(const Call& C, int i, int& pm, int& pn, int& kp0, int& np, int& slice) {
    const long L = (long)i * C.G + C.c;
    const int nM = C.j0.nM, nN = C.j0.nN, nwg = nM * nN, P = C.K / (2 * BK);
    const int S = C.j0.S, nsl = C.j0.cM * nN * S;
    pm = -1; pn = 0; kp0 = 0; np = P; slice = -1;
    if (L < nwg) {
        int wgid = (int)L; { const int q = nwg / NXCD, r = nwg % NXCD, xcd = wgid % NXCD, off = wgid / NXCD; wgid = (xcd < r ? xcd * (q + 1) : r * (q + 1) + (xcd - r) * q) + off; }
        const int nig = WGM * nN, gid = wgid / nig, fm = gid * WGM, gsz = (nM - fm) < WGM ? (nM - fm) : WGM;
        pm = fm + ((wgid % nig) % gsz); pn = (wgid % nig) / gsz;
    } else if (L < (long)nwg + nsl) {
        const int Ls = (int)(L - nwg);
        const int tile = Ls / S, sl = Ls - tile * S, base = P / S, rem = P - base * S;
        pm = nM + tile / nN; pn = tile % nN; slice = sl; np = base + (sl < rem ? 1 : 0); kp0 = sl * base + (sl < rem ? sl : rem);
    }
}

__device__ __forceinline__ u32x4 pack8(const f32x4& a, const f32x4& b) { u32x4 w; w.x = cvt_pk_bf16(a[0], a[1]); w.y = cvt_pk_bf16(a[2], a[3]); w.z = cvt_pk_bf16(b[0], b[1]); w.w = cvt_pk_bf16(b[2], b[3]); return w; }

__device__ __forceinline__ void epi_plain(const f32x4 (&acc)[2][2][4][2], const Job& J, int rowt, int colb, int wr, int wc, int fr, int fq) {
    bf16_t* O = (bf16_t*)J.out;
#pragma unroll
    for (int ai = 0; ai < 2; ++ai)
#pragma unroll
        for (int m = 0; m < 4; ++m) {
            bf16_t* rowp = O + (size_t)(rowt + ai * HALF + wr * 64 + m * 16 + fr) * J.ldc + colb + wc * 32 + 8 * fq;
#pragma unroll
            for (int bj = 0; bj < 2; ++bj) *(u32x4*)(rowp + bj * HALF) = pack8(acc[ai][bj][m][0], acc[ai][bj][m][1]);
        }
}
__device__ __forceinline__ void epi_rope(const f32x4 (&acc)[2][2][4][2], const Job& J, int rowt, int colb, int wr, int wc, int fr, int fq) {
    bf16_t* O = (bf16_t*)J.out; const float* TC = J.aux; const float* TS = J.aux + 1024;
    const bool anyrope = (rowt < MX) && (colb < 640); const int half = wc & 1, j0 = 8 * (fq & 1); const float sgn = fq < 2 ? -1.f : 1.f;
#pragma unroll
    for (int ai = 0; ai < 2; ++ai)
#pragma unroll
        for (int m = 0; m < 4; ++m) {
            const int grow = rowt + ai * HALF + wr * 64 + m * 16 + fr;
            f32x4 c0 = {1.f, 1.f, 1.f, 1.f}, c1 = c0, s0 = {0.f, 0.f, 0.f, 0.f}, s1 = s0;
            if (anyrope) {
                const int t = grow & (SEQ - 1), pos = half ? (t & 63) : (t >> 6);
                c0 = *(const f32x4*)(TC + pos * 16 + j0); c1 = *(const f32x4*)(TC + pos * 16 + j0 + 4);
                s0 = *(const f32x4*)(TS + pos * 16 + j0); s1 = *(const f32x4*)(TS + pos * 16 + j0 + 4);
            }
#pragma unroll
            for (int bj = 0; bj < 2; ++bj) {
                const int cs = colb + bj * HALF; const bool isq = cs < 512, isk = (cs >= 512) && (cs < 640);
                f32x4 v0 = acc[ai][bj][m][0], v1 = acc[ai][bj][m][1];
                if ((isq || isk) && anyrope) {
                    f32x4 p0, p1;
#pragma unroll
                    for (int e = 0; e < 4; ++e) { p0[e] = __shfl_xor(v0[e], 32); p1[e] = __shfl_xor(v1[e], 32); }
                    v0 = v0 * c0 + (p0 * sgn) * s0; v1 = v1 * c1 + (p1 * sgn) * s1;
                }
                if (isq) { v0 = v0 * QSCALE; v1 = v1 * QSCALE; }
                *(u32x4*)(O + (size_t)grow * J.ldc + cs + wc * 32 + 8 * fq) = pack8(v0, v1);
            }
            asm volatile("" ::: "memory");
        }
}
__device__ __forceinline__ void epi_vt(const f32x4 (&acc)[2][2][4][2], const Job& J, int pm, int pn, int wr, int wc, int fr, int fq) {
    const int s = pm >> 1, c0 = (pm & 1) * 256;
    bf16_t* base; size_t cstride;
    if (pn < MX / 256) { const int b = pn >> 3, t0 = (pn & 7) * 256; base = (bf16_t*)J.out + ((size_t)(b * 512) * 2 + s) * SEQ + t0; cstride = 2 * SEQ; }
    else { const int b = pn - MX / 256; base = (bf16_t*)J.out2 + ((size_t)(b * 512) * 2 + s) * CTXL; cstride = 2 * CTXL; }
#pragma unroll
    for (int ai = 0; ai < 2; ++ai)
#pragma unroll
        for (int m = 0; m < 4; ++m) {
            bf16_t* rowp = base + (size_t)(c0 + ai * HALF + wr * 64 + m * 16 + fr) * cstride + wc * 32 + 8 * fq;
#pragma unroll
            for (int bj = 0; bj < 2; ++bj) *(u32x4*)(rowp + bj * HALF) = pack8(acc[ai][bj][m][0], acc[ai][bj][m][1]);
        }
}
__device__ __forceinline__ void epi_ffn(const f32x4 (&acc)[2][2][4][2], const Job& J, int rowt, int pn, int wr, int wc, int fr, int fq, int lane) {
    bf16_t* O = (bf16_t*)J.out; float* SIDE = (float*)J.out2; const float* cw = J.aux;
    const int col = 128 * pn + 32 * wc + 8 * fq;
    f32x4 w0[2], w1[2], w2[2];
#pragma unroll
    for (int n = 0; n < 2; ++n) { w0[n] = *(const f32x4*)(cw + col + 4 * n); w1[n] = *(const f32x4*)(cw + DFF + col + 4 * n); w2[n] = *(const f32x4*)(cw + 2 * DFF + col + 4 * n); }
    const int srcdn = (lane & 48) | ((fr + 15) & 15), srcup = (lane & 48) | ((fr + 1) & 15);
#pragma unroll
    for (int ai = 0; ai < 2; ++ai) {
        const int blk = (rowt + ai * HALF + wr * 64) >> 6;
        f32x4 cv[4][2];
#pragma unroll
        for (int n = 0; n < 2; ++n)
#pragma unroll
            for (int e = 0; e < 4; ++e) {
                float g[4], dn[4], up[4];
#pragma unroll
                for (int m = 0; m < 4; ++m) { g[m] = acc[ai][0][m][n][e]; dn[m] = __shfl(g[m], srcdn); up[m] = __shfl(g[m], srcup); }
#pragma unroll
                for (int m = 0; m < 4; ++m) {
                    const float pv = fr > 0 ? dn[m] : (m > 0 ? dn[m - 1] : 0.f);
                    const float nx = fr < 15 ? up[m] : (m < 3 ? up[m + 1] : 0.f);
                    cv[m][n][e] = w0[n][e] * pv + w1[n][e] * g[m] + w2[n][e] * nx;
                }
            }
#pragma unroll
        for (int m = 0; m < 4; ++m) {
            const int grow = rowt + ai * HALF + wr * 64 + m * 16 + fr;
            const bool first = (m == 0 && fr == 0), last = (m == 3 && fr == 15);
            if (first || last) {
                float* sp = SIDE + ((size_t)(blk * 2 + (last ? 1 : 0)) * 3) * DFF + col;
#pragma unroll
                for (int n = 0; n < 2; ++n) { *(f32x4*)(sp + 4 * n) = cv[m][n]; *(f32x4*)(sp + DFF + 4 * n) = acc[ai][0][m][n]; *(f32x4*)(sp + 2 * DFF + 4 * n) = acc[ai][1][m][n]; }
            } else {
                f32x4 a0, a1;
#pragma unroll
                for (int e = 0; e < 4; ++e) { a0[e] = silu_f(cv[m][0][e]) * acc[ai][1][m][0][e]; a1[e] = silu_f(cv[m][1][e]) * acc[ai][1][m][1][e]; }
                *(u32x4*)(O + (size_t)grow * DFF + col) = pack8(a0, a1);
            }
        }
    }
}
__device__ __forceinline__ void epi_slab(const f32x4 (&acc)[2][2][4][2], const Job& J, const Unit& u, int wr, int wc, int fr, int fq) {
    const int ld = J.nN * BM;
    float* O = J.slab + ((size_t)u.slice * J.cM * BM + (size_t)(u.pm - J.nM) * BM) * ld + u.pn * BM;
#pragma unroll
    for (int ai = 0; ai < 2; ++ai)
#pragma unroll
        for (int m = 0; m < 4; ++m) {
            float* rowp = O + (size_t)(ai * HALF + wr * 64 + m * 16 + fr) * ld + wc * 32 + 8 * fq;
#pragma unroll
            for (int bj = 0; bj < 2; ++bj) { *(f32x4*)(rowp + bj * HALF) = acc[ai][bj][m][0]; *(f32x4*)(rowp + bj * HALF + 4) = acc[ai][bj][m][1]; }
        }
}
__device__ __forceinline__ void epilogue(const f32x4 (&acc)[2][2][4][2], const Call& C, const Unit& u, int wr, int wc, int fr_, int fq_, int lane) {
    asm volatile("" : "+v"(lane));
    const int fr = lane & 15, fq = lane >> 4;
    const Job& J = C.j0;
    if (u.slice >= 0) epi_slab(acc, J, u, wr, wc, fr, fq);
    else if (J.kind == K_PLAIN) epi_plain(acc, J, J.row0 + u.pm * BM, J.col0 + u.pn * BM, wr, wc, fr, fq);
    else if (J.kind == K_DFT) epi_plain(acc, J, J.row0 + ((u.pn >> 1) * J.p0 + u.pm) * BM, J.col0 + (u.pn & 1) * BM, wr, wc, fr, fq);
    else if (J.kind == K_ROPE) epi_rope(acc, J, J.row0 + u.pm * BM, J.col0 + u.pn * BM, wr, wc, fr, fq);
    else if (J.kind == K_VT) epi_vt(acc, J, u.pm, u.pn, wr, wc, fr, fq);
    else epi_ffn(acc, J, J.row0 + u.pm * BM, u.pn, wr, wc, fr, fq, lane);
}

__device__ __forceinline__ void gemm_phase(LAS unsigned char* lds, const Call& C, const int tid) {
    const int wid = __builtin_amdgcn_readfirstlane(tid >> 6), lane = tid & 63, wr = wid >> 2, wc = wid & 3, fr = lane & 15, fq = lane >> 4;
    unsigned voffA[2], voffB[2];
#pragma unroll
    for (int i = 0; i < 2; ++i) { int R, Cc; stage_rc(tid * 16 + i * 8192, R, Cc); const int Rb = (R & ~31) + perm32(R & 31);
        voffA[i] = (unsigned)(R * C.lda + Cc) * 2u; voffB[i] = (unsigned)(Rb * C.ldb + Cc) * 2u; }
    const size_t kstep = (size_t)(BK * 2);
    const size_t hstepA = (size_t)HALF * C.lda * 2, hstepB = (size_t)HALF * C.ldb * 2;
    const unsigned ldsw = (unsigned)wid * 1024u;
    const int aoff = lds_byte(wr * 64 + fr, fq * 8), boff = lds_byte(wc * 32 + fr, fq * 8);
#define PG8_SA(b, h) (((b) * 2 + (h)) * HTB)
#define PG8_SB(b, h) ((4 + (b) * 2 + (h)) * HTB)
#define PG8_STAGE(bufoff, gbase, voff) do { _Pragma("unroll") for (int _i = 0; _i < 2; ++_i) { unsigned _vo = (voff)[_i]; asm volatile("" : "+v"(_vo));   \
        __builtin_amdgcn_global_load_lds((const unsigned*)((const char*)(gbase) + _vo), (LAS unsigned*)(lds + (bufoff) + ldsw + _i * 8192), 16, 0, 0); } } while (0)
#define PG8_LDA(dst, b, h) do { _Pragma("unroll") for (int m = 0; m < 4; ++m) _Pragma("unroll") for (int k = 0; k < 2; ++k) dst[m][k] = *(const LAS bf16x8*)(lds + PG8_SA(b, h) + aoff + m * 2048 + k * 1024); } while (0)
#define PG8_LDB(dst, b, h) do { _Pragma("unroll") for (int n = 0; n < 2; ++n) _Pragma("unroll") for (int k = 0; k < 2; ++k) dst[n][k] = *(const LAS bf16x8*)(lds + PG8_SB(b, h) + boff + n * 2048 + k * 1024); } while (0)
#define PG8_MMA(ai, bj, At, Bt) do { __builtin_amdgcn_s_setprio(1); _Pragma("unroll") for (int m = 0; m < 4; ++m) _Pragma("unroll") for (int n = 0; n < 2; ++n) _Pragma("unroll") for (int k = 0; k < 2; ++k) \
        acc[ai][bj][m][n] = __builtin_amdgcn_mfma_f32_16x16x32_bf16(Bt[n][k], At[m][k], acc[ai][bj][m][n], 0, 0, 0); __builtin_amdgcn_s_setprio(0); } while (0)
#define PG8_WAIT_V(n) asm volatile("s_waitcnt vmcnt(" #n ")" ::: "memory")
#define PG8_WAIT_L(n) asm volatile("s_waitcnt lgkmcnt(" #n ")" ::: "memory")
#define PG8_BAR __builtin_amdgcn_s_barrier()
#define PG8_SCHED __builtin_amdgcn_sched_barrier(0)
#define PG8_APTR(u) ((const char*)C.j0.A + (size_t)(u).pm * 2 * hstepA + (size_t)(u).kp0 * (4 * BK))
#define PG8_BPTR(u) ((const char*)C.j0.B + (size_t)(u).pn * 2 * hstepB + (size_t)(u).kp0 * (4 * BK))
    Unit cur, nxt; int ui = 0;
    next_unit(C, 0, cur.pm, cur.pn, cur.kp0, cur.np, cur.slice);
    if (cur.pm < 0) return;
    f32x4 acc[2][2][4][2];
#pragma unroll
    for (int a = 0; a < 2; ++a)
#pragma unroll
        for (int b = 0; b < 2; ++b)
#pragma unroll
            for (int m = 0; m < 4; ++m)
#pragma unroll
                for (int n = 0; n < 2; ++n) acc[a][b][m][n] = (f32x4){0.f, 0.f, 0.f, 0.f};
    bf16x8 At[4][2], B0[2][2], B1[2][2];
    const char* cA = PG8_APTR(cur); const char* cB = PG8_BPTR(cur);
    PG8_STAGE(PG8_SB(0, 0), cB, voffB); PG8_STAGE(PG8_SB(0, 1), cB + hstepB, voffB); PG8_STAGE(PG8_SA(0, 0), cA, voffA); PG8_STAGE(PG8_SA(0, 1), cA + hstepA, voffA);
    if (wr == 1) PG8_BAR;
    PG8_WAIT_V(2); PG8_BAR;
    PG8_STAGE(PG8_SB(1, 0), cB + kstep, voffB); PG8_STAGE(PG8_SA(1, 0), cA + kstep, voffA); PG8_STAGE(PG8_SB(1, 1), cB + hstepB + kstep, voffB);
    PG8_WAIT_V(6); PG8_BAR;
    for (;;) {
        next_unit(C, ui + 1, nxt.pm, nxt.pn, nxt.kp0, nxt.np, nxt.slice);
        const bool has_next = nxt.pm >= 0;
        const char* nA = has_next ? PG8_APTR(nxt) : cA; const char* nB = has_next ? PG8_BPTR(nxt) : cB;
        const int nt = 2 * cur.np;
        for (int t = 0; t < nt; t += 2) {
            const bool last = (t == nt - 2);
            const char* a1 = cA + (size_t)(t + 1) * kstep;
            const char* a2 = last ? nA : cA + (size_t)(t + 2) * kstep; const char* b2 = last ? nB : cB + (size_t)(t + 2) * kstep;
            const char* a3 = a2 + kstep; const char* b3 = b2 + kstep;
            PG8_LDB(B0, 0, 0); PG8_LDB(B1, 0, 1); PG8_SCHED; PG8_LDA(At, 0, 0); PG8_STAGE(PG8_SA(1, 1), a1 + hstepA, voffA);
            PG8_WAIT_V(8); PG8_WAIT_L(0); PG8_BAR; PG8_MMA(0, 0, At, B0); PG8_MMA(0, 1, At, B1); PG8_BAR; PG8_SCHED;
            PG8_LDA(At, 0, 1); PG8_STAGE(PG8_SB(0, 0), b2, voffB); PG8_STAGE(PG8_SB(0, 1), b2 + hstepB, voffB); PG8_STAGE(PG8_SA(0, 0), a2, voffA);
            PG8_WAIT_V(8); PG8_WAIT_L(0); PG8_BAR; PG8_MMA(1, 0, At, B0); PG8_MMA(1, 1, At, B1); PG8_BAR; PG8_SCHED;
            PG8_LDB(B0, 1, 0); PG8_LDB(B1, 1, 1); PG8_SCHED; PG8_LDA(At, 1, 0); PG8_STAGE(PG8_SA(0, 1), a2 + hstepA, voffA);
            PG8_WAIT_V(8); PG8_WAIT_L(0); PG8_BAR; PG8_MMA(0, 0, At, B0); PG8_MMA(0, 1, At, B1); PG8_BAR; PG8_SCHED;
            PG8_LDA(At, 1, 1); PG8_STAGE(PG8_SB(1, 0), b3, voffB); PG8_STAGE(PG8_SB(1, 1), b3 + hstepB, voffB); PG8_STAGE(PG8_SA(1, 0), a3, voffA);
            PG8_WAIT_V(8); PG8_WAIT_L(0); PG8_BAR; PG8_MMA(1, 0, At, B0); PG8_MMA(1, 1, At, B1); PG8_BAR; PG8_SCHED;
        }
        if (wr == 0) PG8_BAR;
        epilogue(acc, C, cur, wr, wc, fr, fq, lane);
        if (!has_next) break;
#pragma unroll
        for (int a = 0; a < 2; ++a)
#pragma unroll
            for (int b = 0; b < 2; ++b)
#pragma unroll
                for (int m = 0; m < 4; ++m)
#pragma unroll
                    for (int n = 0; n < 2; ++n) acc[a][b][m][n] = (f32x4){0.f, 0.f, 0.f, 0.f};
        cur.pm = nxt.pm; cur.pn = nxt.pn; cur.kp0 = nxt.kp0; cur.np = nxt.np; cur.slice = nxt.slice; cA = nA; cB = nB; ++ui;
        if (wr == 1) PG8_BAR;
    }
    PG8_WAIT_V(0);
    PG8_BAR;
#undef PG8_SA
#undef PG8_SB
#undef PG8_STAGE
#undef PG8_LDA
#undef PG8_LDB
#undef PG8_MMA
#undef PG8_WAIT_V
#undef PG8_WAIT_L
#undef PG8_BAR
#undef PG8_SCHED
#undef PG8_APTR
#undef PG8_BPTR
}
}

__device__ __forceinline__ void tr_item(const float* src, int ldn, bf16_t* dst, bf16_t* dst2, int ldk, LAS float* scr, int lane) {
    f32x4 v[8]; const int r8 = lane >> 3, c4 = lane & 7;
#pragma unroll
    for (int i = 0; i < 8; ++i) v[i] = *(const f32x4*)(src + (size_t)(8 * i + r8) * ldn + 4 * c4);
#pragma unroll
    for (int i = 0; i < 8; ++i) { LAS float* w = scr + (8 * i + r8) * 33 + 4 * c4; w[0] = v[i][0]; w[1] = v[i][1]; w[2] = v[i][2]; w[3] = v[i][3]; }
    LDS_WAIT(); asm volatile("" ::: "memory");
    const int c = lane & 7;
#pragma unroll
    for (int j = 0; j < 4; ++j) { const int n = (lane >> 3) + 8 * j; const LAS float* sp = scr + (8 * c) * 33 + n;
        u32x4 o; o.x = cvt_pk_bf16(sp[0 * 33], sp[1 * 33]); o.y = cvt_pk_bf16(sp[2 * 33], sp[3 * 33]); o.z = cvt_pk_bf16(sp[4 * 33], sp[5 * 33]); o.w = cvt_pk_bf16(sp[6 * 33], sp[7 * 33]);
        *(u32x4*)(dst + (size_t)n * ldk + 8 * c) = o; if (dst2) *(u32x4*)(dst2 + (size_t)n * ldk + 8 * c) = o; }
    LDS_WAIT(); asm volatile("" ::: "memory");
}

struct Args { const float* in[18]; float* out; unsigned char* ws; int ph_lo, ph_hi, dry, pad; };

__device__ __forceinline__ void mod_item(LAS unsigned char* lds, const Args& a, int item, int tid) {
    const int l = item >> 6, n0 = 96 * (item & 63);
    const float* cv = a.in[1]; const float* cc = a.in[3]; const float* mw = a.in[4] + (size_t)l * DM * 6144; const float* mb = a.in[5] + l * 6144;
    LAS float* sv = (LAS float*)lds; LAS float* red = (LAS float*)(lds + 40960);
    for (int i = tid; i < 9 * DM; i += NTHR) { const int r = i >> 10, k = i & 1023; const float v = r < 8 ? cv[r * DM + k] : cc[k]; sv[i] = v / (1.0f + __expf(-v)); }
    __syncthreads();
    const int col4 = tid % 24, kg = tid / 24;
    if (kg < 21) {
        f32x4 acc[9];
#pragma unroll
        for (int r = 0; r < 9; ++r) acc[r] = (f32x4){0.f, 0.f, 0.f, 0.f};
#pragma unroll 7
        for (int k = kg; k < DM; k += 21) {
            const f32x4 w = *(const f32x4*)(mw + (size_t)k * 6144 + n0 + 4 * col4);
#pragma unroll
            for (int r = 0; r < 9; ++r) acc[r] += w * sv[r * DM + k];
        }
#pragma unroll
        for (int r = 0; r < 9; ++r)
#pragma unroll
            for (int e = 0; e < 4; ++e) red[(kg * 9 + r) * 96 + 4 * col4 + e] = acc[r][e];
    }
    __syncthreads();
    float* modx = (float*)(a.ws + WS_MODX); float* modc = (float*)(a.ws + WS_MODC);
    for (int idx = tid; idx < 9 * 96; idx += NTHR) {
        const int r = idx / 96, n = idx % 96; float s = mb[n0 + n];
        for (int g = 0; g < 21; ++g) s += red[(g * 9 + r) * 96 + n];
        if (r < 8) modx[((size_t)(l * 8 + r)) * 6144 + n0 + n] = s; else modc[(size_t)l * 6144 + n0 + n] = s;
    }
    __syncthreads();
}

__device__ __forceinline__ void fold_in_item(LAS unsigned char* lds, const Args& a, int item, int tid) {
    const int o = item >> 6, g = (item >> 4) & 3, kc = item & 15;
    const float* W = a.in[11] + (size_t)o * DM * DM; bf16_t* WMI = (bf16_t*)(a.ws + WS_WMI + o * SZ_WMI);
    LAS float* Wl = (LAS float*)lds; const LAS float* tab = (const LAS float*)(lds + LDS_COSTAB);
    LAS float* tc = (LAS float*)(lds + 64 * 129 * 4); LAS float* ts = tc + 128;
    if (tid < 128) { tc[tid] = tab[16 * tid]; ts[tid] = tab[(16 * tid - 512) & 2047]; }
    {   f32x4 t[4];
#pragma unroll
        for (int i = 0; i < 4; ++i) { const int idx = tid + NTHR * i, kk = idx >> 5, j4 = idx & 31; t[i] = *(const f32x4*)(W + (size_t)(64 * kc + kk) * DM + 512 + 128 * g + 4 * j4); }
#pragma unroll
        for (int i = 0; i < 4; ++i) { const int idx = tid + NTHR * i, kk = idx >> 5, j4 = idx & 31; LAS float* w = Wl + kk * 129 + 4 * j4; w[0] = t[i][0]; w[1] = t[i][1]; w[2] = t[i][2]; w[3] = t[i][3]; } }
    __syncthreads();
    const int lane = tid & 63, wv = tid >> 6, i32 = lane & 31, hi = lane >> 5, kh = wv >> 2, jb = wv & 3, jp = 32 * jb + i32;
    f32x16 dc, ds;
#pragma unroll
    for (int r = 0; r < 16; ++r) { dc[r] = 0.f; ds[r] = 0.f; }
    const LAS float* arow = Wl + (32 * kh + i32) * 129 + hi;
#pragma unroll 8
    for (int st = 0; st < 64; ++st) {
        const float av = arow[2 * st]; const int ph = ((2 * st + hi) * jp) & 127;
        dc = __builtin_amdgcn_mfma_f32_32x32x2f32(av, tc[ph], dc, 0, 0, 0);
        ds = __builtin_amdgcn_mfma_f32_32x32x2f32(av, ts[ph], ds, 0, 0, 0);
    }
    bf16_t* oc = WMI + (size_t)(512 + 128 * g + jp) * DM + 64 * kc + 32 * kh + 4 * hi; bf16_t* os = oc + (size_t)512 * DM;
#pragma unroll
    for (int q = 0; q < 4; ++q) {
        u32x2 wc, ws_; wc.x = cvt_pk_bf16(dc[4 * q], dc[4 * q + 1]); wc.y = cvt_pk_bf16(dc[4 * q + 2], dc[4 * q + 3]); ws_.x = cvt_pk_bf16(ds[4 * q], ds[4 * q + 1]); ws_.y = cvt_pk_bf16(ds[4 * q + 2], ds[4 * q + 3]);
        *(u32x2*)(oc + 8 * q) = wc; *(u32x2*)(os + 8 * q) = ws_;
    }
    __syncthreads();
}
__device__ __forceinline__ void fold_out_item(LAS unsigned char* lds, const Args& a, int item, int tid) {
    const int o = item >> 6, g = (item >> 4) & 3, nc = item & 15;
    const float* WG = a.in[12] + (size_t)(o * 4 + g) * 128 * 128; const float* SC = a.in[13] + o * 512 + 128 * g; const float* WO = a.in[14] + (size_t)o * DM * DM + (size_t)(128 * g) * DM + 64 * nc;
    bf16_t* WMO = (bf16_t*)(a.ws + WS_WMO + o * SZ_WMO);
    LAS float* Wg = (LAS float*)lds; LAS float* Wo = (LAS float*)(lds + 66560);
    {   f32x4 t[8], u[4];
#pragma unroll
        for (int i = 0; i < 8; ++i) t[i] = *(const f32x4*)(WG + 4 * (tid + NTHR * i));
#pragma unroll
        for (int i = 0; i < 4; ++i) { const int idx = tid + NTHR * i, d = idx >> 4, n4 = idx & 15; u[i] = *(const f32x4*)(WO + (size_t)d * DM + 4 * n4) * SC[d]; }
#pragma unroll
        for (int i = 0; i < 8; ++i) { const int idx = 4 * (tid + NTHR * i), c = idx >> 7, d = idx & 127; LAS float* w = Wg + c * 129 + d; w[0] = t[i][0]; w[1] = t[i][1]; w[2] = t[i][2]; w[3] = t[i][3]; }
#pragma unroll
        for (int i = 0; i < 4; ++i) { const int idx = tid + NTHR * i, d = idx >> 4, n4 = idx & 15; LAS float* w = Wo + d * 65 + 4 * n4; w[0] = u[i][0]; w[1] = u[i][1]; w[2] = u[i][2]; w[3] = u[i][3]; } }
    __syncthreads();
    const int lane = tid & 63, wv = tid >> 6, i32 = lane & 31, hi = lane >> 5, cb = wv & 3, nb = wv >> 2;
    f32x16 dd;
#pragma unroll
    for (int r = 0; r < 16; ++r) dd[r] = 0.f;
    const LAS float* arow = Wg + (32 * cb + i32) * 129 + hi; const LAS float* bcol = Wo + hi * 65 + 32 * nb + i32;
#pragma unroll 8
    for (int st = 0; st < 64; ++st) dd = __builtin_amdgcn_mfma_f32_32x32x2f32(arow[2 * st], bcol[2 * st * 65], dd, 0, 0, 0);
    bf16_t* op = WMO + (size_t)(64 * nc + 32 * nb + i32) * KMO + 128 * g + 32 * cb + 4 * hi;
#pragma unroll
    for (int q = 0; q < 4; ++q) { u32x2 w; w.x = cvt_pk_bf16(dd[4 * q], dd[4 * q + 1]); w.y = cvt_pk_bf16(dd[4 * q + 2], dd[4 * q + 3]); *(u32x2*)(op + 8 * q) = w; }
    __syncthreads();
}

__device__ __forceinline__ void tr_layer(LAS unsigned char* lds, const Args& a, int l, int wr, int nw, int lane, int wave) {
    LAS float* scr = (LAS float*)(lds + wave * 8448);
    constexpr int I_WIN = 16 * 72, I_WOUT = 16 * 32, I_WMI = 16 * 16, I_WMO = 8 * 32, I_WUP = 16 * 176, I_WDN = 44 * 32;
    const bool even = (l & 1) == 0; const int eo = l >> 1;
    const int n1 = even ? I_WIN : I_WMI, n2 = even ? I_WOUT : I_WMO, NIT = n1 + n2 + I_WUP + I_WDN;
    for (int it = wr; it < NIT; it += nw) {
        int r = it;
        if (r < n1) {
            if (even) { const int kb = r / 72, nb = r % 72;
                tr_item(a.in[7] + (size_t)eo * DM * ATT_IN + (size_t)(64 * kb) * ATT_IN + 32 * nb, ATT_IN, (bf16_t*)(a.ws + WS_WIN + eo * SZ_WIN) + (size_t)(32 * nb) * DM + 64 * kb, nullptr, DM, scr, lane); }
            else { const int kb = r / 16, nb = r % 16;
                tr_item(a.in[11] + (size_t)eo * DM * DM + (size_t)(64 * kb) * DM + 32 * nb, DM, (bf16_t*)(a.ws + WS_WMI + eo * SZ_WMI) + (size_t)(32 * nb) * DM + 64 * kb, nullptr, DM, scr, lane); }
            continue; }
        r -= n1;
        if (r < n2) {
            const int kb = r / 32, nb = r % 32;
            if (even) tr_item(a.in[10] + (size_t)eo * DM * DM + (size_t)(64 * kb) * DM + 32 * nb, DM, (bf16_t*)(a.ws + WS_WOUT + eo * SZ_WOUT) + (size_t)(32 * nb) * DM + 64 * kb, nullptr, DM, scr, lane);
            else { bf16_t* d1 = (bf16_t*)(a.ws + WS_WMO + eo * SZ_WMO) + (size_t)(32 * nb) * KMO + 512 + 64 * kb;
                tr_item(a.in[14] + (size_t)eo * DM * DM + (size_t)(512 + 64 * kb) * DM + 32 * nb, DM, d1, d1 + 512, KMO, scr, lane); }
            continue; }
        r -= n2;
        if (r < I_WUP) { const int kb = r / 176, nb = r % 176, j = nb >> 3, sub = nb & 7;
            const int scol = sub < 4 ? 128 * j + 32 * sub : DFF + 128 * j + 32 * (sub - 4);
            tr_item(a.in[15] + (size_t)l * DM * NUP + (size_t)(64 * kb) * NUP + scol, NUP, (bf16_t*)(a.ws + WS_WUP + l * SZ_WUP) + (size_t)(32 * nb) * DM + 64 * kb, nullptr, DM, scr, lane); continue; }
        r -= I_WUP;
        { const int kb = r / 32, nb = r % 32;
            tr_item(a.in[17] + (size_t)l * DFF * DM + (size_t)(64 * kb) * DM + 32 * nb, DM, (bf16_t*)(a.ws + WS_WDN + l * SZ_WDN) + (size_t)(32 * nb) * DFF + 64 * kb, nullptr, DFF, scr, lane); }
    }
}
__device__ __forceinline__ void fold_layer(LAS unsigned char* lds, const Args& a, int o, int rk, int n, int tid) {
    { LAS float* tab = (LAS float*)(lds + LDS_COSTAB); for (int i = tid; i < 2048; i += NTHR) tab[i] = cospif((float)i * (1.0f / 1024.0f)); }
    __syncthreads();
    for (int it = rk; it < 64; it += n) fold_in_item(lds, a, o * 64 + it, tid);
    for (int it = rk; it < 64; it += n) fold_out_item(lds, a, o * 64 + (it + 64) % 64, tid);
    if (o == 0) {
        const LAS float* tab = (const LAS float*)(lds + LDS_COSTAB);
        const int gt = rk * NTHR + tid, NT = n * NTHR;
        bf16_t* FM = (bf16_t*)(a.ws + WS_FMAT);
        for (int idx = gt; idx < 2048 * 512; idx += NT) {
            const int k = idx >> 9, ch = idx & 511, s = ch >> 8, t0 = (ch & 255) * 8; float v[8];
#pragma unroll
            for (int e = 0; e < 8; ++e) { const int ph = (k * (t0 + e)) & 2047; v[e] = s ? -tab[(ph - 512) & 2047] * (1.0f / 512.0f) : tab[ph] * (1.0f / 512.0f); }
            u32x4 w; w.x = cvt_pk_bf16(v[0], v[1]); w.y = cvt_pk_bf16(v[2], v[3]); w.z = cvt_pk_bf16(v[4], v[5]); w.w = cvt_pk_bf16(v[6], v[7]);
            *(u32x4*)(FM + (size_t)k * 4096 + ch * 8) = w;
        }
        bf16_t* FC = (bf16_t*)(a.ws + WS_FC); const float nc = 0.005524271728019903f;
        for (int idx = gt; idx < 256 * 64; idx += NT) {
            const int k = idx >> 6, ch = idx & 63, s = ch >> 5, t0 = (ch & 31) * 8; float v[8];
#pragma unroll
            for (int e = 0; e < 8; ++e) { const int ph = ((k * (t0 + e)) & 255) * 8; v[e] = s ? -tab[(ph - 512) & 2047] * nc : tab[ph] * nc; }
            u32x4 w; w.x = cvt_pk_bf16(v[0], v[1]); w.y = cvt_pk_bf16(v[2], v[3]); w.z = cvt_pk_bf16(v[4], v[5]); w.w = cvt_pk_bf16(v[6], v[7]);
            *(u32x4*)(FC + (size_t)k * 512 + ch * 8) = w;
        }
    }
    __syncthreads();
}
__device__ __forceinline__ void prologue_a(LAS unsigned char* lds, const Args& a, int tid, int lane, int wave, int G) {
    const int bx = blockIdx.x;
    for (int it = bx; it < 256; it += G) mod_item(lds, a, it, tid);
    tr_layer(lds, a, 0, bx * NWAVES + wave, G * NWAVES, lane, wave);
    { const int gt = bx * NTHR + tid, NT = G * NTHR; float* TC = (float*)(a.ws + WS_TAB); float* TS = TC + 1024;
      for (int idx = gt; idx < 1024; idx += NT) { const int pos = idx >> 4, j = idx & 15; const float inv = powf(10000.0f, -(float)j / 16.0f); const float ang = (float)pos * inv; TC[idx] = cosf(ang); TS[idx] = sinf(ang); } }
    __syncthreads();
}

__device__ __forceinline__ void ld_row_f32(const float* p, int lane, f32x4 (&v)[4]) {
#pragma unroll
    for (int j = 0; j < 4; ++j) v[j] = *(const f32x4*)(p + 4 * lane + 256 * j);
}
__device__ __forceinline__ float row_rs(const f32x4 (&v)[4]) {
    float s = 0.f;
#pragma unroll
    for (int j = 0; j < 4; ++j) s += (v[j][0] * v[j][0] + v[j][1] * v[j][1]) + (v[j][2] * v[j][2] + v[j][3] * v[j][3]);
    return __builtin_amdgcn_rsqf(wave_sum(s) * (1.0f / DM) + EPS);
}
__device__ __forceinline__ void norm_mod_store(const f32x4 (&x)[4], const float* gain, const float* sc, const float* sh, bf16_t* hrow, int lane) {
    const float rs = row_rs(x);
#pragma unroll
    for (int j = 0; j < 4; ++j) {
        const int c = 4 * lane + 256 * j;
        const f32x4 g = *(const f32x4*)(gain + c), s1 = *(const f32x4*)(sc + c), s0 = *(const f32x4*)(sh + c);
        const f32x4 h = (x[j] * rs * g) * (s1 + 1.0f) + s0;
        u32x2 w; w.x = cvt_pk_bf16(h[0], h[1]); w.y = cvt_pk_bf16(h[2], h[3]);
        *(u32x2*)(hrow + c) = w;
    }
}
typedef GAS const float* gcf;
struct RowRegs { f32x4 x[4], y[4], gt[4], sc[4], sh[4]; };
struct RowCtx { gcf xsX, xsC, modx, modc, slab; GAS const bf16_t* Y; int layer, which, ns, lane; bool do_norm; };
__device__ __forceinline__ void row_load(RowRegs& R, const RowCtx& c, int row) {
    const bool isx = row < MX; const int b = row >> 11, lane = c.lane;
    gcf xi = isx ? c.xsX + (size_t)row * DM : c.xsC + (size_t)(row - MX) * DM;
#pragma unroll
    for (int j = 0; j < 4; ++j) R.x[j] = *(const GAS f32x4*)(xi + 4 * lane + 256 * j);
    gcf mod = isx ? c.modx + (size_t)(c.layer * 8 + b) * 6144 : c.modc + (size_t)c.layer * 6144;
    gcf modn = (c.which == 2) ? mod + (isx ? 8 * 6144 : 6144) : mod;
    const int so = c.which == 1 ? 4096 : 1024, ho = c.which == 1 ? 3072 : 0;
    if (c.do_norm) {
#pragma unroll
        for (int j = 0; j < 4; ++j) { R.sc[j] = *(const GAS f32x4*)(modn + so + 4 * lane + 256 * j); R.sh[j] = *(const GAS f32x4*)(modn + ho + 4 * lane + 256 * j); }
    }
    if (c.which != 0) {
        gcf gate = mod + (c.which == 1 ? 2048 : 5120);
#pragma unroll
        for (int j = 0; j < 4; ++j) R.gt[j] = *(const GAS f32x4*)(gate + 4 * lane + 256 * j);
        if (isx) {
#pragma unroll
            for (int j = 0; j < 4; ++j) { const u32x2 w = *(const GAS u32x2*)(c.Y + (size_t)row * DM + 4 * lane + 256 * j); R.y[j] = (f32x4){bf_lo(w.x), bf_hi(w.x), bf_lo(w.y), bf_hi(w.y)}; }
        } else {
            gcf sl = c.slab + (size_t)(row - MX) * DM;
#pragma unroll
            for (int j = 0; j < 4; ++j) R.y[j] = *(const GAS f32x4*)(sl + 4 * lane + 256 * j);
            for (int k = 1; k < c.ns; ++k)
#pragma unroll
                for (int j = 0; j < 4; ++j) R.y[j] += *(const GAS f32x4*)(sl + (size_t)k * MC * DM + 4 * lane + 256 * j);
        }
    }
}
__device__ __forceinline__ void row_finish(RowRegs& R, const RowCtx& c, int row, const f32x4 (&gA)[4], const f32x4 (&gB)[4], GAS float* xo, GAS bf16_t* ho) {
    const int lane = c.lane;
    if (c.which != 0) {
        const float rsy = row_rs(R.y);
#pragma unroll
        for (int j = 0; j < 4; ++j) { R.x[j] = R.x[j] + R.gt[j] * (R.y[j] * rsy * gA[j]); *(GAS f32x4*)(xo + 4 * lane + 256 * j) = R.x[j]; }
    }
    if (c.do_norm) {
        const float rs = row_rs(R.x);
#pragma unroll
        for (int j = 0; j < 4; ++j) {
            const f32x4 h = (R.x[j] * rs * gB[j]) * (R.sc[j] + 1.0f) + R.sh[j];
            u32x2 w; w.x = cvt_pk_bf16(h[0], h[1]); w.y = cvt_pk_bf16(h[2], h[3]);
            *(GAS u32x2*)(ho + 4 * lane + 256 * j) = w;
        }
    }
}
__device__ __forceinline__ void row_phase(const Args& a, int layer, int which, int nrows, int lane, int gw, int NGW) {
    RowCtx c; c.layer = layer; c.which = which; c.lane = lane; c.do_norm = !(which == 2 && layer == DEPTH - 1);
    c.modx = (gcf)(a.ws + WS_MODX); c.modc = (gcf)(a.ws + WS_MODC); c.Y = (GAS const bf16_t*)(a.ws + WS_Y);
    c.slab = (gcf)(a.ws + (which == 1 ? WS_BIG : WS_MIX)); c.ns = which == 1 ? SL_OUT : SL_DN;
    GAS float* hctx = (GAS float*)(a.ws + WS_HCTX); GAS float* xoX = a.dry ? (GAS float*)(a.ws + WS_BIG) : (GAS float*)a.out; GAS bf16_t* HX = (GAS bf16_t*)(a.ws + WS_HX);
    const bool first = layer == 0 && which < 2;
    c.xsX = first ? (gcf)a.in[0] : (gcf)a.out; c.xsC = first ? (gcf)a.in[2] : (gcf)hctx;
    gcf gains = (gcf)a.in[6];
    f32x4 gA[4], gB[4];
    { gcf pa = gains + (layer * 4 + (which == 1 ? 1 : 3)) * DM; gcf pb = gains + ((which == 2 ? layer + 1 : layer) * 4 + (which == 1 ? 2 : 0)) * DM;
      if (!c.do_norm) pb = pa;
#pragma unroll
      for (int j = 0; j < 4; ++j) { gA[j] = *(const GAS f32x4*)(pa + 4 * lane + 256 * j); gB[j] = *(const GAS f32x4*)(pb + 4 * lane + 256 * j); } }
    const int nX = (MX + NGW - 1) / NGW, nC = nrows > MX ? (nrows - MX + NGW - 1) / NGW : 0;
    for (int i = 0; i < nX + nC; i += 2) {
        int rowA = i < nX ? gw * nX + i : MX + gw * nC + (i - nX); const int lim = i < nX ? MX : nrows;
        int rowB = i + 1 < nX ? gw * nX + i + 1 : MX + gw * nC + (i + 1 - nX); const int limB = i + 1 < nX ? MX : nrows;
        const bool okA = rowA < lim, two = okA && (i + 1 < nX + nC) && rowB < limB;
        if (!okA) { if (i + 1 < nX + nC && rowB < limB) { rowA = rowB; } else continue; }
        if (!two) rowB = rowA;
        RowRegs A, B;
        row_load(A, c, rowA); row_load(B, c, rowB);
        row_finish(A, c, rowA, gA, gB, rowA < MX ? xoX + (size_t)rowA * DM : hctx + (size_t)(rowA - MX) * DM, HX + (size_t)rowA * DM);
        if (two) row_finish(B, c, rowB, gA, gB, rowB < MX ? xoX + (size_t)rowB * DM : hctx + (size_t)(rowB - MX) * DM, HX + (size_t)rowB * DM);
    }
}

typedef short v4i16_t __attribute__((ext_vector_type(4)));
constexpr int AT_KP = 144, AT_VP = 192;
constexpr int AT_KB = 128 * AT_KP, AT_VB = 128 * AT_VP, AT_BUF = AT_KB + AT_VB, AT_STG = 2 * AT_BUF, AT_STGW = 32 * 144, AT_SCR = AT_STG + 8 * AT_STGW;
static_assert(AT_SCR + 8 * 256 <= RING_BYTES, "attention LDS map");
constexpr float AT_THR = 8.0f;
__device__ __forceinline__ int crow(int r, int hi) { return (r & 3) + 8 * (r >> 2) + 4 * hi; }

__device__ __forceinline__ void attn_unit(LAS unsigned char* lds, const bf16_t* U, bf16_t* MIXo, const float* sink8, int b, int hk, int qrow0, int qpos0, bool latent, int tid) {
    const int lane = tid & 63, r32 = lane & 31, hi = lane >> 5, wid = __builtin_amdgcn_readfirstlane(tid >> 6);
    const int hq = 4 * hk + (wid >> 1), rowoff = 32 * (wid & 1), qa = qpos0 + rowoff;
    const int ctxrow0 = MX + b * CTXL, nst = latent ? 5 : 2;
    bf16x8 qf[4];
#pragma unroll
    for (int d0 = 0; d0 < 4; ++d0) qf[d0] = *(const bf16x8*)(U + (size_t)(qrow0 + rowoff + r32) * ATT_IN + hq * 64 + 16 * d0 + 8 * hi);
    const float sink2 = sink8[hq] * LOG2E;
    float mref = sink2, lsum = hi == 0 ? 1.f : 0.f;
    f32x16 o0, o1, negm;
#pragma unroll
    for (int r = 0; r < 16; ++r) { o0[r] = 0.f; o1[r] = 0.f; negm[r] = -sink2; }
    volatile LAS float* scr = (volatile LAS float*)(lds + AT_SCR) + wid * 64;
    const int skey = tid >> 3, sch = tid & 7;
    u32x4 kr0, kr1, vr0, vr1;
#define AT_ROW(st, key) ((st) < 2 ? ctxrow0 + 128 * (st) + (key) : b * SEQ + min(max(qpos0 - 128 + 128 * ((st) - 2) + (key), 0), SEQ - 1))
#define AT_LOAD(st) do { const bf16_t* p0_ = U + (size_t)AT_ROW(st, skey) * ATT_IN + 512 + hk * 64 + 8 * sch; const bf16_t* p1_ = U + (size_t)AT_ROW(st, skey + 64) * ATT_IN + 512 + hk * 64 + 8 * sch; \
        kr0 = *(const u32x4*)p0_; vr0 = *(const u32x4*)(p0_ + 128); kr1 = *(const u32x4*)p1_; vr1 = *(const u32x4*)(p1_ + 128); } while (0)
#define AT_WRITE(bufi) do { LAS unsigned char* kb_ = lds + (bufi) * AT_BUF; LAS unsigned char* vb_ = kb_ + AT_KB; \
        *(LAS u32x4*)(kb_ + skey * AT_KP + sch * 16) = kr0; *(LAS u32x4*)(kb_ + (skey + 64) * AT_KP + sch * 16) = kr1; \
        *(LAS u32x4*)(vb_ + skey * AT_VP + sch * 16) = vr0; *(LAS u32x4*)(vb_ + (skey + 64) * AT_VP + sch * 16) = vr1; } while (0)
    AT_LOAD(0); AT_WRITE(0);
    __syncthreads();
    for (int st = 0; st < nst; ++st) {
        if (st + 1 < nst) AT_LOAD(st + 1);
        const LAS unsigned char* kbuf = lds + (st & 1) * AT_BUF; const LAS unsigned char* vbuf = kbuf + AT_KB;
        const bool win = st >= 2;
#pragma unroll
        for (int h = 0; h < 2; ++h) {
            const int kp = qpos0 - 128 + 128 * (st - 2) + 64 * h;
            if (win && (kp < 0 || kp >= SEQ || kp > qa + 159 || kp + 63 < qa - 128)) continue;
            const bool needmask = win && !(qa + 31 - kp <= 128 && kp + 63 - qa <= 128);
            const LAS unsigned char* kb = kbuf + (64 * h + r32) * AT_KP + 16 * hi;
            f32x16 p0 = negm, p1 = negm;
#pragma unroll
            for (int d0 = 0; d0 < 4; ++d0) {
                const bf16x8 k0 = *(const LAS bf16x8*)(kb + 32 * d0), k1 = *(const LAS bf16x8*)(kb + 32 * AT_KP + 32 * d0);
                p0 = __builtin_amdgcn_mfma_f32_32x32x16_bf16(k0, qf[d0], p0, 0, 0, 0); p1 = __builtin_amdgcn_mfma_f32_32x32x16_bf16(k1, qf[d0], p1, 0, 0, 0);
            }
            if (needmask) {
                const int qpos = qa + r32;
#pragma unroll
                for (int r = 0; r < 16; ++r) { const int kq = kp + crow(r, hi); int d0_ = qpos - kq; d0_ = d0_ < 0 ? -d0_ : d0_; int d1_ = qpos - (kq + 32); d1_ = d1_ < 0 ? -d1_ : d1_;
                    if (d0_ > 128) p0[r] = -INFINITY; if (d1_ > 128) p1[r] = -INFINITY; }
            }
            float mx = fmaxf(fmaxf(p0[0], p0[1]), p1[0]);
#pragma unroll
            for (int r = 2; r < 16; r += 2) mx = fmaxf(fmaxf(mx, p0[r]), p0[r + 1]);
#pragma unroll
            for (int r = 1; r < 15; r += 2) mx = fmaxf(fmaxf(mx, p1[r]), p1[r + 1]);
            mx = fmaxf(mx, p1[15]);
            mx = fmaxf(mx, __shfl_xor(mx, 32));
            if (__any(mx > AT_THR)) {
                const float dl = fmaxf(mx, 0.f), f = __builtin_amdgcn_exp2f(-dl);
                mref += dl; lsum *= f;
#pragma unroll
                for (int r = 0; r < 16; ++r) { p0[r] -= dl; p1[r] -= dl; negm[r] = -mref; }
                if (hi == 0) scr[r32] = f;
                LDS_WAIT();
#pragma unroll
                for (int r = 0; r < 16; ++r) { const float al = scr[crow(r, hi)]; o0[r] *= al; o1[r] *= al; }
                LDS_WAIT();
            }
            float rsum = 0.f;
#pragma unroll
            for (int r = 0; r < 16; ++r) { p0[r] = __builtin_amdgcn_exp2f(p0[r]); p1[r] = __builtin_amdgcn_exp2f(p1[r]); rsum += p0[r] + p1[r]; }
            lsum += rsum;
            bf16x8 pa[4];
#pragma unroll
            for (int s2 = 0; s2 < 2; ++s2) {
                u32x4 w0, w1;
                w0.x = cvt_pk_bf16(p0[8 * s2 + 0], p0[8 * s2 + 1]); w0.y = cvt_pk_bf16(p0[8 * s2 + 2], p0[8 * s2 + 3]); w0.z = cvt_pk_bf16(p0[8 * s2 + 4], p0[8 * s2 + 5]); w0.w = cvt_pk_bf16(p0[8 * s2 + 6], p0[8 * s2 + 7]);
                w1.x = cvt_pk_bf16(p1[8 * s2 + 0], p1[8 * s2 + 1]); w1.y = cvt_pk_bf16(p1[8 * s2 + 2], p1[8 * s2 + 3]); w1.z = cvt_pk_bf16(p1[8 * s2 + 4], p1[8 * s2 + 5]); w1.w = cvt_pk_bf16(p1[8 * s2 + 6], p1[8 * s2 + 7]);
                pa[s2] = __builtin_bit_cast(bf16x8, w0); pa[2 + s2] = __builtin_bit_cast(bf16x8, w1);
            }
            const LAS unsigned char* vb = vbuf + (64 * h + 4 * hi + ((lane & 15) >> 2)) * AT_VP + ((lane >> 4) & 1) * 32 + (lane & 3) * 8;
#pragma unroll
            for (int s = 0; s < 4; ++s) {
#pragma unroll
                for (int d = 0; d < 2; ++d) {
                    const v4i16_t lo = __builtin_amdgcn_ds_read_tr16_b64_v4i16((LAS v4i16_t*)(vb + 16 * s * AT_VP + 64 * d));
                    const v4i16_t hh = __builtin_amdgcn_ds_read_tr16_b64_v4i16((LAS v4i16_t*)(vb + (16 * s + 8) * AT_VP + 64 * d));
                    const bf16x8 vf = (bf16x8){lo[0], lo[1], lo[2], lo[3], hh[0], hh[1], hh[2], hh[3]};
                    if (d == 0) o0 = __builtin_amdgcn_mfma_f32_32x32x16_bf16(pa[s], vf, o0, 0, 0, 0); else o1 = __builtin_amdgcn_mfma_f32_32x32x16_bf16(pa[s], vf, o1, 0, 0, 0);
                }
            }
        }
        if (st + 1 < nst) AT_WRITE((st + 1) & 1);
        __syncthreads();
    }
    {
        const float lt = lsum + __shfl_xor(lsum, 32);
        if (hi == 0) scr[r32] = 1.0f / lt;
        LDS_WAIT();
        LAS unsigned short* stg = (LAS unsigned short*)(lds + AT_STG + wid * AT_STGW);
#pragma unroll
        for (int r = 0; r < 16; ++r) { const int q = crow(r, hi); const float il = scr[q];
            stg[q * 72 + r32] = (unsigned short)(cvt_pk_bf16(o0[r] * il, 0.f) & 0xffffu); stg[q * 72 + 32 + r32] = (unsigned short)(cvt_pk_bf16(o1[r] * il, 0.f) & 0xffffu); }
        LDS_WAIT();
#pragma unroll
        for (int i = 0; i < 4; ++i) { const int row = i * 8 + (lane >> 3), ch = lane & 7; const u32x4 v = *(const LAS u32x4*)((const LAS unsigned char*)stg + row * 144 + ch * 16);
            *(u32x4*)(MIXo + (size_t)(qrow0 + rowoff + row) * KMO + hq * 64 + 8 * ch) = v; }
        LDS_WAIT();
    }
#undef AT_ROW
#undef AT_LOAD
#undef AT_WRITE
}

__device__ __forceinline__ u32x4 ld16(const bf16_t* p) { return *(const u32x4*)p; }
__device__ __forceinline__ void unpack8(const u32x4& w, float (&f)[8]) { f[0] = bf_lo(w.x); f[1] = bf_hi(w.x); f[2] = bf_lo(w.y); f[3] = bf_hi(w.y); f[4] = bf_lo(w.z); f[5] = bf_hi(w.z); f[6] = bf_lo(w.w); f[7] = bf_hi(w.w); }

__device__ __forceinline__ void sconv_pass(const Args& a, int e, int nrows, int gt, int NT) {
    const bf16_t* U = (const bf16_t*)(a.ws + WS_BIG); bf16_t* MIXo = (bf16_t*)(a.ws + WS_MIX); const float* cw = a.in[9] + (size_t)e * 3 * 512;
    for (int idx = gt; idx < nrows * 64; idx += NT) {
        const int row = idx >> 6, ch = idx & 63;
        const int t = row < MX ? (row & (SEQ - 1)) : ((row - MX) & (CTXL - 1)), T = row < MX ? SEQ : CTXL;
        const bf16_t* up = U + (size_t)row * ATT_IN + 8 * ch;
        float bv[8], acc[8];
        unpack8(ld16(up + 768), bv);
#pragma unroll
        for (int q = 0; q < 8; ++q) acc[q] = 0.f;
#pragma unroll
        for (int j = 0; j < 3; ++j) {
            const int tt = t + j - 1;
            if (tt >= 0 && tt < T) {
                float cvv[8], zv[8];
                unpack8(ld16(up + (ptrdiff_t)(j - 1) * ATT_IN + 1280), cvv); unpack8(ld16(up + (ptrdiff_t)(j - 1) * ATT_IN + 1792), zv);
                const f32x4 w0 = *(const f32x4*)(cw + j * 512 + 8 * ch), w1 = *(const f32x4*)(cw + j * 512 + 8 * ch + 4);
#pragma unroll
                for (int q = 0; q < 4; ++q) { acc[q] += w0[q] * (cvv[q] * zv[q]); acc[4 + q] += w1[q] * (cvv[4 + q] * zv[4 + q]); }
            }
        }
        u32x4 w; w.x = cvt_pk_bf16(bv[0] * acc[0], bv[1] * acc[1]); w.y = cvt_pk_bf16(bv[2] * acc[2], bv[3] * acc[3]); w.z = cvt_pk_bf16(bv[4] * acc[4], bv[5] * acc[5]); w.w = cvt_pk_bf16(bv[6] * acc[6], bv[7] * acc[7]);
        *(u32x4*)(MIXo + (size_t)row * KMO + 512 + 8 * ch) = w;
    }
}
__device__ __forceinline__ void pool_pass(const Args& a, int nrows, int gt, int NT) {
    const bf16_t* UP = (const bf16_t*)(a.ws + WS_UPOOL); bf16_t* MIXo = (bf16_t*)(a.ws + WS_MIX);
    for (int idx = gt; idx < nrows * 64; idx += NT) {
        const int row = idx >> 6, ch = idx & 63, g = ch >> 4, hw = 1 << g;
        const int t = row < MX ? (row & (SEQ - 1)) : ((row - MX) & (CTXL - 1)), T = row < MX ? SEQ : CTXL;
        const int lo = t - hw < 0 ? 0 : t - hw, hi = t + hw > T ? T : t + hw;
        const bf16_t* up = UP + (size_t)row * 512 + 8 * ch;
        float acc[8], f[8];
#pragma unroll
        for (int q = 0; q < 8; ++q) acc[q] = 0.f;
        for (int s = lo; s < hi; ++s) { unpack8(ld16(up + (ptrdiff_t)(s - t) * 512), f);
#pragma unroll
            for (int q = 0; q < 8; ++q) acc[q] += f[q]; }
        unpack8(ld16(up), f);
        const float inv = 1.0f / (float)(hi - lo);
#pragma unroll
        for (int q = 0; q < 8; ++q) acc[q] = acc[q] * inv - f[q];
        u32x4 w; w.x = cvt_pk_bf16(acc[0], acc[1]); w.y = cvt_pk_bf16(acc[2], acc[3]); w.z = cvt_pk_bf16(acc[4], acc[5]); w.w = cvt_pk_bf16(acc[6], acc[7]);
        *(u32x4*)(MIXo + (size_t)row * KMO + 8 * ch) = w;
    }
}
__device__ __forceinline__ void ffn_fixup(const Args& a, int layer, int nrows, int gt, int NT) {
    const float* SIDE = (const float*)(a.ws + WS_SIDE); bf16_t* ACT = (bf16_t*)(a.ws + WS_BIG); const float* cw = a.in[16] + (size_t)layer * 3 * DFF;
    const int nblk = nrows >> 6;
    for (int idx = gt; idx < nblk * 2 * (DFF / 4); idx += NT) {
        const int c4 = idx % (DFF / 4), bw = idx / (DFF / 4), blk = bw >> 1, which = bw & 1, col = 4 * c4;
        const int row = blk * 64 + (which ? 63 : 0);
        const int sb = row < MX ? (blk & 31) : ((blk - MX / 64) & 3), nsb = row < MX ? 32 : 4;
        const float* sp = SIDE + ((size_t)(blk * 2 + which) * 3) * DFF + col;
        f32x4 cv = *(const f32x4*)sp; const f32x4 vv = *(const f32x4*)(sp + 2 * DFF);
        if (which == 0 && sb > 0) { const f32x4 gl = *(const f32x4*)(SIDE + ((size_t)((blk - 1) * 2 + 1) * 3 + 1) * DFF + col); cv += *(const f32x4*)(cw + col) * gl; }
        if (which == 1 && sb < nsb - 1) { const f32x4 gf = *(const f32x4*)(SIDE + ((size_t)((blk + 1) * 2 + 0) * 3 + 1) * DFF + col); cv += *(const f32x4*)(cw + 2 * DFF + col) * gf; }
        u32x2 w; w.x = cvt_pk_bf16(silu_f(cv[0]) * vv[0], silu_f(cv[1]) * vv[1]); w.y = cvt_pk_bf16(silu_f(cv[2]) * vv[2], silu_f(cv[3]) * vv[3]);
        *(u32x2*)(ACT + (size_t)row * DFF + col) = w;
    }
}

constexpr int STEPS_PER_LAYER = 13, N_STEPS = 2 + STEPS_PER_LAYER * DEPTH;
enum { ST_NOP = 0, ST_PRO, ST_ROW, ST_GEMM, ST_ATT, ST_POOL, ST_FIX };

__global__ void __launch_bounds__(NTHR, 2) dit_fwd(Args args) {
    extern __shared__ __attribute__((aligned(16))) unsigned char lds_raw[];
    LAS unsigned char* lds = (LAS unsigned char*)lds_raw;
    for (int u = threadIdx.x; u < (LDS_BYTES - LDSCTL_OFF) / 4; u += NTHR) ((LAS unsigned*)(lds + LDSCTL_OFF))[u] = 0u;
    __syncthreads();
    XcdBarrier bar; bar.bar = (unsigned*)(args.ws + WS_CTL) + CW_BAR; bar.x = 0; bar.st = nullptr;
    if (!MK_PER_PHASE) bar = xcd_barrier_post((unsigned*)(args.ws + WS_CTL) + CW_BAR, (volatile LAS unsigned*)(lds + MISC_OFF) + 8);

    for (int st = args.ph_lo; st < args.ph_hi; ++st) {
        int tid = threadIdx.x; asm volatile("" : "+v"(tid));
        int G = gridDim.x, bx = blockIdx.x; asm volatile("" : "+s"(G), "+s"(bx));
        unsigned char* ws = args.ws; asm volatile("" : "+s"(ws));
        const int lane = tid & 63, wave = __builtin_amdgcn_readfirstlane(tid >> 6);
        bf16_t* HX = (bf16_t*)(ws + WS_HX); bf16_t* Yb = (bf16_t*)(ws + WS_Y); bf16_t* MIXb = (bf16_t*)(ws + WS_MIX); bf16_t* BIG = (bf16_t*)(ws + WS_BIG);
        int kind = ST_NOP, l = 0, sub = -1, rw = 0, coff = 0; bool seam = false;
        if (st == 0) { kind = ST_PRO; seam = true; }
        else if (st == 1) { kind = ST_ROW; rw = 0; seam = true; }
        else if (st >= N_STEPS) { seam = true; }
        else { l = (st - 2) / STEPS_PER_LAYER; sub = (st - 2) % STEPS_PER_LAYER; }
        const bool even = (l & 1) == 0; const int eo = l >> 1;
        const bool ctx_live = l < 2;
        const int nrows = ctx_live ? MT : MX, nMt = nrows / 256;
        gm::Call C{}; C.G = G;
        if (sub == 0) {
            kind = ST_GEMM; C.K = DM; C.lda = DM; C.ldb = DM;
            if (even) C.j0 = gm::Job{HX, (const bf16_t*)(ws + WS_WIN + eo * SZ_WIN), BIG, (const float*)(ws + WS_TAB), nullptr, nMt, ATT_IN / 256, gm::K_ROPE, ATT_IN, 0, 0, 0, 0, 1, nullptr};
            else C.j0 = gm::Job{(const bf16_t*)(ws + WS_WMI + eo * SZ_WMI) + (size_t)512 * DM, HX, ws + WS_VT, nullptr, ws + WS_VTC, 4, nMt, gm::K_VT, 0, 0, 0, 0, 0, 1, nullptr};
        } else if (sub == 1) {
            seam = true; C.K = DM; C.lda = DM; C.ldb = DM;
            if (!even) { kind = ST_GEMM; coff = (4 * nMt) % G; C.j0 = gm::Job{HX, (const bf16_t*)(ws + WS_WMI + eo * SZ_WMI), ws + WS_UPOOL, nullptr, nullptr, nMt, 2, gm::K_PLAIN, 512, 0, 0, 0, 0, 1, nullptr}; }
            else if (l == 2) { kind = ST_GEMM; coff = (64 * 9) % G;
                C.j0 = gm::Job{HX + (size_t)MX * DM, (const bf16_t*)(ws + WS_WIN + eo * SZ_WIN) + (size_t)512 * DM, BIG, (const float*)(ws + WS_TAB), nullptr, MC / 256, 1, gm::K_ROPE, ATT_IN, MX, 512, 0, 0, 1, nullptr}; }
        } else if (sub == 2) {
            if (even) { kind = ST_ATT; seam = true; }
            else { kind = ST_GEMM; C.K = SEQ; C.lda = 2 * SEQ; C.ldb = 2 * SEQ;
                C.j0 = gm::Job{(const bf16_t*)(ws + WS_FMAT), (const bf16_t*)(ws + WS_VT), MIXb, nullptr, nullptr, 8, 16, gm::K_DFT, KMO, 0, 512, 8, 0, 1, nullptr}; }
        } else if (sub == 3) {
            if (!even) { kind = ST_GEMM; coff = 128 % G; C.K = SEQ; C.lda = 2 * SEQ; C.ldb = 2 * SEQ;
                C.j0 = gm::Job{(const bf16_t*)(ws + WS_FMAT) + SEQ, (const bf16_t*)(ws + WS_VT) + SEQ, MIXb, nullptr, nullptr, 8, 16, gm::K_DFT, KMO, 0, 1024, 8, 0, 1, nullptr}; }
        } else if (sub == 4) {
            if (!even && ctx_live) { kind = ST_GEMM; C.K = CTXL; C.lda = 2 * CTXL; C.ldb = 2 * CTXL;
                C.j0 = gm::Job{(const bf16_t*)(ws + WS_FC), (const bf16_t*)(ws + WS_VTC), MIXb, nullptr, nullptr, 1, 16, gm::K_DFT, KMO, MX, 512, 1, 0, 1, nullptr}; }
        } else if (sub == 5) {
            if (!even && ctx_live) { kind = ST_GEMM; coff = 16 % G; C.K = CTXL; C.lda = 2 * CTXL; C.ldb = 2 * CTXL;
                C.j0 = gm::Job{(const bf16_t*)(ws + WS_FC) + CTXL, (const bf16_t*)(ws + WS_VTC) + CTXL, MIXb, nullptr, nullptr, 1, 16, gm::K_DFT, KMO, MX, 1024, 1, 0, 1, nullptr}; }
        } else if (sub == 6) {
            if (!even) { kind = ST_POOL; seam = true; }
        } else if (sub == 7) {
            kind = ST_GEMM; seam = true; C.lda = KMO;
            if (even) { C.K = DM; C.ldb = DM; C.j0 = gm::Job{MIXb, (const bf16_t*)(ws + WS_WOUT + eo * SZ_WOUT), Yb, nullptr, nullptr, MX / 256, 4, gm::K_PLAIN, DM, 0, 0, 0, nMt - MX / 256, SL_OUT, (float*)(ws + WS_BIG)}; }
            else { C.K = KMO; C.ldb = KMO; C.j0 = gm::Job{MIXb, (const bf16_t*)(ws + WS_WMO + eo * SZ_WMO), Yb, nullptr, nullptr, MX / 256, 4, gm::K_PLAIN, DM, 0, 0, 0, nMt - MX / 256, SL_OUT, (float*)(ws + WS_BIG)}; }
        } else if (sub == 8) { kind = ST_ROW; rw = 1; seam = true; }
        else if (sub == 9) {
            kind = ST_GEMM; seam = true; C.K = DM; C.lda = DM; C.ldb = DM;
            C.j0 = gm::Job{HX, (const bf16_t*)(ws + WS_WUP + l * SZ_WUP), BIG, args.in[16] + (size_t)l * 3 * DFF, ws + WS_SIDE, nMt, NUP / 256, gm::K_FFN, DFF, 0, 0, 0, 0, 1, nullptr};
        } else if (sub == 10) { kind = ST_FIX; seam = true; }
        else if (sub == 11) {
            kind = ST_GEMM; seam = true; C.K = DFF; C.lda = DFF; C.ldb = DFF;
            C.j0 = gm::Job{BIG, (const bf16_t*)(ws + WS_WDN + l * SZ_WDN), Yb, nullptr, nullptr, MX / 256, 4, gm::K_PLAIN, DM, 0, 0, 0, nMt - MX / 256, SL_DN, (float*)(ws + WS_MIX)};
        } else if (sub == 12) { kind = ST_ROW; rw = 2; seam = true; }
        C.c = bx >= coff ? bx - coff : bx - coff + G;

        if (kind == ST_GEMM) {
            gm::gemm_phase(lds, C, tid);
            const bool hostA = (sub == 0 && even && l + 1 < DEPTH), hostB = (sub == 9 && l + 1 < DEPTH);
            if (hostA || hostB) {
                const int total = C.j0.nM * C.j0.nN, rem = total % G;
                const int rk = rem ? C.c - rem : C.c, n = rem ? G - rem : G;
                if (rk >= 0) { if (hostA) fold_layer(lds, args, l >> 1, rk, n, tid); else tr_layer(lds, args, l + 1, rk * NWAVES + wave, n * NWAVES, lane, wave); __syncthreads(); }
            }
        }
        else if (kind == ST_PRO) prologue_a(lds, args, tid, lane, wave, G);
        else if (kind == ST_ROW) row_phase(args, l, rw, rw == 0 ? MT : nrows, lane, bx * NWAVES + wave, G * NWAVES);
        else if (kind == ST_ATT) {
            const float* sink = args.in[8] + eo * 8;
            for (int u = bx; u < 512 + (l == 0 ? 64 : 0); u += G) {
                if (u < 512) { const int bh = u >> 5, i = u & 31, b = bh >> 1, hk = bh & 1; attn_unit(lds, BIG, MIXb, sink, b, hk, b * SEQ + 64 * i, 64 * i, true, tid); }
                else { const int v = u - 512, bh = v >> 2, i = v & 3, b = bh >> 1, hk = bh & 1; attn_unit(lds, BIG, MIXb, sink, b, hk, MX + b * CTXL + 64 * i, 0, false, tid); }
            }
            sconv_pass(args, eo, nrows, bx * NTHR + tid, G * NTHR);
        }
        else if (kind == ST_POOL) pool_pass(args, nrows, bx * NTHR + tid, G * NTHR);
        else if (kind == ST_FIX) ffn_fixup(args, l, nrows, bx * NTHR + tid, G * NTHR);
        if (!MK_PER_PHASE && seam && st + 1 < args.ph_hi) xcd_barrier(bar);
    }
}

extern "C" void kernel_launch(void* const* d_in, const int* in_sizes, int n_in, void* d_out, int out_size, void* d_ws, size_t ws_size, hipStream_t stream) {
    static int grid = 0;
    if (grid == 0) {
        if (n_in != 18 || out_size != MX * DM || ws_size < WS_END) { fprintf(stderr, "kernel_launch: unexpected shapes (n_in %d, out %d, ws %zu)\n", n_in, out_size, ws_size); grid = -1; return; }
        int dev = 0, cus = 0;
        if (hipGetDevice(&dev) != hipSuccess || hipDeviceGetAttribute(&cus, hipDeviceAttributeMultiprocessorCount, dev) != hipSuccess) { grid = -1; return; }
        if (hipFuncSetAttribute((const void*)dit_fwd, hipFuncAttributeMaxDynamicSharedMemorySize, LDS_BYTES) != hipSuccess) { grid = -1; return; }
        (void)hipGetLastError();
        grid = cus;
    }
    if (grid < 0) return;
    if (hipMemsetAsync((char*)d_ws + WS_CTL, 0, CTL_ZERO_BYTES, stream) != hipSuccess) return;
    Args a{};
    for (int i = 0; i < 18; ++i) a.in[i] = (const float*)d_in[i];
    a.out = (float*)d_out; a.ws = (unsigned char*)d_ws;
#if MK_PER_PHASE
    for (int p = 0; p < N_STEPS; ++p) { a.ph_lo = p; a.ph_hi = p + 1; hipLaunchKernelGGL(dit_fwd, dim3(grid), dim3(NTHR), LDS_BYTES, stream, a); }
#else
    a.ph_lo = 0; a.ph_hi = N_STEPS;
    hipLaunchKernelGGL(dit_fwd, dim3(grid), dim3(NTHR), LDS_BYTES, stream, a);
#if PROBE_CLASS
    for (int r = 0; r < PROBE_REPS; ++r)
        for (int l = 0; l < DEPTH; ++l) {
            const int base = 2 + STEPS_PER_LAYER * l; const bool ev = (l & 1) == 0;
            int lo = -1, hi = -1;
            switch (PROBE_CLASS) {
                case 1: lo = base + 9; hi = lo + 1; break;
                case 2: lo = base + 11; hi = lo + 1; break;
                case 3: lo = base + 0; hi = base + 2; break;
                case 4: lo = base + 7; hi = lo + 1; break;
                case 5: if (ev) { lo = base + 2; hi = lo + 1; } break;
                case 6: if (!ev) { lo = base + 2; hi = base + 7; } break;
                case 7: if (l == 0) { lo = 0; hi = 1; } break;
                case 8: lo = 1; hi = 2; break;
                case 9: lo = base + 10; hi = lo + 1; break;
                case 10: lo = 2 + 3; hi = lo + 1; break;
                case 11: lo = base + 8; hi = lo + 1; a.dry = 1; break;
                case 12: lo = base + 12; hi = lo + 1; a.dry = 1; break;
                case 13: lo = N_STEPS; hi = N_STEPS + 9; break;
            }
            if (lo >= 0) { a.ph_lo = lo; a.ph_hi = hi; hipLaunchKernelGGL(dit_fwd, dim3(grid), dim3(NTHR), LDS_BYTES, stream, a); }
        }
#endif
#endif
}
```

```cpp
#include <hip/hip_runtime.h>
#include <cstdio>
#include <cstdint>

#ifndef MK_PER_PHASE
#define MK_PER_PHASE 0
#endif

#ifndef PROBE_CLASS
#define PROBE_CLASS 0
#endif
#define PROBE_REPS 3
#define GAS __attribute__((address_space(1)))
#define LAS __attribute__((address_space(3)))
typedef unsigned short bf16_t;
typedef short bf16x8 __attribute__((ext_vector_type(8)));
typedef float f32x4 __attribute__((ext_vector_type(4)));
typedef float f32x16 __attribute__((ext_vector_type(16)));
typedef unsigned u32x4 __attribute__((ext_vector_type(4)));
typedef unsigned u32x2 __attribute__((ext_vector_type(2)));
typedef GAS unsigned gu32;
#define RLX_AGENT __ATOMIC_RELAXED, __HIP_MEMORY_SCOPE_AGENT
#define LDS_WAIT() asm volatile("s_waitcnt lgkmcnt(0)" ::: "memory")
#define VM_WAIT() asm volatile("s_waitcnt vmcnt(0)" ::: "memory")

constexpr int DM = 1024, NBATCH = 8, SEQ = 2048, CTXL = 256, DEPTH = 4;
constexpr int MX = NBATCH * SEQ, MC = NBATCH * CTXL, MT = MX + MC;
constexpr int ATT_IN = 2304, DFF = 2816, NUP = 2 * DFF, KMO = 1536;
constexpr float EPS = 1e-6f;
constexpr float QSCALE = 0.125f * 1.4426950408889634f;
constexpr float LOG2E = 1.4426950408889634f;
constexpr int NWAVES = 8, NTHR = 512;

constexpr size_t MiB = 1u << 20;
constexpr size_t WS_CTL = 0, CTL_ZERO_BYTES = 1 * MiB;
constexpr size_t WS_MODX = 1 * MiB, WS_MODC = WS_MODX + (size_t)4 * 8 * 6144 * 4;
constexpr size_t WS_TAB = 2 * MiB;
constexpr size_t WS_WIN = 4 * MiB, SZ_WIN = (size_t)ATT_IN * DM * 2;
constexpr size_t WS_WOUT = 13 * MiB, SZ_WOUT = (size_t)DM * DM * 2;
constexpr size_t WS_WMI = 17 * MiB, SZ_WMI = (size_t)1536 * DM * 2;
constexpr size_t WS_WMO = 23 * MiB, SZ_WMO = (size_t)DM * KMO * 2;
constexpr size_t WS_WUP = 29 * MiB, SZ_WUP = (size_t)NUP * DM * 2;
constexpr size_t WS_WDN = 73 * MiB, SZ_WDN = (size_t)DM * DFF * 2;
constexpr size_t WS_FMAT = 96 * MiB;
constexpr size_t WS_FC = 112 * MiB;
constexpr size_t WS_HCTX = 113 * MiB;
constexpr size_t WS_HX = 122 * MiB;
constexpr size_t WS_Y = 158 * MiB;
constexpr size_t WS_BIG = 194 * MiB;
constexpr size_t WS_UPOOL = WS_BIG, WS_VT = WS_BIG + 20 * MiB, WS_VTC = WS_BIG + 52 * MiB;
constexpr size_t WS_MIX = 293 * MiB;
constexpr size_t WS_SIDE = 348 * MiB;
constexpr size_t WS_END = 368 * MiB;
constexpr int CW_BAR = 4096;
constexpr int SL_OUT = 4, SL_DN = 6;

constexpr int RING_BYTES = 131072, LDSCTL_OFF = RING_BYTES, MISC_OFF = LDSCTL_OFF + 320, LDS_BYTES = 147456;
constexpr int LDS_COSTAB = 122880;

__device__ __forceinline__ unsigned cvt_pk_bf16(float lo, float hi) { unsigned r; asm("v_cvt_pk_bf16_f32 %0, %1, %2" : "=v"(r) : "v"(lo), "v"(hi)); return r; }
__device__ __forceinline__ float bf_lo(unsigned w) { return __uint_as_float(w << 16); }
__device__ __forceinline__ float bf_hi(unsigned w) { return __uint_as_float(w & 0xffff0000u); }
__device__ __forceinline__ float wave_sum(float v) {
#pragma unroll
    for (int o = 1; o < 64; o <<= 1) v += __shfl_xor(v, o);
    return v;
}
__device__ __forceinline__ float silu_f(float x) { return x * __builtin_amdgcn_rcpf(1.0f + __builtin_amdgcn_exp2f(-x * LOG2E)); }

#define XB_TMO      128
#define XB_XCNT(j)  (256  + 64 * (j))
#define XB_XSUB(j)  (1280 + 64 * (j))
#define XB_XGEN(j)  (2304 + 64 * (j))
#define XB_TOP      3328
#define XB_TOPGEN   3392
#define XCD_BAR_WORDS 3456
#define XB_SPIN_CAP (1u << 18)
__device__ __forceinline__ unsigned xb_ld(unsigned* p)              { return __hip_atomic_load(p, __ATOMIC_RELAXED, __HIP_MEMORY_SCOPE_AGENT); }
__device__ __forceinline__ unsigned xb_add(unsigned* p, unsigned v) { return __hip_atomic_fetch_add(p, v, __ATOMIC_RELAXED, __HIP_MEMORY_SCOPE_AGENT); }
__device__ __forceinline__ unsigned xb_xcc_id() { return (unsigned)__builtin_amdgcn_s_getreg((3 << 11) | 20) & 0xFu; }
#define XB_SPIN(cond, bar) do { unsigned _sp = 0; while (cond) { __builtin_amdgcn_s_sleep(1); \
    if ((++_sp & 255u) == 0u) { if (xb_ld(&(bar)[XB_TMO])) break; if (_sp > XB_SPIN_CAP) { atomicAdd(&(bar)[XB_TMO], 1u); break; } } } } while (0)
struct XcdBarrier { unsigned* bar; unsigned x; volatile LAS unsigned* st; };
__device__ __forceinline__ XcdBarrier xcd_barrier_post(unsigned* bar, volatile LAS unsigned* st) {
    XcdBarrier b; b.bar = bar; b.x = xb_xcc_id(); b.st = st;
    if (threadIdx.x == 0) (void)xb_add(&bar[XB_XCNT(b.x)], 1u);
    return b;
}
__device__ __forceinline__ void xcd_barrier_complete(unsigned* bar, unsigned x, unsigned& nloc, unsigned& nx) {
    const unsigned G = gridDim.x * gridDim.y * gridDim.z;
    unsigned sum, cnt, mine, sp = 0u;
    for (;;) {
        sum = 0u; cnt = 0u; mine = 0u;
#pragma unroll
        for (unsigned j = 0; j < 16; ++j) { const unsigned c = xb_ld(&bar[XB_XCNT(j)]); sum += c; cnt += (c > 0u) ? 1u : 0u; mine = (j == x) ? c : mine; }
        if (sum == G) break;
        __builtin_amdgcn_s_sleep(1);
        if ((++sp & 255u) == 0u) { if (xb_ld(&bar[XB_TMO])) break; if (sp > XB_SPIN_CAP) { atomicAdd(&bar[XB_TMO], 1u); break; } }
    }
    nloc = mine > 0u ? mine : 1u; nx = cnt > 0u ? cnt : 1u;
}
__device__ __forceinline__ void xcd_barrier(const XcdBarrier& b) {
    asm volatile("s_waitcnt vmcnt(0)" ::: "memory");
    __syncthreads();
    if (threadIdx.x == 0) {
        unsigned* bar = b.bar; asm volatile("" : "+s"(bar));
        __builtin_amdgcn_s_waitcnt(0);
        unsigned nloc = b.st[0], nx = b.st[1];
        if (nloc == 0u) { xcd_barrier_complete(bar, b.x, nloc, nx); b.st[0] = nloc; b.st[1] = nx; }
        const unsigned old = xb_add(&bar[XB_XSUB(b.x)], 1u);
        const unsigned gen = old / nloc;
        if (old + 1u == (gen + 1u) * nloc) {
            __builtin_amdgcn_fence(__ATOMIC_RELEASE, "agent");
            asm volatile("s_waitcnt vmcnt(0)" ::: "memory");
            const unsigned og = xb_add(&bar[XB_TOP], 1u);
            const unsigned tg = og / nx;
            if (og + 1u == (tg + 1u) * nx) xb_add(&bar[XB_TOPGEN], 1u);
            else XB_SPIN(xb_ld(&bar[XB_TOPGEN]) == tg, bar);
            __builtin_amdgcn_fence(__ATOMIC_ACQUIRE, "agent");
            xb_add(&bar[XB_XGEN(b.x)], 1u);
            asm volatile("s_waitcnt vmcnt(0)" ::: "memory");
        } else {
            XB_SPIN(xb_ld(&bar[XB_XGEN(b.x)]) == gen, bar);
            __builtin_amdgcn_fence(__ATOMIC_ACQUIRE, "agent");
            asm volatile("s_waitcnt vmcnt(0)" ::: "memory");
        }
    }
    __syncthreads();
}

namespace gm {
constexpr int BM = 256, BK = 64, HALF = 128, HTB = HALF * BK * 2, NXCD = 8, WGM = 8;
__device__ __forceinline__ int lds_byte(int r, int c) { const int st = (r >> 4) * 2 + (c >> 5), rr = r & 15, cc = c & 31, ob = rr * 64 + cc * 2; return st * 1024 + (ob ^ (((ob >> 9) & 1) << 5)); }
__device__ __forceinline__ void stage_rc(int b, int& R, int& C) { const int st = b / 1024, sb = b % 1024, swz = sb ^ (((sb >> 9) & 1) << 5); R = (st >> 1) * 16 + swz / 64; C = (st & 1) * 32 + (swz % 64) / 2; }
__device__ __forceinline__ int perm32(int rho) { const int n = rho >> 4, i = rho & 15; return 8 * (i >> 2) + 4 * n + (i & 3); }

enum { K_PLAIN = 0, K_DFT = 1, K_ROPE = 2, K_VT = 3, K_FFN = 4 };
struct Job { const bf16_t* A; const bf16_t* B; void* out; const float* aux; void* out2; int nM, nN, kind, ldc, row0, col0, p0; int cM, S; float* slab; };
struct Call { int K, lda, ldb, G, c; Job j0; };
struct Unit { int pm, pn, kp0, np, slice; };

__device__ __forceinline__ void next_unit(const Call& C, int i, int& pm, int& pn, int& kp0, int& np, int& slice) {
    const long L = (long)i * C.G + C.c;
    const int nM = C.j0.nM, nN = C.j0.nN, nwg = nM * nN, P = C.K / (2 * BK);
    const int S = C.j0.S, nsl = C.j0.cM * nN * S;
    pm = -1; pn = 0; kp0 = 0; np = P; slice = -1;
    if (L < nwg) {
        int wgid = (int)L; { const int q = nwg / NXCD, r = nwg % NXCD, xcd = wgid % NXCD, off = wgid / NXCD; wgid = (xcd < r ? xcd * (q + 1) : r * (q + 1) + (xcd - r) * q) + off; }
        const int nig = WGM * nN, gid = wgid / nig, fm = gid * WGM, gsz = (nM - fm) < WGM ? (nM - fm) : WGM;
        pm = fm + ((wgid % nig) % gsz); pn = (wgid % nig) / gsz;
    } else if (L < (long)nwg + nsl) {
        const int Ls = (int)(L - nwg);
        const int tile = Ls / S, sl = Ls - tile * S, base = P / S, rem = P - base * S;
        pm = nM + tile / nN; pn = tile % nN; slice = sl; np = base + (sl < rem ? 1 : 0); kp0 = sl * base + (sl < rem ? sl : rem);
    }
}

__device__ __forceinline__ u32x4 pack8(const f32x4& a, const f32x4& b) { u32x4 w; w.x = cvt_pk_bf16(a[0], a[1]); w.y = cvt_pk_bf16(a[2], a[3]); w.z = cvt_pk_bf16(b[0], b[1]); w.w = cvt_pk_bf16(b[2], b[3]); return w; }

__device__ __forceinline__ void epi_plain(const f32x4 (&acc)[2][2][4][2], const Job& J, int rowt, int colb, int wr, int wc, int fr, int fq) {
    bf16_t* O = (bf16_t*)J.out;
#pragma unroll
    for (int ai = 0; ai < 2; ++ai)
#pragma unroll
        for (int m = 0; m < 4; ++m) {
            bf16_t* rowp = O + (size_t)(rowt + ai * HALF + wr * 64 + m * 16 + fr) * J.ldc + colb + wc * 32 + 8 * fq;
#pragma unroll
            for (int bj = 0; bj < 2; ++bj) *(u32x4*)(rowp + bj * HALF) = pack8(acc[ai][bj][m][0], acc[ai][bj][m][1]);
        }
}
__device__ __forceinline__ void epi_rope(const f32x4 (&acc)[2][2][4][2], const Job& J, int rowt, int colb, int wr, int wc, int fr, int fq) {
    bf16_t* O = (bf16_t*)J.out; const float* TC = J.aux; const float* TS = J.aux + 1024;
    const bool anyrope = (rowt < MX) && (colb < 640); const int half = wc & 1, j0 = 8 * (fq & 1); const float sgn = fq < 2 ? -1.f : 1.f;
#pragma unroll
    for (int ai = 0; ai < 2; ++ai)
#pragma unroll
        for (int m = 0; m < 4; ++m) {
            const int grow = rowt + ai * HALF + wr * 64 + m * 16 + fr;
            f32x4 c0 = {1.f, 1.f, 1.f, 1.f}, c1 = c0, s0 = {0.f, 0.f, 0.f, 0.f}, s1 = s0;
            if (anyrope) {
                const int t = grow & (SEQ - 1), pos = half ? (t & 63) : (t >> 6);
                c0 = *(const f32x4*)(TC + pos * 16 + j0); c1 = *(const f32x4*)(TC + pos * 16 + j0 + 4);
                s0 = *(const f32x4*)(TS + pos * 16 + j0); s1 = *(const f32x4*)(TS + pos * 16 + j0 + 4);
            }
#pragma unroll
            for (int bj = 0; bj < 2; ++bj) {
                const int cs = colb + bj * HALF; const bool isq = cs < 512, isk = (cs >= 512) && (cs < 640);
                f32x4 v0 = acc[ai][bj][m][0], v1 = acc[ai][bj][m][1];
                if ((isq || isk) && anyrope) {
                    f32x4 p0, p1;
#pragma unroll
                    for (int e = 0; e < 4; ++e) { p0[e] = __shfl_xor(v0[e], 32); p1[e] = __shfl_xor(v1[e], 32); }
                    v0 = v0 * c0 + (p0 * sgn) * s0; v1 = v1 * c1 + (p1 * sgn) * s1;
                }
                if (isq) { v0 = v0 * QSCALE; v1 = v1 * QSCALE; }
                *(u32x4*)(O + (size_t)grow * J.ldc + cs + wc * 32 + 8 * fq) = pack8(v0, v1);
            }
            asm volatile("" ::: "memory");
        }
}
__device__ __forceinline__ void epi_vt(const f32x4 (&acc)[2][2][4][2], const Job& J, int pm, int pn, int wr, int wc, int fr, int fq) {
    const int s = pm >> 1, c0 = (pm & 1) * 256;
    bf16_t* base; size_t cstride;
    if (pn < MX / 256) { const int b = pn >> 3, t0 = (pn & 7) * 256; base = (bf16_t*)J.out + ((size_t)(b * 512) * 2 + s) * SEQ + t0; cstride = 2 * SEQ; }
    else { const int b = pn - MX / 256; base = (bf16_t*)J.out2 + ((size_t)(b * 512) * 2 + s) * CTXL; cstride = 2 * CTXL; }
#pragma unroll
    for (int ai = 0; ai < 2; ++ai)
#pragma unroll
        for (int m = 0; m < 4; ++m) {
            bf16_t* rowp = base + (size_t)(c0 + ai * HALF + wr * 64 + m * 16 + fr) * cstride + wc * 32 + 8 * fq;
#pragma unroll
            for (int bj = 0; bj < 2; ++bj) *(u32x4*)(rowp + bj * HALF) = pack8(acc[ai][bj][m][0], acc[ai][bj][m][1]);
        }
}
__device__ __forceinline__ void epi_ffn(const f32x4 (&acc)[2][2][4][2], const Job& J, int rowt, int pn, int wr, int wc, int fr, int fq, int lane) {
    bf16_t* O = (bf16_t*)J.out; float* SIDE = (float*)J.out2; const float* cw = J.aux;
    const int col = 128 * pn + 32 * wc + 8 * fq;
    f32x4 w0[2], w1[2], w2[2];
#pragma unroll
    for (int n = 0; n < 2; ++n) { w0[n] = *(const f32x4*)(cw + col + 4 * n); w1[n] = *(const f32x4*)(cw + DFF + col + 4 * n); w2[n] = *(const f32x4*)(cw + 2 * DFF + col + 4 * n); }
    const int srcdn = (lane & 48) | ((fr + 15) & 15), srcup = (lane & 48) | ((fr + 1) & 15);
#pragma unroll
    for (int ai = 0; ai < 2; ++ai) {
        const int blk = (rowt + ai * HALF + wr * 64) >> 6;
        f32x4 cv[4][2];
#pragma unroll
        for (int n = 0; n < 2; ++n)
#pragma unroll
            for (int e = 0; e < 4; ++e) {
                float g[4], dn[4], up[4];
#pragma unroll
                for (int m = 0; m < 4; ++m) { g[m] = acc[ai][0][m][n][e]; dn[m] = __shfl(g[m], srcdn); up[m] = __shfl(g[m], srcup); }
#pragma unroll
                for (int m = 0; m < 4; ++m) {
                    const float pv = fr > 0 ? dn[m] : (m > 0 ? dn[m - 1] : 0.f);
                    const float nx = fr < 15 ? up[m] : (m < 3 ? up[m + 1] : 0.f);
                    cv[m][n][e] = w0[n][e] * pv + w1[n][e] * g[m] + w2[n][e] * nx;
                }
            }
#pragma unroll
        for (int m = 0; m < 4; ++m) {
            const int grow = rowt + ai * HALF + wr * 64 + m * 16 + fr;
            const bool first = (m == 0 && fr == 0), last = (m == 3 && fr == 15);
            if (first || last) {
                float* sp = SIDE + ((size_t)(blk * 2 + (last ? 1 : 0)) * 3) * DFF + col;
#pragma unroll
                for (int n = 0; n < 2; ++n) { *(f32x4*)(sp + 4 * n) = cv[m][n]; *(f32x4*)(sp + DFF + 4 * n) = acc[ai][0][m][n]; *(f32x4*)(sp + 2 * DFF + 4 * n) = acc[ai][1][m][n]; }
            } else {
                f32x4 a0, a1;
#pragma unroll
                for (int e = 0; e < 4; ++e) { a0[e] = silu_f(cv[m][0][e]) * acc[ai][1][m][0][e]; a1[e] = silu_f(cv[m][1][e]) * acc[ai][1][m][1][e]; }
                *(u32x4*)(O + (size_t)grow * DFF + col) = pack8(a0, a1);
            }
        }
    }
}
__device__ __forceinline__ void epi_slab(const f32x4 (&acc)[2][2][4][2], const Job& J, const Unit& u, int wr, int wc, int fr, int fq) {
    const int ld = J.nN * BM;
    float* O = J.slab + ((size_t)u.slice * J.cM * BM + (size_t)(u.pm - J.nM) * BM) * ld + u.pn * BM;
#pragma unroll
    for (int ai = 0; ai < 2; ++ai)
#pragma unroll
        for (int m = 0; m < 4; ++m) {
            float* rowp = O + (size_t)(ai * HALF + wr * 64 + m * 16 + fr) * ld + wc * 32 + 8 * fq;
#pragma unroll
            for (int bj = 0; bj < 2; ++bj) { *(f32x4*)(rowp + bj * HALF) = acc[ai][bj][m][0]; *(f32x4*)(rowp + bj * HALF + 4) = acc[ai][bj][m][1]; }
        }
}
__device__ __forceinline__ void epilogue(const f32x4 (&acc)[2][2][4][2], const Call& C, const Unit& u, int wr, int wc, int fr_, int fq_, int lane) {
    asm volatile("" : "+v"(lane));
    const int fr = lane & 15, fq = lane >> 4;
    const Job& J = C.j0;
    if (u.slice >= 0) epi_slab(acc, J, u, wr, wc, fr, fq);
    else if (J.kind == K_PLAIN) epi_plain(acc, J, J.row0 + u.pm * BM, J.col0 + u.pn * BM, wr, wc, fr, fq);
    else if (J.kind == K_DFT) epi_plain(acc, J, J.row0 + ((u.pn >> 1) * J.p0 + u.pm) * BM, J.col0 + (u.pn & 1) * BM, wr, wc, fr, fq);
    else if (J.kind == K_ROPE) epi_rope(acc, J, J.row0 + u.pm * BM, J.col0 + u.pn * BM, wr, wc, fr, fq);
    else if (J.kind == K_VT) epi_vt(acc, J, u.pm, u.pn, wr, wc, fr, fq);
    else epi_ffn(acc, J, J.row0 + u.pm * BM, u.pn, wr, wc, fr, fq, lane);
}

__device__ __forceinline__ void gemm_phase(LAS unsigned char* lds, const Call& C, const int tid) {
    const int wid = __builtin_amdgcn_readfirstlane(tid >> 6), lane = tid & 63, wr = wid >> 2, wc = wid & 3, fr = lane & 15, fq = lane >> 4;
    unsigned voffA[2], voffB[2];
#pragma unroll
    for (int i = 0; i < 2; ++i) { int R, Cc; stage_rc(tid * 16 + i * 8192, R, Cc); const int Rb = (R & ~31) + perm32(R & 31);
        voffA[i] = (unsigned)(R * C.lda + Cc) * 2u; voffB[i] = (unsigned)(Rb * C.ldb + Cc) * 2u; }
    const size_t kstep = (size_t)(BK * 2);
    const size_t hstepA = (size_t)HALF * C.lda * 2, hstepB = (size_t)HALF * C.ldb * 2;
    const unsigned ldsw = (unsigned)wid * 1024u;
    const int aoff = lds_byte(wr * 64 + fr, fq * 8), boff = lds_byte(wc * 32 + fr, fq * 8);
#define PG8_SA(b, h) (((b) * 2 + (h)) * HTB)
#define PG8_SB(b, h) ((4 + (b) * 2 + (h)) * HTB)
#define PG8_STAGE(bufoff, gbase, voff) do { _Pragma("unroll") for (int _i = 0; _i < 2; ++_i) { unsigned _vo = (voff)[_i]; asm volatile("" : "+v"(_vo));   \
        __builtin_amdgcn_global_load_lds((const unsigned*)((const char*)(gbase) + _vo), (LAS unsigned*)(lds + (bufoff) + ldsw + _i * 8192), 16, 0, 0); } } while (0)
#define PG8_LDA(dst, b, h) do { _Pragma("unroll") for (int m = 0; m < 4; ++m) _Pragma("unroll") for (int k = 0; k < 2; ++k) dst[m][k] = *(const LAS bf16x8*)(lds + PG8_SA(b, h) + aoff + m * 2048 + k * 1024); } while (0)
#define PG8_LDB(dst, b, h) do { _Pragma("unroll") for (int n = 0; n < 2; ++n) _Pragma("unroll") for (int k = 0; k < 2; ++k) dst[n][k] = *(const LAS bf16x8*)(lds + PG8_SB(b, h) + boff + n * 2048 + k * 1024); } while (0)
#define PG8_MMA(ai, bj, At, Bt) do { __builtin_amdgcn_s_setprio(1); _Pragma("unroll") for (int m = 0; m < 4; ++m) _Pragma("unroll") for (int n = 0; n < 2; ++n) _Pragma("unroll") for (int k = 0; k < 2; ++k) \
        acc[ai][bj][m][n] = __builtin_amdgcn_mfma_f32_16x16x32_bf16(Bt[n][k], At[m][k], acc[ai][bj][m][n], 0, 0, 0); __builtin_amdgcn_s_setprio(0); } while (0)
#define PG8_WAIT_V(n) asm volatile("s_waitcnt vmcnt(" #n ")" ::: "memory")
#define PG8_WAIT_L(n) asm volatile("s_waitcnt lgkmcnt(" #n ")" ::: "memory")
#define PG8_BAR __builtin_amdgcn_s_barrier()
#define PG8_SCHED __builtin_amdgcn_sched_barrier(0)
#define PG8_APTR(u) ((const char*)C.j0.A + (size_t)(u).pm * 2 * hstepA + (size_t)(u).kp0 * (4 * BK))
#define PG8_BPTR(u) ((const char*)C.j0.B + (size_t)(u).pn * 2 * hstepB + (size_t)(u).kp0 * (4 * BK))
    Unit cur, nxt; int ui = 0;
    next_unit(C, 0, cur.pm, cur.pn, cur.kp0, cur.np, cur.slice);
    if (cur.pm < 0) return;
    f32x4 acc[2][2][4][2];
#pragma unroll
    for (int a = 0; a < 2; ++a)
#pragma unroll
        for (int b = 0; b < 2; ++b)
#pragma unroll
            for (int m = 0; m < 4; ++m)
#pragma unroll
                for (int n = 0; n < 2; ++n) acc[a][b][m][n] = (f32x4){0.f, 0.f, 0.f, 0.f};
    bf16x8 At[4][2], B0[2][2], B1[2][2];
    const char* cA = PG8_APTR(cur); const char* cB = PG8_BPTR(cur);
    PG8_STAGE(PG8_SB(0, 0), cB, voffB); PG8_STAGE(PG8_SB(0, 1), cB + hstepB, voffB); PG8_STAGE(PG8_SA(0, 0), cA, voffA); PG8_STAGE(PG8_SA(0, 1), cA + hstepA, voffA);
    if (wr == 1) PG8_BAR;
    PG8_WAIT_V(2); PG8_BAR;
    PG8_STAGE(PG8_SB(1, 0), cB + kstep, voffB); PG8_STAGE(PG8_SA(1, 0), cA + kstep, voffA); PG8_STAGE(PG8_SB(1, 1), cB + hstepB + kstep, voffB);
    PG8_WAIT_V(6); PG8_BAR;
    for (;;) {
        next_unit(C, ui + 1, nxt.pm, nxt.pn, nxt.kp0, nxt.np, nxt.slice);
        const bool has_next = nxt.pm >= 0;
        const char* nA = has_next ? PG8_APTR(nxt) : cA; const char* nB = has_next ? PG8_BPTR(nxt) : cB;
        const int nt = 2 * cur.np;
        for (int t = 0; t < nt; t += 2) {
            const bool last = (t == nt - 2);
            const char* a1 = cA + (size_t)(t + 1) * kstep;
            const char* a2 = last ? nA : cA + (size_t)(t + 2) * kstep; const char* b2 = last ? nB : cB + (size_t)(t + 2) * kstep;
            const char* a3 = a2 + kstep; const char* b3 = b2 + kstep;
            PG8_LDB(B0, 0, 0); PG8_LDB(B1, 0, 1); PG8_SCHED; PG8_LDA(At, 0, 0); PG8_STAGE(PG8_SA(1, 1), a1 + hstepA, voffA);
            PG8_WAIT_V(8); PG8_WAIT_L(0); PG8_BAR; PG8_MMA(0, 0, At, B0); PG8_MMA(0, 1, At, B1); PG8_BAR; PG8_SCHED;
            PG8_LDA(At, 0, 1); PG8_STAGE(PG8_SB(0, 0), b2, voffB); PG8_STAGE(PG8_SB(0, 1), b2 + hstepB, voffB); PG8_STAGE(PG8_SA(0, 0), a2, voffA);
            PG8_WAIT_V(8); PG8_WAIT_L(0); PG8_BAR; PG8_MMA(1, 0, At, B0); PG8_MMA(1, 1, At, B1); PG8_BAR; PG8_SCHED;
            PG8_LDB(B0, 1, 0); PG8_LDB(B1, 1, 1); PG8_SCHED; PG8_LDA(At, 1, 0); PG8_STAGE(PG8_SA(0, 1), a2 + hstepA, voffA);
            PG8_WAIT_V(8); PG8_WAIT_L(0); PG8_BAR; PG8_MMA(0, 0, At, B0); PG8_MMA(0, 1, At, B1); PG8_BAR; PG8_SCHED;
            PG8_LDA(At, 1, 1); PG8_STAGE(PG8_SB(1, 0), b3, voffB); PG8_STAGE(PG8_SB(1, 1), b3 + hstepB, voffB); PG8_STAGE(PG8_SA(1, 0), a3, voffA);
            PG8_WAIT_V(8); PG8_WAIT_L(0); PG8_BAR; PG8_MMA(1, 0, At, B0); PG8_MMA(1, 1, At, B1); PG8_BAR; PG8_SCHED;
        }
        if (wr == 0) PG8_BAR;
        epilogue(acc, C, cur, wr, wc, fr, fq, lane);
        if (!has_next) break;
#pragma unroll
        for (int a = 0; a < 2; ++a)
#pragma unroll
            for (int b = 0; b < 2; ++b)
#pragma unroll
                for (int m = 0; m < 4; ++m)
#pragma unroll
                    for (int n = 0; n < 2; ++n) acc[a][b][m][n] = (f32x4){0.f, 0.f, 0.f, 0.f};
        cur.pm = nxt.pm; cur.pn = nxt.pn; cur.kp0 = nxt.kp0; cur.np = nxt.np; cur.slice = nxt.slice; cA = nA; cB = nB; ++ui;
        if (wr == 1) PG8_BAR;
    }
    PG8_WAIT_V(0);
    PG8_BAR;
#undef PG8_SA
#undef PG8_SB
#undef PG8_STAGE
#undef PG8_LDA
#undef PG8_LDB
#undef PG8_MMA
#undef PG8_WAIT_V
#undef PG8_WAIT_L
#undef PG8_BAR
#undef PG8_SCHED
#undef PG8_APTR
#undef PG8_BPTR
}
}

__device__ __forceinline__ void tr_load(const float* src, int ldn, int lane, f32x4 (&v)[8]) {
    const int r8 = lane >> 3, c4 = lane & 7;
#pragma unroll
    for (int i = 0; i < 8; ++i) v[i] = *(const f32x4*)(src + (size_t)(8 * i + r8) * ldn + 4 * c4);
}
__device__ __forceinline__ void tr_finish(const f32x4 (&v)[8], bf16_t* dst, bf16_t* dst2, int ldk, LAS float* scr, int lane) {
    const int r8 = lane >> 3, c4 = lane & 7;
#pragma unroll
    for (int i = 0; i < 8; ++i) { LAS float* w = scr + (8 * i + r8) * 33 + 4 * c4; w[0] = v[i][0]; w[1] = v[i][1]; w[2] = v[i][2]; w[3] = v[i][3]; }
    LDS_WAIT(); asm volatile("" ::: "memory");
    const int c = lane & 7;
#pragma unroll
    for (int j = 0; j < 4; ++j) { const int n = (lane >> 3) + 8 * j; const LAS float* sp = scr + (8 * c) * 33 + n;
        u32x4 o; o.x = cvt_pk_bf16(sp[0 * 33], sp[1 * 33]); o.y = cvt_pk_bf16(sp[2 * 33], sp[3 * 33]); o.z = cvt_pk_bf16(sp[4 * 33], sp[5 * 33]); o.w = cvt_pk_bf16(sp[6 * 33], sp[7 * 33]);
        *(u32x4*)(dst + (size_t)n * ldk + 8 * c) = o; if (dst2) *(u32x4*)(dst2 + (size_t)n * ldk + 8 * c) = o; }
    LDS_WAIT(); asm volatile("" ::: "memory");
}

struct Args { const float* in[18]; float* out; unsigned char* ws; int ph_lo, ph_hi, dry, pad; };

__device__ __forceinline__ void mod_item(LAS unsigned char* lds, const Args& a, int item, int tid) {
    const int l = item >> 6, n0 = 96 * (item & 63);
    const float* cv = a.in[1]; const float* cc = a.in[3]; const float* mw = a.in[4] + (size_t)l * DM * 6144; const float* mb = a.in[5] + l * 6144;
    LAS float* sv = (LAS float*)lds; LAS float* red = (LAS float*)(lds + 40960);
    for (int i = tid; i < 9 * DM; i += NTHR) { const int r = i >> 10, k = i & 1023; const float v = r < 8 ? cv[r * DM + k] : cc[k]; sv[i] = v / (1.0f + __expf(-v)); }
    __syncthreads();
    const int col4 = tid % 24, kg = tid / 24;
    if (kg < 21) {
        f32x4 acc[9];
#pragma unroll
        for (int r = 0; r < 9; ++r) acc[r] = (f32x4){0.f, 0.f, 0.f, 0.f};
#pragma unroll 7
        for (int k = kg; k < DM; k += 21) {
            const f32x4 w = *(const f32x4*)(mw + (size_t)k * 6144 + n0 + 4 * col4);
#pragma unroll
            for (int r = 0; r < 9; ++r) acc[r] += w * sv[r * DM + k];
        }
#pragma unroll
        for (int r = 0; r < 9; ++r)
#pragma unroll
            for (int e = 0; e < 4; ++e) red[(kg * 9 + r) * 96 + 4 * col4 + e] = acc[r][e];
    }
    __syncthreads();
    float* modx = (float*)(a.ws + WS_MODX); float* modc = (float*)(a.ws + WS_MODC);
    for (int idx = tid; idx < 9 * 96; idx += NTHR) {
        const int r = idx / 96, n = idx % 96; float s = mb[n0 + n];
        for (int g = 0; g < 21; ++g) s += red[(g * 9 + r) * 96 + n];
        if (r < 8) modx[((size_t)(l * 8 + r)) * 6144 + n0 + n] = s; else modc[(size_t)l * 6144 + n0 + n] = s;
    }
    __syncthreads();
}

__device__ __forceinline__ void fold_in_item(LAS unsigned char* lds, const Args& a, int item, int tid) {
    const int o = item >> 6, g = (item >> 4) & 3, kc = item & 15;
    const float* W = a.in[11] + (size_t)o * DM * DM; bf16_t* WMI = (bf16_t*)(a.ws + WS_WMI + o * SZ_WMI);
    LAS float* Wl = (LAS float*)lds; const LAS float* tab = (const LAS float*)(lds + LDS_COSTAB);
    LAS float* tc = (LAS float*)(lds + 64 * 129 * 4); LAS float* ts = tc + 128;
    if (tid < 128) { tc[tid] = tab[16 * tid]; ts[tid] = tab[(16 * tid - 512) & 2047]; }
    {   f32x4 t[4];
#pragma unroll
        for (int i = 0; i < 4; ++i) { const int idx = tid + NTHR * i, kk = idx >> 5, j4 = idx & 31; t[i] = *(const f32x4*)(W + (size_t)(64 * kc + kk) * DM + 512 + 128 * g + 4 * j4); }
#pragma unroll
        for (int i = 0; i < 4; ++i) { const int idx = tid + NTHR * i, kk = idx >> 5, j4 = idx & 31; LAS float* w = Wl + kk * 129 + 4 * j4; w[0] = t[i][0]; w[1] = t[i][1]; w[2] = t[i][2]; w[3] = t[i][3]; } }
    __syncthreads();
    const int lane = tid & 63, wv = tid >> 6, i32 = lane & 31, hi = lane >> 5, kh = wv >> 2, jb = wv & 3, jp = 32 * jb + i32;
    f32x16 dc, ds;
#pragma unroll
    for (int r = 0; r < 16; ++r) { dc[r] = 0.f; ds[r] = 0.f; }
    const LAS float* arow = Wl + (32 * kh + i32) * 129 + hi;
#pragma unroll 8
    for (int st = 0; st < 64; ++st) {
        const float av = arow[2 * st]; const int ph = ((2 * st + hi) * jp) & 127;
        dc = __builtin_amdgcn_mfma_f32_32x32x2f32(av, tc[ph], dc, 0, 0, 0);
        ds = __builtin_amdgcn_mfma_f32_32x32x2f32(av, ts[ph], ds, 0, 0, 0);
    }
    bf16_t* oc = WMI + (size_t)(512 + 128 * g + jp) * DM + 64 * kc + 32 * kh + 4 * hi; bf16_t* os = oc + (size_t)512 * DM;
#pragma unroll
    for (int q = 0; q < 4; ++q) {
        u32x2 wc, ws_; wc.x = cvt_pk_bf16(dc[4 * q], dc[4 * q + 1]); wc.y = cvt_pk_bf16(dc[4 * q + 2], dc[4 * q + 3]); ws_.x = cvt_pk_bf16(ds[4 * q], ds[4 * q + 1]); ws_.y = cvt_pk_bf16(ds[4 * q + 2], ds[4 * q + 3]);
        *(u32x2*)(oc + 8 * q) = wc; *(u32x2*)(os + 8 * q) = ws_;
    }
    __syncthreads();
}
__device__ __forceinline__ void fold_out_item(LAS unsigned char* lds, const Args& a, int item, int tid) {
    const int o = item >> 6, g = (item >> 4) & 3, nc = item & 15;
    const float* WG = a.in[12] + (size_t)(o * 4 + g) * 128 * 128; const float* SC = a.in[13] + o * 512 + 128 * g; const float* WO = a.in[14] + (size_t)o * DM * DM + (size_t)(128 * g) * DM + 64 * nc;
    bf16_t* WMO = (bf16_t*)(a.ws + WS_WMO + o * SZ_WMO);
    LAS float* Wg = (LAS float*)lds; LAS float* Wo = (LAS float*)(lds + 66560);
    {   f32x4 t[8], u[4];
#pragma unroll
        for (int i = 0; i < 8; ++i) t[i] = *(const f32x4*)(WG + 4 * (tid + NTHR * i));
#pragma unroll
        for (int i = 0; i < 4; ++i) { const int idx = tid + NTHR * i, d = idx >> 4, n4 = idx & 15; u[i] = *(const f32x4*)(WO + (size_t)d * DM + 4 * n4) * SC[d]; }
#pragma unroll
        for (int i = 0; i < 8; ++i) { const int idx = 4 * (tid + NTHR * i), c = idx >> 7, d = idx & 127; LAS float* w = Wg + c * 129 + d; w[0] = t[i][0]; w[1] = t[i][1]; w[2] = t[i][2]; w[3] = t[i][3]; }
#pragma unroll
        for (int i = 0; i < 4; ++i) { const int idx = tid + NTHR * i, d = idx >> 4, n4 = idx & 15; LAS float* w = Wo + d * 65 + 4 * n4; w[0] = u[i][0]; w[1] = u[i][1]; w[2] = u[i][2]; w[3] = u[i][3]; } }
    __syncthreads();
    const int lane = tid & 63, wv = tid >> 6, i32 = lane & 31, hi = lane >> 5, cb = wv & 3, nb = wv >> 2;
    f32x16 dd;
#pragma unroll
    for (int r = 0; r < 16; ++r) dd[r] = 0.f;
    const LAS float* arow = Wg + (32 * cb + i32) * 129 + hi; const LAS float* bcol = Wo + hi * 65 + 32 * nb + i32;
#pragma unroll 8
    for (int st = 0; st < 64; ++st) dd = __builtin_amdgcn_mfma_f32_32x32x2f32(arow[2 * st], bcol[2 * st * 65], dd, 0, 0, 0);
    bf16_t* op = WMO + (size_t)(64 * nc + 32 * nb + i32) * KMO + 128 * g + 32 * cb + 4 * hi;
#pragma unroll
    for (int q = 0; q < 4; ++q) { u32x2 w; w.x = cvt_pk_bf16(dd[4 * q], dd[4 * q + 1]); w.y = cvt_pk_bf16(dd[4 * q + 2], dd[4 * q + 3]); *(u32x2*)(op + 8 * q) = w; }
    __syncthreads();
}

struct TrDesc { const float* src; bf16_t* dst; bf16_t* dst2; int ldn, ldk; };
__device__ __forceinline__ TrDesc tr_decode(const Args& a, int l, int it) {
    constexpr int I_WIN = 16 * 72, I_WOUT = 16 * 32, I_WMI = 16 * 16, I_WMO = 8 * 32, I_WUP = 16 * 176;
    const bool even = (l & 1) == 0; const int eo = l >> 1;
    const int n1 = even ? I_WIN : I_WMI, n2 = even ? I_WOUT : I_WMO;
    TrDesc d; d.dst2 = nullptr; int r = it;
    if (r < n1) {
        if (even) { const int kb = r / 72, nb = r % 72; d.src = a.in[7] + (size_t)eo * DM * ATT_IN + (size_t)(64 * kb) * ATT_IN + 32 * nb; d.ldn = ATT_IN; d.dst = (bf16_t*)(a.ws + WS_WIN + eo * SZ_WIN) + (size_t)(32 * nb) * DM + 64 * kb; d.ldk = DM; }
        else { const int kb = r / 16, nb = r % 16; d.src = a.in[11] + (size_t)eo * DM * DM + (size_t)(64 * kb) * DM + 32 * nb; d.ldn = DM; d.dst = (bf16_t*)(a.ws + WS_WMI + eo * SZ_WMI) + (size_t)(32 * nb) * DM + 64 * kb; d.ldk = DM; }
        return d; }
    r -= n1;
    if (r < n2) {
        const int kb = r / 32, nb = r % 32;
        if (even) { d.src = a.in[10] + (size_t)eo * DM * DM + (size_t)(64 * kb) * DM + 32 * nb; d.ldn = DM; d.dst = (bf16_t*)(a.ws + WS_WOUT + eo * SZ_WOUT) + (size_t)(32 * nb) * DM + 64 * kb; d.ldk = DM; }
        else { d.src = a.in[14] + (size_t)eo * DM * DM + (size_t)(512 + 64 * kb) * DM + 32 * nb; d.ldn = DM; d.dst = (bf16_t*)(a.ws + WS_WMO + eo * SZ_WMO) + (size_t)(32 * nb) * KMO + 512 + 64 * kb; d.dst2 = d.dst + 512; d.ldk = KMO; }
        return d; }
    r -= n2;
    if (r < I_WUP) { const int kb = r / 176, nb = r % 176, j = nb >> 3, sub = nb & 7; const int scol = sub < 4 ? 128 * j + 32 * sub : DFF + 128 * j + 32 * (sub - 4);
        d.src = a.in[15] + (size_t)l * DM * NUP + (size_t)(64 * kb) * NUP + scol; d.ldn = NUP; d.dst = (bf16_t*)(a.ws + WS_WUP + l * SZ_WUP) + (size_t)(32 * nb) * DM + 64 * kb; d.ldk = DM; return d; }
    r -= I_WUP;
    { const int kb = r / 32, nb = r % 32; d.src = a.in[17] + (size_t)l * DFF * DM + (size_t)(64 * kb) * DM + 32 * nb; d.ldn = DM; d.dst = (bf16_t*)(a.ws + WS_WDN + l * SZ_WDN) + (size_t)(32 * nb) * DFF + 64 * kb; d.ldk = DFF; }
    return d;
}
__device__ __forceinline__ void tr_layer(LAS unsigned char* lds, const Args& a, int l, int wr, int nw, int lane, int wave) {
    LAS float* scr = (LAS float*)(lds + wave * 8448);
    const int NIT = ((l & 1) == 0 ? 16 * 72 + 16 * 32 : 16 * 16 + 8 * 32) + 16 * 176 + 44 * 32;
    for (int it = wr; it < NIT; it += 2 * nw) {
        const bool two = it + nw < NIT;
        const TrDesc d0 = tr_decode(a, l, it), d1 = tr_decode(a, l, two ? it + nw : it);
        f32x4 v0[8], v1[8];
        tr_load(d0.src, d0.ldn, lane, v0); tr_load(d1.src, d1.ldn, lane, v1);
        tr_finish(v0, d0.dst, d0.dst2, d0.ldk, scr, lane);
        if (two) tr_finish(v1, d1.dst, d1.dst2, d1.ldk, scr, lane);
    }
}
__device__ __forceinline__ void fold_layer(LAS unsigned char* lds, const Args& a, int o, int rk, int n, int tid) {
    { LAS float* tab = (LAS float*)(lds + LDS_COSTAB); for (int i = tid; i < 2048; i += NTHR) tab[i] = cospif((float)i * (1.0f / 1024.0f)); }
    __syncthreads();
    for (int it = rk; it < 64; it += n) fold_in_item(lds, a, o * 64 + it, tid);
    for (int it = rk; it < 64; it += n) fold_out_item(lds, a, o * 64 + (it + 64) % 64, tid);
    if (o == 0) {
        const LAS float* tab = (const LAS float*)(lds + LDS_COSTAB);
        const int gt = rk * NTHR + tid, NT = n * NTHR;
        bf16_t* FM = (bf16_t*)(a.ws + WS_FMAT);
        for (int idx = gt; idx < 2048 * 256; idx += NT) {
            const int k = idx >> 8, t0 = (idx & 255) * 8, ph0 = (k * t0) & 2047;
            float c = tab[ph0], sn = tab[(ph0 - 512) & 2047]; const float dc = tab[k], dsn = tab[(k - 512) & 2047];
            float vc[8], vs[8];
#pragma unroll
            for (int e = 0; e < 8; ++e) { vc[e] = c * (1.0f / 512.0f); vs[e] = sn * (-1.0f / 512.0f); const float c2 = c * dc - sn * dsn; sn = sn * dc + c * dsn; c = c2; }
            u32x4 w; w.x = cvt_pk_bf16(vc[0], vc[1]); w.y = cvt_pk_bf16(vc[2], vc[3]); w.z = cvt_pk_bf16(vc[4], vc[5]); w.w = cvt_pk_bf16(vc[6], vc[7]);
            *(u32x4*)(FM + (size_t)k * 4096 + t0) = w;
            w.x = cvt_pk_bf16(vs[0], vs[1]); w.y = cvt_pk_bf16(vs[2], vs[3]); w.z = cvt_pk_bf16(vs[4], vs[5]); w.w = cvt_pk_bf16(vs[6], vs[7]);
            *(u32x4*)(FM + (size_t)k * 4096 + 2048 + t0) = w;
        }
        bf16_t* FC = (bf16_t*)(a.ws + WS_FC); const float nc = 0.005524271728019903f;
        for (int idx = gt; idx < 256 * 64; idx += NT) {
            const int k = idx >> 6, ch = idx & 63, s = ch >> 5, t0 = (ch & 31) * 8; float v[8];
#pragma unroll
            for (int e = 0; e < 8; ++e) { const int ph = ((k * (t0 + e)) & 255) * 8; v[e] = s ? -tab[(ph - 512) & 2047] * nc : tab[ph] * nc; }
            u32x4 w; w.x = cvt_pk_bf16(v[0], v[1]); w.y = cvt_pk_bf16(v[2], v[3]); w.z = cvt_pk_bf16(v[4], v[5]); w.w = cvt_pk_bf16(v[6], v[7]);
            *(u32x4*)(FC + (size_t)k * 512 + ch * 8) = w;
        }
    }
    __syncthreads();
}
__device__ __forceinline__ void prologue_a(LAS unsigned char* lds, const Args& a, int tid, int lane, int wave, int G) {
    const int bx = blockIdx.x;
    for (int it = bx; it < 256; it += G) mod_item(lds, a, it, tid);
    tr_layer(lds, a, 0, bx * NWAVES + wave, G * NWAVES, lane, wave);
    { const int gt = bx * NTHR + tid, NT = G * NTHR; float* TC = (float*)(a.ws + WS_TAB); float* TS = TC + 1024;
      for (int idx = gt; idx < 1024; idx += NT) { const int pos = idx >> 4, j = idx & 15; const float inv = powf(10000.0f, -(float)j / 16.0f); const float ang = (float)pos * inv; TC[idx] = cosf(ang); TS[idx] = sinf(ang); } }
    __syncthreads();
}

__device__ __forceinline__ void ld_row_f32(const float* p, int lane, f32x4 (&v)[4]) {
#pragma unroll
    for (int j = 0; j < 4; ++j) v[j] = *(const f32x4*)(p + 4 * lane + 256 * j);
}
__device__ __forceinline__ float row_rs(const f32x4 (&v)[4]) {
    float s = 0.f;
#pragma unroll
    for (int j = 0; j < 4; ++j) s += (v[j][0] * v[j][0] + v[j][1] * v[j][1]) + (v[j][2] * v[j][2] + v[j][3] * v[j][3]);
    return __builtin_amdgcn_rsqf(wave_sum(s) * (1.0f / DM) + EPS);
}
__device__ __forceinline__ void norm_mod_store(const f32x4 (&x)[4], const float* gain, const float* sc, const float* sh, bf16_t* hrow, int lane) {
    const float rs = row_rs(x);
#pragma unroll
    for (int j = 0; j < 4; ++j) {
        const int c = 4 * lane + 256 * j;
        const f32x4 g = *(const f32x4*)(gain + c), s1 = *(const f32x4*)(sc + c), s0 = *(const f32x4*)(sh + c);
        const f32x4 h = (x[j] * rs * g) * (s1 + 1.0f) + s0;
        u32x2 w; w.x = cvt_pk_bf16(h[0], h[1]); w.y = cvt_pk_bf16(h[2], h[3]);
        *(u32x2*)(hrow + c) = w;
    }
}
typedef GAS const float* gcf;
struct RowRegs { f32x4 x[4], y[4], gt[4], sc[4], sh[4]; };
struct RowCtx { gcf xsX, xsC, modx, modc, slab; GAS const bf16_t* Y; int layer, which, ns, lane; bool do_norm; };
__device__ __forceinline__ void row_load(RowRegs& R, const RowCtx& c, int row) {
    const bool isx = row < MX; const int b = row >> 11, lane = c.lane;
    gcf xi = isx ? c.xsX + (size_t)row * DM : c.xsC + (size_t)(row - MX) * DM;
#pragma unroll
    for (int j = 0; j < 4; ++j) R.x[j] = *(const GAS f32x4*)(xi + 4 * lane + 256 * j);
    gcf mod = isx ? c.modx + (size_t)(c.layer * 8 + b) * 6144 : c.modc + (size_t)c.layer * 6144;
    gcf modn = (c.which == 2) ? mod + (isx ? 8 * 6144 : 6144) : mod;
    const int so = c.which == 1 ? 4096 : 1024, ho = c.which == 1 ? 3072 : 0;
    if (c.do_norm) {
#pragma unroll
        for (int j = 0; j < 4; ++j) { R.sc[j] = *(const GAS f32x4*)(modn + so + 4 * lane + 256 * j); R.sh[j] = *(const GAS f32x4*)(modn + ho + 4 * lane + 256 * j); }
    }
    if (c.which != 0) {
        gcf gate = mod + (c.which == 1 ? 2048 : 5120);
#pragma unroll
        for (int j = 0; j < 4; ++j) R.gt[j] = *(const GAS f32x4*)(gate + 4 * lane + 256 * j);
        if (isx) {
#pragma unroll
            for (int j = 0; j < 4; ++j) { const u32x2 w = *(const GAS u32x2*)(c.Y + (size_t)row * DM + 4 * lane + 256 * j); R.y[j] = (f32x4){bf_lo(w.x), bf_hi(w.x), bf_lo(w.y), bf_hi(w.y)}; }
        } else {
            gcf sl = c.slab + (size_t)(row - MX) * DM;
#pragma unroll
            for (int j = 0; j < 4; ++j) R.y[j] = *(const GAS f32x4*)(sl + 4 * lane + 256 * j);
            for (int k = 1; k < c.ns; ++k)
#pragma unroll
                for (int j = 0; j < 4; ++j) R.y[j] += *(const GAS f32x4*)(sl + (size_t)k * MC * DM + 4 * lane + 256 * j);
        }
    }
}
__device__ __forceinline__ void row_finish(RowRegs& R, const RowCtx& c, int row, const f32x4 (&gA)[4], const f32x4 (&gB)[4], GAS float* xo, GAS bf16_t* ho) {
    const int lane = c.lane;
    if (c.which != 0) {
        const float rsy = row_rs(R.y);
#pragma unroll
        for (int j = 0; j < 4; ++j) { R.x[j] = R.x[j] + R.gt[j] * (R.y[j] * rsy * gA[j]); *(GAS f32x4*)(xo + 4 * lane + 256 * j) = R.x[j]; }
    }
    if (c.do_norm) {
        const float rs = row_rs(R.x);
#pragma unroll
        for (int j = 0; j < 4; ++j) {
            const f32x4 h = (R.x[j] * rs * gB[j]) * (R.sc[j] + 1.0f) + R.sh[j];
            u32x2 w; w.x = cvt_pk_bf16(h[0], h[1]); w.y = cvt_pk_bf16(h[2], h[3]);
            *(GAS u32x2*)(ho + 4 * lane + 256 * j) = w;
        }
    }
}
__device__ __forceinline__ void row_phase(const Args& a, int layer, int which, int nrows, int lane, int gw, int NGW) {
    RowCtx c; c.layer = layer; c.which = which; c.lane = lane; c.do_norm = !(which == 2 && layer == DEPTH - 1);
    c.modx = (gcf)(a.ws + WS_MODX); c.modc = (gcf)(a.ws + WS_MODC); c.Y = (GAS const bf16_t*)(a.ws + WS_Y);
    c.slab = (gcf)(a.ws + (which == 1 ? WS_BIG : WS_MIX)); c.ns = which == 1 ? SL_OUT : SL_DN;
    GAS float* hctx = (GAS float*)(a.ws + WS_HCTX); GAS float* xoX = a.dry ? (GAS float*)(a.ws + WS_BIG) : (GAS float*)a.out; GAS bf16_t* HX = (GAS bf16_t*)(a.ws + WS_HX);
    const bool first = layer == 0 && which < 2;
    c.xsX = first ? (gcf)a.in[0] : (gcf)a.out; c.xsC = first ? (gcf)a.in[2] : (gcf)hctx;
    gcf gains = (gcf)a.in[6];
    f32x4 gA[4], gB[4];
    { gcf pa = gains + (layer * 4 + (which == 1 ? 1 : 3)) * DM; gcf pb = gains + ((which == 2 ? layer + 1 : layer) * 4 + (which == 1 ? 2 : 0)) * DM;
      if (!c.do_norm) pb = pa;
#pragma unroll
      for (int j = 0; j < 4; ++j) { gA[j] = *(const GAS f32x4*)(pa + 4 * lane + 256 * j); gB[j] = *(const GAS f32x4*)(pb + 4 * lane + 256 * j); } }
    const int nX = (MX + NGW - 1) / NGW, nC = nrows > MX ? (nrows - MX + NGW - 1) / NGW : 0;
    for (int i = 0; i < nX + nC; i += 2) {
        int rowA = i < nX ? gw * nX + i : MX + gw * nC + (i - nX); const int lim = i < nX ? MX : nrows;
        int rowB = i + 1 < nX ? gw * nX + i + 1 : MX + gw * nC + (i + 1 - nX); const int limB = i + 1 < nX ? MX : nrows;
        const bool okA = rowA < lim, two = okA && (i + 1 < nX + nC) && rowB < limB;
        if (!okA) { if (i + 1 < nX + nC && rowB < limB) { rowA = rowB; } else continue; }
        if (!two) rowB = rowA;
        RowRegs A, B;
        row_load(A, c, rowA); row_load(B, c, rowB);
        row_finish(A, c, rowA, gA, gB, rowA < MX ? xoX + (size_t)rowA * DM : hctx + (size_t)(rowA - MX) * DM, HX + (size_t)rowA * DM);
        if (two) row_finish(B, c, rowB, gA, gB, rowB < MX ? xoX + (size_t)rowB * DM : hctx + (size_t)(rowB - MX) * DM, HX + (size_t)rowB * DM);
    }
}

typedef short v4i16_t __attribute__((ext_vector_type(4)));
constexpr int AT_KP = 144, AT_VP = 192;
constexpr int AT_KB = 128 * AT_KP, AT_VB = 128 * AT_VP, AT_BUF = AT_KB + AT_VB, AT_STG = 2 * AT_BUF, AT_STGW = 32 * 144, AT_SCR = AT_STG + 8 * AT_STGW;
static_assert(AT_SCR + 8 * 256 <= RING_BYTES, "attention LDS map");
constexpr float AT_THR = 8.0f;
__device__ __forceinline__ int crow(int r, int hi) { return (r & 3) + 8 * (r >> 2) + 4 * hi; }

__device__ __forceinline__ void attn_unit(LAS unsigned char* lds, const bf16_t* U, bf16_t* MIXo, const float* sink8, int b, int hk, int qrow0, int qpos0, bool latent, int tid) {
    const int lane = tid & 63, r32 = lane & 31, hi = lane >> 5, wid = __builtin_amdgcn_readfirstlane(tid >> 6);
    const int hq = 4 * hk + (wid >> 1), rowoff = 32 * (wid & 1), qa = qpos0 + rowoff;
    const int ctxrow0 = MX + b * CTXL, nst = latent ? 5 : 2;
    bf16x8 qf[4];
#pragma unroll
    for (int d0 = 0; d0 < 4; ++d0) qf[d0] = *(const bf16x8*)(U + (size_t)(qrow0 + rowoff + r32) * ATT_IN + hq * 64 + 16 * d0 + 8 * hi);
    const float sink2 = sink8[hq] * LOG2E;
    float mref = sink2, lsum = hi == 0 ? 1.f : 0.f;
    f32x16 o0, o1, negm;
#pragma unroll
    for (int r = 0; r < 16; ++r) { o0[r] = 0.f; o1[r] = 0.f; negm[r] = -sink2; }
    volatile LAS float* scr = (volatile LAS float*)(lds + AT_SCR) + wid * 64;
    const int skey = tid >> 3, sch = tid & 7;
    u32x4 kr0, kr1, vr0, vr1;
#define AT_ROW(st, key) ((st) < 2 ? ctxrow0 + 128 * (st) + (key) : b * SEQ + min(max(qpos0 - 128 + 128 * ((st) - 2) + (key), 0), SEQ - 1))
#define AT_LOAD(st) do { const bf16_t* p0_ = U + (size_t)AT_ROW(st, skey) * ATT_IN + 512 + hk * 64 + 8 * sch; const bf16_t* p1_ = U + (size_t)AT_ROW(st, skey + 64) * ATT_IN + 512 + hk * 64 + 8 * sch; \
        kr0 = *(const u32x4*)p0_; vr0 = *(const u32x4*)(p0_ + 128); kr1 = *(const u32x4*)p1_; vr1 = *(const u32x4*)(p1_ + 128); } while (0)
#define AT_WRITE(bufi) do { LAS unsigned char* kb_ = lds + (bufi) * AT_BUF; LAS unsigned char* vb_ = kb_ + AT_KB; \
        *(LAS u32x4*)(kb_ + skey * AT_KP + sch * 16) = kr0; *(LAS u32x4*)(kb_ + (skey + 64) * AT_KP + sch * 16) = kr1; \
        *(LAS u32x4*)(vb_ + skey * AT_VP + sch * 16) = vr0; *(LAS u32x4*)(vb_ + (skey + 64) * AT_VP + sch * 16) = vr1; } while (0)
    AT_LOAD(0); AT_WRITE(0);
    __syncthreads();
    for (int st = 0; st < nst; ++st) {
        if (st + 1 < nst) AT_LOAD(st + 1);
        const LAS unsigned char* kbuf = lds + (st & 1) * AT_BUF; const LAS unsigned char* vbuf = kbuf + AT_KB;
        const bool win = st >= 2;
#pragma unroll
        for (int h = 0; h < 2; ++h) {
            const int kp = qpos0 - 128 + 128 * (st - 2) + 64 * h;
            if (win && (kp < 0 || kp >= SEQ || kp > qa + 159 || kp + 63 < qa - 128)) continue;
            const bool needmask = win && !(qa + 31 - kp <= 128 && kp + 63 - qa <= 128);
            const LAS unsigned char* kb = kbuf + (64 * h + r32) * AT_KP + 16 * hi;
            f32x16 p0 = negm, p1 = negm;
#pragma unroll
            for (int d0 = 0; d0 < 4; ++d0) {
                const bf16x8 k0 = *(const LAS bf16x8*)(kb + 32 * d0), k1 = *(const LAS bf16x8*)(kb + 32 * AT_KP + 32 * d0);
                p0 = __builtin_amdgcn_mfma_f32_32x32x16_bf16(k0, qf[d0], p0, 0, 0, 0); p1 = __builtin_amdgcn_mfma_f32_32x32x16_bf16(k1, qf[d0], p1, 0, 0, 0);
            }
            if (needmask) {
                const int qpos = qa + r32;
#pragma unroll
                for (int r = 0; r < 16; ++r) { const int kq = kp + crow(r, hi); int d0_ = qpos - kq; d0_ = d0_ < 0 ? -d0_ : d0_; int d1_ = qpos - (kq + 32); d1_ = d1_ < 0 ? -d1_ : d1_;
                    if (d0_ > 128) p0[r] = -INFINITY; if (d1_ > 128) p1[r] = -INFINITY; }
            }
            float mx = fmaxf(fmaxf(p0[0], p0[1]), p1[0]);
#pragma unroll
            for (int r = 2; r < 16; r += 2) mx = fmaxf(fmaxf(mx, p0[r]), p0[r + 1]);
#pragma unroll
            for (int r = 1; r < 15; r += 2) mx = fmaxf(fmaxf(mx, p1[r]), p1[r + 1]);
            mx = fmaxf(mx, p1[15]);
            mx = fmaxf(mx, __shfl_xor(mx, 32));
            if (__any(mx > AT_THR)) {
                const float dl = fmaxf(mx, 0.f), f = __builtin_amdgcn_exp2f(-dl);
                mref += dl; lsum *= f;
#pragma unroll
                for (int r = 0; r < 16; ++r) { p0[r] -= dl; p1[r] -= dl; negm[r] = -mref; }
                if (hi == 0) scr[r32] = f;
                LDS_WAIT();
#pragma unroll
                for (int r = 0; r < 16; ++r) { const float al = scr[crow(r, hi)]; o0[r] *= al; o1[r] *= al; }
                LDS_WAIT();
            }
            float rsum = 0.f;
#pragma unroll
            for (int r = 0; r < 16; ++r) { p0[r] = __builtin_amdgcn_exp2f(p0[r]); p1[r] = __builtin_amdgcn_exp2f(p1[r]); rsum += p0[r] + p1[r]; }
            lsum += rsum;
            bf16x8 pa[4];
#pragma unroll
            for (int s2 = 0; s2 < 2; ++s2) {
                u32x4 w0, w1;
                w0.x = cvt_pk_bf16(p0[8 * s2 + 0], p0[8 * s2 + 1]); w0.y = cvt_pk_bf16(p0[8 * s2 + 2], p0[8 * s2 + 3]); w0.z = cvt_pk_bf16(p0[8 * s2 + 4], p0[8 * s2 + 5]); w0.w = cvt_pk_bf16(p0[8 * s2 + 6], p0[8 * s2 + 7]);
                w1.x = cvt_pk_bf16(p1[8 * s2 + 0], p1[8 * s2 + 1]); w1.y = cvt_pk_bf16(p1[8 * s2 + 2], p1[8 * s2 + 3]); w1.z = cvt_pk_bf16(p1[8 * s2 + 4], p1[8 * s2 + 5]); w1.w = cvt_pk_bf16(p1[8 * s2 + 6], p1[8 * s2 + 7]);
                pa[s2] = __builtin_bit_cast(bf16x8, w0); pa[2 + s2] = __builtin_bit_cast(bf16x8, w1);
            }
            const LAS unsigned char* vb = vbuf + (64 * h + 4 * hi + ((lane & 15) >> 2)) * AT_VP + ((lane >> 4) & 1) * 32 + (lane & 3) * 8;
#pragma unroll
            for (int s = 0; s < 4; ++s) {
#pragma unroll
                for (int d = 0; d < 2; ++d) {
                    const v4i16_t lo = __builtin_amdgcn_ds_read_tr16_b64_v4i16((LAS v4i16_t*)(vb + 16 * s * AT_VP + 64 * d));
                    const v4i16_t hh = __builtin_amdgcn_ds_read_tr16_b64_v4i16((LAS v4i16_t*)(vb + (16 * s + 8) * AT_VP + 64 * d));
                    const bf16x8 vf = (bf16x8){lo[0], lo[1], lo[2], lo[3], hh[0], hh[1], hh[2], hh[3]};
                    if (d == 0) o0 = __builtin_amdgcn_mfma_f32_32x32x16_bf16(pa[s], vf, o0, 0, 0, 0); else o1 = __builtin_amdgcn_mfma_f32_32x32x16_bf16(pa[s], vf, o1, 0, 0, 0);
                }
            }
        }
        if (st + 1 < nst) AT_WRITE((st + 1) & 1);
        __syncthreads();
    }
    {
        const float lt = lsum + __shfl_xor(lsum, 32);
        if (hi == 0) scr[r32] = 1.0f / lt;
        LDS_WAIT();
        LAS unsigned short* stg = (LAS unsigned short*)(lds + AT_STG + wid * AT_STGW);
#pragma unroll
        for (int r = 0; r < 16; ++r) { const int q = crow(r, hi); const float il = scr[q];
            stg[q * 72 + r32] = (unsigned short)(cvt_pk_bf16(o0[r] * il, 0.f) & 0xffffu); stg[q * 72 + 32 + r32] = (unsigned short)(cvt_pk_bf16(o1[r] * il, 0.f) & 0xffffu); }
        LDS_WAIT();
#pragma unroll
        for (int i = 0; i < 4; ++i) { const int row = i * 8 + (lane >> 3), ch = lane & 7; const u32x4 v = *(const LAS u32x4*)((const LAS unsigned char*)stg + row * 144 + ch * 16);
            *(u32x4*)(MIXo + (size_t)(qrow0 + rowoff + row) * KMO + hq * 64 + 8 * ch) = v; }
        LDS_WAIT();
    }
#undef AT_ROW
#undef AT_LOAD
#undef AT_WRITE
}

__device__ __forceinline__ u32x4 ld16(const bf16_t* p) { return *(const u32x4*)p; }
__device__ __forceinline__ void unpack8(const u32x4& w, float (&f)[8]) { f[0] = bf_lo(w.x); f[1] = bf_hi(w.x); f[2] = bf_lo(w.y); f[3] = bf_hi(w.y); f[4] = bf_lo(w.z); f[5] = bf_hi(w.z); f[6] = bf_lo(w.w); f[7] = bf_hi(w.w); }

__device__ __forceinline__ void sconv_pass(const Args& a, int e, int nrows, int gt, int NT) {
    const bf16_t* U = (const bf16_t*)(a.ws + WS_BIG); bf16_t* MIXo = (bf16_t*)(a.ws + WS_MIX); const float* cw = a.in[9] + (size_t)e * 3 * 512;
    for (int idx = gt; idx < nrows * 64; idx += NT) {
        const int row = idx >> 6, ch = idx & 63;
        const int t = row < MX ? (row & (SEQ - 1)) : ((row - MX) & (CTXL - 1)), T = row < MX ? SEQ : CTXL;
        const bf16_t* up = U + (size_t)row * ATT_IN + 8 * ch;
        float bv[8], acc[8];
        unpack8(ld16(up + 768), bv);
#pragma unroll
        for (int q = 0; q < 8; ++q) acc[q] = 0.f;
#pragma unroll
        for (int j = 0; j < 3; ++j) {
            const int tt = t + j - 1;
            if (tt >= 0 && tt < T) {
                float cvv[8], zv[8];
                unpack8(ld16(up + (ptrdiff_t)(j - 1) * ATT_IN + 1280), cvv); unpack8(ld16(up + (ptrdiff_t)(j - 1) * ATT_IN + 1792), zv);
                const f32x4 w0 = *(const f32x4*)(cw + j * 512 + 8 * ch), w1 = *(const f32x4*)(cw + j * 512 + 8 * ch + 4);
#pragma unroll
                for (int q = 0; q < 4; ++q) { acc[q] += w0[q] * (cvv[q] * zv[q]); acc[4 + q] += w1[q] * (cvv[4 + q] * zv[4 + q]); }
            }
        }
        u32x4 w; w.x = cvt_pk_bf16(bv[0] * acc[0], bv[1] * acc[1]); w.y = cvt_pk_bf16(bv[2] * acc[2], bv[3] * acc[3]); w.z = cvt_pk_bf16(bv[4] * acc[4], bv[5] * acc[5]); w.w = cvt_pk_bf16(bv[6] * acc[6], bv[7] * acc[7]);
        *(u32x4*)(MIXo + (size_t)row * KMO + 512 + 8 * ch) = w;
    }
}
__device__ __forceinline__ void pool_pass(const Args& a, int nrows, int gt, int NT) {
    const bf16_t* UP = (const bf16_t*)(a.ws + WS_UPOOL); bf16_t* MIXo = (bf16_t*)(a.ws + WS_MIX);
    for (int idx = gt; idx < nrows * 64; idx += NT) {
        const int row = idx >> 6, ch = idx & 63, g = ch >> 4, hw = 1 << g;
        const int t = row < MX ? (row & (SEQ - 1)) : ((row - MX) & (CTXL - 1)), T = row < MX ? SEQ : CTXL;
        const int lo = t - hw < 0 ? 0 : t - hw, hi = t + hw > T ? T : t + hw;
        const bf16_t* up = UP + (size_t)row * 512 + 8 * ch;
        float acc[8], f[8];
#pragma unroll
        for (int q = 0; q < 8; ++q) acc[q] = 0.f;
        for (int s = lo; s < hi; ++s) { unpack8(ld16(up + (ptrdiff_t)(s - t) * 512), f);
#pragma unroll
            for (int q = 0; q < 8; ++q) acc[q] += f[q]; }
        unpack8(ld16(up), f);
        const float inv = 1.0f / (float)(hi - lo);
#pragma unroll
        for (int q = 0; q < 8; ++q) acc[q] = acc[q] * inv - f[q];
        u32x4 w; w.x = cvt_pk_bf16(acc[0], acc[1]); w.y = cvt_pk_bf16(acc[2], acc[3]); w.z = cvt_pk_bf16(acc[4], acc[5]); w.w = cvt_pk_bf16(acc[6], acc[7]);
        *(u32x4*)(MIXo + (size_t)row * KMO + 8 * ch) = w;
    }
}
__device__ __forceinline__ void ffn_fixup(const Args& a, int layer, int nrows, int gt, int NT) {
    const float* SIDE = (const float*)(a.ws + WS_SIDE); bf16_t* ACT = (bf16_t*)(a.ws + WS_BIG); const float* cw = a.in[16] + (size_t)layer * 3 * DFF;
    const int nblk = nrows >> 6;
    for (int idx = gt; idx < nblk * 2 * (DFF / 4); idx += NT) {
        const int c4 = idx % (DFF / 4), bw = idx / (DFF / 4), blk = bw >> 1, which = bw & 1, col = 4 * c4;
        const int row = blk * 64 + (which ? 63 : 0);
        const int sb = row < MX ? (blk & 31) : ((blk - MX / 64) & 3), nsb = row < MX ? 32 : 4;
        const float* sp = SIDE + ((size_t)(blk * 2 + which) * 3) * DFF + col;
        f32x4 cv = *(const f32x4*)sp; const f32x4 vv = *(const f32x4*)(sp + 2 * DFF);
        if (which == 0 && sb > 0) { const f32x4 gl = *(const f32x4*)(SIDE + ((size_t)((blk - 1) * 2 + 1) * 3 + 1) * DFF + col); cv += *(const f32x4*)(cw + col) * gl; }
        if (which == 1 && sb < nsb - 1) { const f32x4 gf = *(const f32x4*)(SIDE + ((size_t)((blk + 1) * 2 + 0) * 3 + 1) * DFF + col); cv += *(const f32x4*)(cw + 2 * DFF + col) * gf; }
        u32x2 w; w.x = cvt_pk_bf16(silu_f(cv[0]) * vv[0], silu_f(cv[1]) * vv[1]); w.y = cvt_pk_bf16(silu_f(cv[2]) * vv[2], silu_f(cv[3]) * vv[3]);
        *(u32x2*)(ACT + (size_t)row * DFF + col) = w;
    }
}

constexpr int STEPS_PER_LAYER = 13, N_STEPS = 2 + STEPS_PER_LAYER * DEPTH;
enum { ST_NOP = 0, ST_PRO, ST_ROW, ST_GEMM, ST_ATT, ST_POOL, ST_FIX };

__global__ void __launch_bounds__(NTHR, 2) dit_fwd(Args args) {
    extern __shared__ __attribute__((aligned(16))) unsigned char lds_raw[];
    LAS unsigned char* lds = (LAS unsigned char*)lds_raw;
    for (int u = threadIdx.x; u < (LDS_BYTES - LDSCTL_OFF) / 4; u += NTHR) ((LAS unsigned*)(lds + LDSCTL_OFF))[u] = 0u;
    __syncthreads();
    XcdBarrier bar; bar.bar = (unsigned*)(args.ws + WS_CTL) + CW_BAR; bar.x = 0; bar.st = nullptr;
    if (!MK_PER_PHASE) bar = xcd_barrier_post((unsigned*)(args.ws + WS_CTL) + CW_BAR, (volatile LAS unsigned*)(lds + MISC_OFF) + 8);

    for (int st = args.ph_lo; st < args.ph_hi; ++st) {
        int tid = threadIdx.x; asm volatile("" : "+v"(tid));
        int G = gridDim.x, bx = blockIdx.x; asm volatile("" : "+s"(G), "+s"(bx));
        unsigned char* ws = args.ws; asm volatile("" : "+s"(ws));
        const int lane = tid & 63, wave = __builtin_amdgcn_readfirstlane(tid >> 6);
        bf16_t* HX = (bf16_t*)(ws + WS_HX); bf16_t* Yb = (bf16_t*)(ws + WS_Y); bf16_t* MIXb = (bf16_t*)(ws + WS_MIX); bf16_t* BIG = (bf16_t*)(ws + WS_BIG);
        int kind = ST_NOP, l = 0, sub = -1, rw = 0, coff = 0; bool seam = false;
        if (st == 0) { kind = ST_PRO; seam = true; }
        else if (st == 1) { kind = ST_ROW; rw = 0; seam = true; }
        else if (st >= N_STEPS) { seam = true; }
        else { l = (st - 2) / STEPS_PER_LAYER; sub = (st - 2) % STEPS_PER_LAYER; }
        const bool even = (l & 1) == 0; const int eo = l >> 1;
        const bool ctx_live = l < 2;
        const int nrows = ctx_live ? MT : MX, nMt = nrows / 256;
        gm::Call C{}; C.G = G;
        if (sub == 0) {
            kind = ST_GEMM; C.K = DM; C.lda = DM; C.ldb = DM;
            if (even) C.j0 = gm::Job{HX, (const bf16_t*)(ws + WS_WIN + eo * SZ_WIN), BIG, (const float*)(ws + WS_TAB), nullptr, nMt, ATT_IN / 256, gm::K_ROPE, ATT_IN, 0, 0, 0, 0, 1, nullptr};
            else C.j0 = gm::Job{(const bf16_t*)(ws + WS_WMI + eo * SZ_WMI) + (size_t)512 * DM, HX, ws + WS_VT, nullptr, ws + WS_VTC, 4, nMt, gm::K_VT, 0, 0, 0, 0, 0, 1, nullptr};
        } else if (sub == 1) {
            seam = true; C.K = DM; C.lda = DM; C.ldb = DM;
            if (!even) { kind = ST_GEMM; coff = (4 * nMt) % G; C.j0 = gm::Job{HX, (const bf16_t*)(ws + WS_WMI + eo * SZ_WMI), ws + WS_UPOOL, nullptr, nullptr, nMt, 2, gm::K_PLAIN, 512, 0, 0, 0, 0, 1, nullptr}; }
            else if (l == 2) { kind = ST_GEMM; coff = (64 * 9) % G;
                C.j0 = gm::Job{HX + (size_t)MX * DM, (const bf16_t*)(ws + WS_WIN + eo * SZ_WIN) + (size_t)512 * DM, BIG, (const float*)(ws + WS_TAB), nullptr, MC / 256, 1, gm::K_ROPE, ATT_IN, MX, 512, 0, 0, 1, nullptr}; }
        } else if (sub == 2) {
            if (even) { kind = ST_ATT; seam = true; }
            else { kind = ST_GEMM; C.K = SEQ; C.lda = 2 * SEQ; C.ldb = 2 * SEQ;
                C.j0 = gm::Job{(const bf16_t*)(ws + WS_FMAT), (const bf16_t*)(ws + WS_VT), MIXb, nullptr, nullptr, 8, 16, gm::K_DFT, KMO, 0, 512, 8, 0, 1, nullptr}; }
        } else if (sub == 3) {
            if (!even) { kind = ST_GEMM; coff = 128 % G; C.K = SEQ; C.lda = 2 * SEQ; C.ldb = 2 * SEQ;
                C.j0 = gm::Job{(const bf16_t*)(ws + WS_FMAT) + SEQ, (const bf16_t*)(ws + WS_VT) + SEQ, MIXb, nullptr, nullptr, 8, 16, gm::K_DFT, KMO, 0, 1024, 8, 0, 1, nullptr}; }
        } else if (sub == 4) {
            if (!even && ctx_live) { kind = ST_GEMM; C.K = CTXL; C.lda = 2 * CTXL; C.ldb = 2 * CTXL;
                C.j0 = gm::Job{(const bf16_t*)(ws + WS_FC), (const bf16_t*)(ws + WS_VTC), MIXb, nullptr, nullptr, 1, 16, gm::K_DFT, KMO, MX, 512, 1, 0, 1, nullptr}; }
        } else if (sub == 5) {
            if (!even && ctx_live) { kind = ST_GEMM; coff = 16 % G; C.K = CTXL; C.lda = 2 * CTXL; C.ldb = 2 * CTXL;
                C.j0 = gm::Job{(const bf16_t*)(ws + WS_FC) + CTXL, (const bf16_t*)(ws + WS_VTC) + CTXL, MIXb, nullptr, nullptr, 1, 16, gm::K_DFT, KMO, MX, 1024, 1, 0, 1, nullptr}; }
        } else if (sub == 6) {
            if (!even) { kind = ST_POOL; seam = true; }
        } else if (sub == 7) {
            kind = ST_GEMM; seam = true; C.lda = KMO;
            if (even) { C.K = DM; C.ldb = DM; C.j0 = gm::Job{MIXb, (const bf16_t*)(ws + WS_WOUT + eo * SZ_WOUT), Yb, nullptr, nullptr, MX / 256, 4, gm::K_PLAIN, DM, 0, 0, 0, nMt - MX / 256, SL_OUT, (float*)(ws + WS_BIG)}; }
            else { C.K = KMO; C.ldb = KMO; C.j0 = gm::Job{MIXb, (const bf16_t*)(ws + WS_WMO + eo * SZ_WMO), Yb, nullptr, nullptr, MX / 256, 4, gm::K_PLAIN, DM, 0, 0, 0, nMt - MX / 256, SL_OUT, (float*)(ws + WS_BIG)}; }
        } else if (sub == 8) { kind = ST_ROW; rw = 1; seam = true; }
        else if (sub == 9) {
            kind = ST_GEMM; seam = true; C.K = DM; C.lda = DM; C.ldb = DM;
            C.j0 = gm::Job{HX, (const bf16_t*)(ws + WS_WUP + l * SZ_WUP), BIG, args.in[16] + (size_t)l * 3 * DFF, ws + WS_SIDE, nMt, NUP / 256, gm::K_FFN, DFF, 0, 0, 0, 0, 1, nullptr};
        } else if (sub == 10) { kind = ST_FIX; seam = true; }
        else if (sub == 11) {
            kind = ST_GEMM; seam = true; C.K = DFF; C.lda = DFF; C.ldb = DFF;
            C.j0 = gm::Job{BIG, (const bf16_t*)(ws + WS_WDN + l * SZ_WDN), Yb, nullptr, nullptr, MX / 256, 4, gm::K_PLAIN, DM, 0, 0, 0, nMt - MX / 256, SL_DN, (float*)(ws + WS_MIX)};
        } else if (sub == 12) { kind = ST_ROW; rw = 2; seam = true; }
        C.c = bx >= coff ? bx - coff : bx - coff + G;

        if (kind == ST_GEMM) {
            gm::gemm_phase(lds, C, tid);
            const bool hostA = (sub == 0 && even && l + 1 < DEPTH), hostB = (sub == 9 && l + 1 < DEPTH);
            if (hostA || hostB) {
                const int total = C.j0.nM * C.j0.nN, rem = total % G;
                const int rk = rem ? C.c - rem : C.c, n = rem ? G - rem : G;
                if (rk >= 0) { if (hostA) fold_layer(lds, args, l >> 1, rk, n, tid); else tr_layer(lds, args, l + 1, rk * NWAVES + wave, n * NWAVES, lane, wave); __syncthreads(); }
            }
        }
        else if (kind == ST_PRO) prologue_a(lds, args, tid, lane, wave, G);
        else if (kind == ST_ROW) row_phase(args, l, rw, rw == 0 ? MT : nrows, lane, bx * NWAVES + wave, G * NWAVES);
        else if (kind == ST_ATT) {
            const float* sink = args.in[8] + eo * 8;
            for (int u = bx; u < 512 + (l == 0 ? 64 : 0); u += G) {
                if (u < 512) { const int bh = u >> 5, i = u & 31, b = bh >> 1, hk = bh & 1; attn_unit(lds, BIG, MIXb, sink, b, hk, b * SEQ + 64 * i, 64 * i, true, tid); }
                else { const int v = u - 512, bh = v >> 2, i = v & 3, b = bh >> 1, hk = bh & 1; attn_unit(lds, BIG, MIXb, sink, b, hk, MX + b * CTXL + 64 * i, 0, false, tid); }
            }
            sconv_pass(args, eo, nrows, bx * NTHR + tid, G * NTHR);
        }
        else if (kind == ST_POOL) pool_pass(args, nrows, bx * NTHR + tid, G * NTHR);
        else if (kind == ST_FIX) ffn_fixup(args, l, nrows, bx * NTHR + tid, G * NTHR);
        if (!MK_PER_PHASE && seam && st + 1 < args.ph_hi) xcd_barrier(bar);
    }
}

extern "C" void kernel_launch(void* const* d_in, const int* in_sizes, int n_in, void* d_out, int out_size, void* d_ws, size_t ws_size, hipStream_t stream) {
    static int grid = 0;
    if (grid == 0) {
        if (n_in != 18 || out_size != MX * DM || ws_size < WS_END) { fprintf(stderr, "kernel_launch: unexpected shapes (n_in %d, out %d, ws %zu)\n", n_in, out_size, ws_size); grid = -1; return; }
        int dev = 0, cus = 0;
        if (hipGetDevice(&dev) != hipSuccess || hipDeviceGetAttribute(&cus, hipDeviceAttributeMultiprocessorCount, dev) != hipSuccess) { grid = -1; return; }
        if (hipFuncSetAttribute((const void*)dit_fwd, hipFuncAttributeMaxDynamicSharedMemorySize, LDS_BYTES) != hipSuccess) { grid = -1; return; }
        (void)hipGetLastError();
        grid = cus;
    }
    if (grid < 0) return;
    if (hipMemsetAsync((char*)d_ws + WS_CTL, 0, CTL_ZERO_BYTES, stream) != hipSuccess) return;
    Args a{};
    for (int i = 0; i < 18; ++i) a.in[i] = (const float*)d_in[i];
    a.out = (float*)d_out; a.ws = (unsigned char*)d_ws;
#if MK_PER_PHASE
    for (int p = 0; p < N_STEPS; ++p) { a.ph_lo = p; a.ph_hi = p + 1; hipLaunchKernelGGL(dit_fwd, dim3(grid), dim3(NTHR), LDS_BYTES, stream, a); }
#else
    a.ph_lo = 0; a.ph_hi = N_STEPS;
    hipLaunchKernelGGL(dit_fwd, dim3(grid), dim3(NTHR), LDS_BYTES, stream, a);
#if PROBE_CLASS
    for (int r = 0; r < PROBE_REPS; ++r)
        for (int l = 0; l < DEPTH; ++l) {
            const int base = 2 + STEPS_PER_LAYER * l; const bool ev = (l & 1) == 0;
            int lo = -1, hi = -1;
            switch (PROBE_CLASS) {
                case 1: lo = base + 9; hi = lo + 1; break;
                case 2: lo = base + 11; hi = lo + 1; break;
                case 3: lo = base + 0; hi = base + 2; break;
                case 4: lo = base + 7; hi = lo + 1; break;
                case 5: if (ev) { lo = base + 2; hi = lo + 1; } break;
                case 6: if (!ev) { lo = base + 2; hi = base + 7; } break;
                case 7: if (l == 0) { lo = 0; hi = 1; } break;
                case 8: lo = 1; hi = 2; break;
                case 9: lo = base + 10; hi = lo + 1; break;
                case 10: lo = 2 + 3; hi = lo + 1; break;
                case 11: lo = base + 8; hi = lo + 1; a.dry = 1; break;
                case 12: lo = base + 12; hi = lo + 1; a.dry = 1; break;
                case 13: lo = N_STEPS; hi = N_STEPS + 9; break;
            }
            if (lo >= 0) { a.ph_lo = lo; a.ph_hi = hi; hipLaunchKernelGGL(dit_fwd, dim3(grid), dim3(NTHR), LDS_BYTES, stream, a); }
        }
#endif
#endif
}
```

```cpp
#include <hip/hip_runtime.h>
#include <cstdio>
#include <cstdint>

#ifndef MK_PER_PHASE
#define MK_PER_PHASE 0
#endif

#ifndef PROBE_CLASS
#define PROBE_CLASS 0
#endif
#define PROBE_REPS 3
#define GAS __attribute__((address_space(1)))
#define LAS __attribute__((address_space(3)))
typedef unsigned short bf16_t;
typedef short bf16x8 __attribute__((ext_vector_type(8)));
typedef float f32x4 __attribute__((ext_vector_type(4)));
typedef float f32x16 __attribute__((ext_vector_type(16)));
typedef unsigned u32x4 __attribute__((ext_vector_type(4)));
typedef unsigned u32x2 __attribute__((ext_vector_type(2)));
typedef GAS unsigned gu32;
#define RLX_AGENT __ATOMIC_RELAXED, __HIP_MEMORY_SCOPE_AGENT
#define LDS_WAIT() asm volatile("s_waitcnt lgkmcnt(0)" ::: "memory")
#define VM_WAIT() asm volatile("s_waitcnt vmcnt(0)" ::: "memory")

constexpr int DM = 1024, NBATCH = 8, SEQ = 2048, CTXL = 256, DEPTH = 4;
constexpr int MX = NBATCH * SEQ, MC = NBATCH * CTXL, MT = MX + MC;
constexpr int ATT_IN = 2304, DFF = 2816, NUP = 2 * DFF, KMO = 1536  , WMOLD = 1024  ;
constexpr float EPS = 1e-6f;
constexpr float QSCALE = 0.125f * 1.4426950408889634f;
constexpr float LOG2E = 1.4426950408889634f;
constexpr int NWAVES = 8, NTHR = 512;

constexpr size_t MiB = 1u << 20;
constexpr size_t WS_CTL = 0, CTL_ZERO_BYTES = 1 * MiB;
constexpr size_t WS_MODX = 1 * MiB, WS_MODC = WS_MODX + (size_t)4 * 8 * 6144 * 4;
constexpr size_t WS_TAB = 2 * MiB;
constexpr size_t WS_WIN = 4 * MiB, SZ_WIN = (size_t)ATT_IN * DM * 2;
constexpr size_t WS_WOUT = 13 * MiB, SZ_WOUT = (size_t)DM * DM * 2;
constexpr size_t WS_WMI = 17 * MiB, SZ_WMI = (size_t)1536 * DM * 2;
constexpr size_t WS_WMO = 23 * MiB, SZ_WMO = (size_t)DM * WMOLD * 2;
constexpr size_t WS_WUP = 29 * MiB, SZ_WUP = (size_t)NUP * DM * 2;
constexpr size_t WS_WDN = 73 * MiB, SZ_WDN = (size_t)DM * DFF * 2;
constexpr size_t WS_FMAT = 96 * MiB;
constexpr size_t WS_FC = 112 * MiB;
constexpr size_t WS_HCTX = 113 * MiB;
constexpr size_t WS_HX = 122 * MiB;
constexpr size_t WS_DSLAB = WS_HX;
constexpr size_t WS_Y = 158 * MiB;
constexpr size_t WS_BIG = 194 * MiB;
constexpr size_t WS_UPOOL = WS_BIG, WS_VT = WS_BIG + 20 * MiB, WS_VTC = WS_BIG + 52 * MiB;
constexpr size_t WS_MIX = 293 * MiB;
constexpr size_t WS_SIDE = 348 * MiB;
constexpr size_t WS_END = 368 * MiB;
constexpr int CW_BAR = 4096;
constexpr int SL_OUT = 4, SL_DN = 6;

constexpr int RING_BYTES = 131072, LDSCTL_OFF = RING_BYTES, MISC_OFF = LDSCTL_OFF + 320, LDS_BYTES = 147456;
constexpr int LDS_COSTAB = 122880;

__device__ __forceinline__ unsigned cvt_pk_bf16(float lo, float hi) { unsigned r; asm("v_cvt_pk_bf16_f32 %0, %1, %2" : "=v"(r) : "v"(lo), "v"(hi)); return r; }
__device__ __forceinline__ float bf_lo(unsigned w) { return __uint_as_float(w << 16); }
__device__ __forceinline__ float bf_hi(unsigned w) { return __uint_as_float(w & 0xffff0000u); }
__device__ __forceinline__ float wave_sum(float v) {
#pragma unroll
    for (int o = 1; o < 64; o <<= 1) v += __shfl_xor(v, o);
    return v;
}
__device__ __forceinline__ float silu_f(float x) { return x * __builtin_amdgcn_rcpf(1.0f + __builtin_amdgcn_exp2f(-x * LOG2E)); }

#define XB_TMO      128
#define XB_XCNT(j)  (256  + 64 * (j))
#define XB_XSUB(j)  (1280 + 64 * (j))
#define XB_XGEN(j)  (2304 + 64 * (j))
#define XB_TOP      3328
#define XB_TOPGEN   3392
#define XCD_BAR_WORDS 3456
#define XB_SPIN_CAP (1u << 18)
__device__ __forceinline__ unsigned xb_ld(unsigned* p)              { return __hip_atomic_load(p, __ATOMIC_RELAXED, __HIP_MEMORY_SCOPE_AGENT); }
__device__ __forceinline__ unsigned xb_add(unsigned* p, unsigned v) { return __hip_atomic_fetch_add(p, v, __ATOMIC_RELAXED, __HIP_MEMORY_SCOPE_AGENT); }
__device__ __forceinline__ unsigned xb_xcc_id() { return (unsigned)__builtin_amdgcn_s_getreg((3 << 11) | 20) & 0xFu; }
#define XB_SPIN(cond, bar) do { unsigned _sp = 0; while (cond) { __builtin_amdgcn_s_sleep(1); \
    if ((++_sp & 255u) == 0u) { if (xb_ld(&(bar)[XB_TMO])) break; if (_sp > XB_SPIN_CAP) { atomicAdd(&(bar)[XB_TMO], 1u); break; } } } } while (0)
struct XcdBarrier { unsigned* bar; unsigned x; volatile LAS unsigned* st; };
__device__ __forceinline__ XcdBarrier xcd_barrier_post(unsigned* bar, volatile LAS unsigned* st) {
    XcdBarrier b; b.bar = bar; b.x = xb_xcc_id(); b.st = st;
    if (threadIdx.x == 0) (void)xb_add(&bar[XB_XCNT(b.x)], 1u);
    return b;
}
__device__ __forceinline__ void xcd_barrier_complete(unsigned* bar, unsigned x, unsigned& nloc, unsigned& nx) {
    const unsigned G = gridDim.x * gridDim.y * gridDim.z;
    unsigned sum, cnt, mine, sp = 0u;
    for (;;) {
        sum = 0u; cnt = 0u; mine = 0u;
#pragma unroll
        for (unsigned j = 0; j < 16; ++j) { const unsigned c = xb_ld(&bar[XB_XCNT(j)]); sum += c; cnt += (c > 0u) ? 1u : 0u; mine = (j == x) ? c : mine; }
        if (sum == G) break;
        __builtin_amdgcn_s_sleep(1);
        if ((++sp & 255u) == 0u) { if (xb_ld(&bar[XB_TMO])) break; if (sp > XB_SPIN_CAP) { atomicAdd(&bar[XB_TMO], 1u); break; } }
    }
    nloc = mine > 0u ? mine : 1u; nx = cnt > 0u ? cnt : 1u;
}
__device__ __forceinline__ void xcd_barrier(const XcdBarrier& b) {
    asm volatile("s_waitcnt vmcnt(0)" ::: "memory");
    __syncthreads();
    if (threadIdx.x == 0) {
        unsigned* bar = b.bar; asm volatile("" : "+s"(bar));
        __builtin_amdgcn_s_waitcnt(0);
        unsigned nloc = b.st[0], nx = b.st[1];
        if (nloc == 0u) { xcd_barrier_complete(bar, b.x, nloc, nx); b.st[0] = nloc; b.st[1] = nx; }
        const unsigned old = xb_add(&bar[XB_XSUB(b.x)], 1u);
        const unsigned gen = old / nloc;
        if (old + 1u == (gen + 1u) * nloc) {
            __builtin_amdgcn_fence(__ATOMIC_RELEASE, "agent");
            asm volatile("s_waitcnt vmcnt(0)" ::: "memory");
            const unsigned og = xb_add(&bar[XB_TOP], 1u);
            const unsigned tg = og / nx;
            if (og + 1u == (tg + 1u) * nx) xb_add(&bar[XB_TOPGEN], 1u);
            else XB_SPIN(xb_ld(&bar[XB_TOPGEN]) == tg, bar);
            __builtin_amdgcn_fence(__ATOMIC_ACQUIRE, "agent");
            xb_add(&bar[XB_XGEN(b.x)], 1u);
            asm volatile("s_waitcnt vmcnt(0)" ::: "memory");
        } else {
            XB_SPIN(xb_ld(&bar[XB_XGEN(b.x)]) == gen, bar);
            __builtin_amdgcn_fence(__ATOMIC_ACQUIRE, "agent");
            asm volatile("s_waitcnt vmcnt(0)" ::: "memory");
        }
    }
    __syncthreads();
}

namespace gm {
constexpr int BM = 256, BK = 64, HALF = 128, HTB = HALF * BK * 2, NXCD = 8, WGM = 8;
__device__ __forceinline__ int lds_byte(int r, int c) { const int st = (r >> 4) * 2 + (c >> 5), rr = r & 15, cc = c & 31, ob = rr * 64 + cc * 2; return st * 1024 + (ob ^ (((ob >> 9) & 1) << 5)); }
__device__ __forceinline__ void stage_rc(int b, int& R, int& C) { const int st = b / 1024, sb = b % 1024, swz = sb ^ (((sb >> 9) & 1) << 5); R = (st >> 1) * 16 + swz / 64; C = (st & 1) * 32 + (swz % 64) / 2; }
__device__ __forceinline__ int perm32(int rho) { const int n = rho >> 4, i = rho & 15; return 8 * (i >> 2) + 4 * n + (i & 3); }

enum { K_PLAIN = 0, K_DFT = 1, K_ROPE = 2, K_VT = 3, K_FFN = 4 };
struct Job { const bf16_t* A; const bf16_t* B; void* out; const float* aux; void* out2; int nM, nN, kind, ldc, row0, col0, p0; int cM, S; float* slab; };
struct Call { int K, lda, ldb, G, c; Job j0; };
struct Unit { int pm, pn, kp0, np, slice; };

__device__ __forceinline__ void next_unit(const Call& C, int i, int& pm, int& pn, int& kp0, int& np, int& slice) {
    const long L = (long)i * C.G + C.c;
    const int nM = C.j0.nM, nN = C.j0.nN, nwg = nM * nN, P = C.K / (2 * BK);
    const int S = C.j0.S, nsl = C.j0.cM * nN * S;
    pm = -1; pn = 0; kp0 = 0; np = P; slice = -1;
    if (L < nwg) {
        int wgid = (int)L; { const int q = nwg / NXCD, r = nwg % NXCD, xcd = wgid % NXCD, off = wgid / NXCD; wgid = (xcd < r ? xcd * (q + 1) : r * (q + 1) + (xcd - r) * q) + off; }
        const int nig = WGM * nN, gid = wgid / nig, fm = gid * WGM, gsz = (nM - fm) < WGM ? (nM - fm) : WGM;
        pm = fm + ((wgid % nig) % gsz); pn = (wgid % nig) / gsz;
    } else if (L < (long)nwg + nsl) {
        const int Ls = (int)(L - nwg);
        const int tile = Ls / S, sl = Ls - tile * S, base = P / S, rem = P - base * S;
        pm = nM + tile / nN; pn = tile % nN; slice = sl; np = base + (sl < rem ? 1 : 0); kp0 = sl * base + (sl < rem ? sl : rem);
    }
}

__device__ __forceinline__ u32x4 pack8(const f32x4& a, const f32x4& b) { u32x4 w; w.x = cvt_pk_bf16(a[0], a[1]); w.y = cvt_pk_bf16(a[2], a[3]); w.z = cvt_pk_bf16(b[0], b[1]); w.w = cvt_pk_bf16(b[2], b[3]); return w; }

__device__ __forceinline__ void epi_plain(const f32x4 (&acc)[2][2][4][2], const Job& J, int rowt, int colb, int wr, int wc, int fr, int fq) {
    bf16_t* O = (bf16_t*)J.out;
#pragma unroll
    for (int ai = 0; ai < 2; ++ai)
#pragma unroll
        for (int m = 0; m < 4; ++m) {
            bf16_t* rowp = O + (size_t)(rowt + ai * HALF + wr * 64 + m * 16 + fr) * J.ldc + colb + wc * 32 + 8 * fq;
#pragma unroll
            for (int bj = 0; bj < 2; ++bj) *(u32x4*)(rowp + bj * HALF) = pack8(acc[ai][bj][m][0], acc[ai][bj][m][1]);
        }
}
__device__ __forceinline__ void epi_rope(const f32x4 (&acc)[2][2][4][2], const Job& J, int rowt, int colb, int wr, int wc, int fr, int fq) {
    bf16_t* O = (bf16_t*)J.out; const float* TC = J.aux; const float* TS = J.aux + 1024;
    const bool anyrope = (rowt < MX) && (colb < 640); const int half = wc & 1, j0 = 8 * (fq & 1); const float sgn = fq < 2 ? -1.f : 1.f;
#pragma unroll
    for (int ai = 0; ai < 2; ++ai)
#pragma unroll
        for (int m = 0; m < 4; ++m) {
            const int grow = rowt + ai * HALF + wr * 64 + m * 16 + fr;
            f32x4 c0 = {1.f, 1.f, 1.f, 1.f}, c1 = c0, s0 = {0.f, 0.f, 0.f, 0.f}, s1 = s0;
            if (anyrope) {
                const int t = grow & (SEQ - 1), pos = half ? (t & 63) : (t >> 6);
                c0 = *(const f32x4*)(TC + pos * 16 + j0); c1 = *(const f32x4*)(TC + pos * 16 + j0 + 4);
                s0 = *(const f32x4*)(TS + pos * 16 + j0); s1 = *(const f32x4*)(TS + pos * 16 + j0 + 4);
            }
#pragma unroll
            for (int bj = 0; bj < 2; ++bj) {
                const int cs = colb + bj * HALF; const bool isq = cs < 512, isk = (cs >= 512) && (cs < 640);
                f32x4 v0 = acc[ai][bj][m][0], v1 = acc[ai][bj][m][1];
                if ((isq || isk) && anyrope) {
                    f32x4 p0, p1;
#pragma unroll
                    for (int e = 0; e < 4; ++e) { p0[e] = __shfl_xor(v0[e], 32); p1[e] = __shfl_xor(v1[e], 32); }
                    v0 = v0 * c0 + (p0 * sgn) * s0; v1 = v1 * c1 + (p1 * sgn) * s1;
                }
                if (isq) { v0 = v0 * QSCALE; v1 = v1 * QSCALE; }
                *(u32x4*)(O + (size_t)grow * J.ldc + cs + wc * 32 + 8 * fq) = pack8(v0, v1);
            }
            asm volatile("" ::: "memory");
        }
}
__device__ __forceinline__ void epi_vt(const f32x4 (&acc)[2][2][4][2], const Job& J, int pm, int pn, int wr, int wc, int fr, int fq) {
    const int s = pm >> 1, c0 = (pm & 1) * 256;
    bf16_t* base; size_t cstride;
    if (pn < MX / 256) { const int b = pn >> 3, t0 = (pn & 7) * 256; base = (bf16_t*)J.out + ((size_t)(b * 512) * 2 + s) * SEQ + t0; cstride = 2 * SEQ; }
    else { const int b = pn - MX / 256; base = (bf16_t*)J.out2 + ((size_t)(b * 512) * 2 + s) * CTXL; cstride = 2 * CTXL; }
#pragma unroll
    for (int ai = 0; ai < 2; ++ai)
#pragma unroll
        for (int m = 0; m < 4; ++m) {
            bf16_t* rowp = base + (size_t)(c0 + ai * HALF + wr * 64 + m * 16 + fr) * cstride + wc * 32 + 8 * fq;
#pragma unroll
            for (int bj = 0; bj < 2; ++bj) *(u32x4*)(rowp + bj * HALF) = pack8(acc[ai][bj][m][0], acc[ai][bj][m][1]);
        }
}
__device__ __forceinline__ void epi_ffn(const f32x4 (&acc)[2][2][4][2], const Job& J, int rowt, int pn, int wr, int wc, int fr, int fq, int lane) {
    bf16_t* O = (bf16_t*)J.out; float* SIDE = (float*)J.out2; const float* cw = J.aux;
    const int col = 128 * pn + 32 * wc + 8 * fq;
    f32x4 w0[2], w1[2], w2[2];
#pragma unroll
    for (int n = 0; n < 2; ++n) { w0[n] = *(const f32x4*)(cw + col + 4 * n); w1[n] = *(const f32x4*)(cw + DFF + col + 4 * n); w2[n] = *(const f32x4*)(cw + 2 * DFF + col + 4 * n); }
    const int srcdn = (lane & 48) | ((fr + 15) & 15), srcup = (lane & 48) | ((fr + 1) & 15);
#pragma unroll
    for (int ai = 0; ai < 2; ++ai) {
        const int blk = (rowt + ai * HALF + wr * 64) >> 6;
        f32x4 cv[4][2];
#pragma unroll
        for (int n = 0; n < 2; ++n)
#pragma unroll
            for (int e = 0; e < 4; ++e) {
                float g[4], dn[4], up[4];
#pragma unroll
                for (int m = 0; m < 4; ++m) { g[m] = acc[ai][0][m][n][e]; dn[m] = __shfl(g[m], srcdn); up[m] = __shfl(g[m], srcup); }
#pragma unroll
                for (int m = 0; m < 4; ++m) {
                    const float pv = fr > 0 ? dn[m] : (m > 0 ? dn[m - 1] : 0.f);
                    const float nx = fr < 15 ? up[m] : (m < 3 ? up[m + 1] : 0.f);
                    cv[m][n][e] = w0[n][e] * pv + w1[n][e] * g[m] + w2[n][e] * nx;
                }
            }
#pragma unroll
        for (int m = 0; m < 4; ++m) {
            const int grow = rowt + ai * HALF + wr * 64 + m * 16 + fr;
            const bool first = (m == 0 && fr == 0), last = (m == 3 && fr == 15);
            if (first || last) {
                float* sp = SIDE + ((size_t)(blk * 2 + (last ? 1 : 0)) * 3) * DFF + col;
#pragma unroll
                for (int n = 0; n < 2; ++n) { *(f32x4*)(sp + 4 * n) = cv[m][n]; *(f32x4*)(sp + DFF + 4 * n) = acc[ai][0][m][n]; *(f32x4*)(sp + 2 * DFF + 4 * n) = acc[ai][1][m][n]; }
            } else {
                f32x4 a0, a1;
#pragma unroll
                for (int e = 0; e < 4; ++e) { a0[e] = silu_f(cv[m][0][e]) * acc[ai][1][m][0][e]; a1[e] = silu_f(cv[m][1][e]) * acc[ai][1][m][1][e]; }
                *(u32x4*)(O + (size_t)grow * DFF + col) = pack8(a0, a1);
            }
        }
    }
}
__device__ __forceinline__ void epi_slab(const f32x4 (&acc)[2][2][4][2], const Job& J, const Unit& u, int wr, int wc, int fr, int fq) {
    const int ld = J.nN * BM;
    float* O = J.slab + ((size_t)u.slice * J.cM * BM + (size_t)(u.pm - J.nM) * BM) * ld + u.pn * BM;
#pragma unroll
    for (int ai = 0; ai < 2; ++ai)
#pragma unroll
        for (int m = 0; m < 4; ++m) {
            float* rowp = O + (size_t)(ai * HALF + wr * 64 + m * 16 + fr) * ld + wc * 32 + 8 * fq;
#pragma unroll
            for (int bj = 0; bj < 2; ++bj) { *(f32x4*)(rowp + bj * HALF) = acc[ai][bj][m][0]; *(f32x4*)(rowp + bj * HALF + 4) = acc[ai][bj][m][1]; }
        }
}
__device__ __forceinline__ void epilogue(const f32x4 (&acc)[2][2][4][2], const Call& C, const Unit& u, int wr, int wc, int fr_, int fq_, int lane) {
    asm volatile("" : "+v"(lane));
    const int fr = lane & 15, fq = lane >> 4;
    const Job& J = C.j0;
    if (u.slice >= 0) epi_slab(acc, J, u, wr, wc, fr, fq);
    else if (J.kind == K_PLAIN) epi_plain(acc, J, J.row0 + u.pm * BM, J.col0 + u.pn * BM, wr, wc, fr, fq);
    else if (J.kind == K_DFT) epi_plain(acc, J, J.row0 + ((u.pn >> 1) * J.p0 + u.pm) * BM, J.col0 + (u.pn & 1) * BM, wr, wc, fr, fq);
    else if (J.kind == K_ROPE) epi_rope(acc, J, J.row0 + u.pm * BM, J.col0 + u.pn * BM, wr, wc, fr, fq);
    else if (J.kind == K_VT) epi_vt(acc, J, u.pm, u.pn, wr, wc, fr, fq);
    else epi_ffn(acc, J, J.row0 + u.pm * BM, u.pn, wr, wc, fr, fq, lane);
}

__device__ __forceinline__ void gemm_phase(LAS unsigned char* lds, const Call& C, const int tid) {
    const int wid = __builtin_amdgcn_readfirstlane(tid >> 6), lane = tid & 63, wr = wid >> 2, wc = wid & 3, fr = lane & 15, fq = lane >> 4;
    unsigned voffA[2], voffB[2];
#pragma unroll
    for (int i = 0; i < 2; ++i) { int R, Cc; stage_rc(tid * 16 + i * 8192, R, Cc); const int Rb = (R & ~31) + perm32(R & 31);
        voffA[i] = (unsigned)(R * C.lda + Cc) * 2u; voffB[i] = (unsigned)(Rb * C.ldb + Cc) * 2u; }
    const size_t kstep = (size_t)(BK * 2);
    const size_t hstepA = (size_t)HALF * C.lda * 2, hstepB = (size_t)HALF * C.ldb * 2;
    const unsigned ldsw = (unsigned)wid * 1024u;
    const int aoff = lds_byte(wr * 64 + fr, fq * 8), boff = lds_byte(wc * 32 + fr, fq * 8);
#define PG8_SA(b, h) (((b) * 2 + (h)) * HTB)
#define PG8_SB(b, h) ((4 + (b) * 2 + (h)) * HTB)
#define PG8_STAGE(bufoff, gbase, voff) do { _Pragma("unroll") for (int _i = 0; _i < 2; ++_i) { unsigned _vo = (voff)[_i]; asm volatile("" : "+v"(_vo));   \
        __builtin_amdgcn_global_load_lds((const unsigned*)((const char*)(gbase) + _vo), (LAS unsigned*)(lds + (bufoff) + ldsw + _i * 8192), 16, 0, 0); } } while (0)
#define PG8_LDA(dst, b, h) do { _Pragma("unroll") for (int m = 0; m < 4; ++m) _Pragma("unroll") for (int k = 0; k < 2; ++k) dst[m][k] = *(const LAS bf16x8*)(lds + PG8_SA(b, h) + aoff + m * 2048 + k * 1024); } while (0)
#define PG8_LDB(dst, b, h) do { _Pragma("unroll") for (int n = 0; n < 2; ++n) _Pragma("unroll") for (int k = 0; k < 2; ++k) dst[n][k] = *(const LAS bf16x8*)(lds + PG8_SB(b, h) + boff + n * 2048 + k * 1024); } while (0)
#define PG8_MMA(ai, bj, At, Bt) do { __builtin_amdgcn_s_setprio(1); _Pragma("unroll") for (int m = 0; m < 4; ++m) _Pragma("unroll") for (int n = 0; n < 2; ++n) _Pragma("unroll") for (int k = 0; k < 2; ++k) \
        acc[ai][bj][m][n] = __builtin_amdgcn_mfma_f32_16x16x32_bf16(Bt[n][k], At[m][k], acc[ai][bj][m][n], 0, 0, 0); __builtin_amdgcn_s_setprio(0); } while (0)
#define PG8_WAIT_V(n) asm volatile("s_waitcnt vmcnt(" #n ")" ::: "memory")
#define PG8_WAIT_L(n) asm volatile("s_waitcnt lgkmcnt(" #n ")" ::: "memory")
#define PG8_BAR __builtin_amdgcn_s_barrier()
#define PG8_SCHED __builtin_amdgcn_sched_barrier(0)
#define PG8_APTR(u) ((const char*)C.j0.A + (size_t)(u).pm * 2 * hstepA + (size_t)(u).kp0 * (4 * BK))
#define PG8_BPTR(u) ((const char*)C.j0.B + (size_t)(u).pn * 2 * hstepB + (size_t)(u).kp0 * (4 * BK))
    Unit cur, nxt; int ui = 0;
    next_unit(C, 0, cur.pm, cur.pn, cur.kp0, cur.np, cur.slice);
    if (cur.pm < 0) return;
    f32x4 acc[2][2][4][2];
#pragma unroll
    for (int a = 0; a < 2; ++a)
#pragma unroll
        for (int b = 0; b < 2; ++b)
#pragma unroll
            for (int m = 0; m < 4; ++m)
#pragma unroll
                for (int n = 0; n < 2; ++n) acc[a][b][m][n] = (f32x4){0.f, 0.f, 0.f, 0.f};
    bf16x8 At[4][2], B0[2][2], B1[2][2];
    const char* cA = PG8_APTR(cur); const char* cB = PG8_BPTR(cur);
    PG8_STAGE(PG8_SB(0, 0), cB, voffB); PG8_STAGE(PG8_SB(0, 1), cB + hstepB, voffB); PG8_STAGE(PG8_SA(0, 0), cA, voffA); PG8_STAGE(PG8_SA(0, 1), cA + hstepA, voffA);
    if (wr == 1) PG8_BAR;
    PG8_WAIT_V(2); PG8_BAR;
    PG8_STAGE(PG8_SB(1, 0), cB + kstep, voffB); PG8_STAGE(PG8_SA(1, 0), cA + kstep, voffA); PG8_STAGE(PG8_SB(1, 1), cB + hstepB + kstep, voffB);
    PG8_WAIT_V(6); PG8_BAR;
    for (;;) {
        next_unit(C, ui + 1, nxt.pm, nxt.pn, nxt.kp0, nxt.np, nxt.slice);
        const bool has_next = nxt.pm >= 0;
        const char* nA = has_next ? PG8_APTR(nxt) : cA; const char* nB = has_next ? PG8_BPTR(nxt) : cB;
        const int nt = 2 * cur.np;
        for (int t = 0; t < nt; t += 2) {
            const bool last = (t == nt - 2);
            const char* a1 = cA + (size_t)(t + 1) * kstep;
            const char* a2 = last ? nA : cA + (size_t)(t + 2) * kstep; const char* b2 = last ? nB : cB + (size_t)(t + 2) * kstep;
            const char* a3 = a2 + kstep; const char* b3 = b2 + kstep;
            PG8_LDB(B0, 0, 0); PG8_LDB(B1, 0, 1); PG8_SCHED; PG8_LDA(At, 0, 0); PG8_STAGE(PG8_SA(1, 1), a1 + hstepA, voffA);
            PG8_WAIT_V(8); PG8_WAIT_L(0); PG8_BAR; PG8_MMA(0, 0, At, B0); PG8_MMA(0, 1, At, B1); PG8_BAR; PG8_SCHED;
            PG8_LDA(At, 0, 1); PG8_STAGE(PG8_SB(0, 0), b2, voffB); PG8_STAGE(PG8_SB(0, 1), b2 + hstepB, voffB); PG8_STAGE(PG8_SA(0, 0), a2, voffA);
            PG8_WAIT_V(8); PG8_WAIT_L(0); PG8_BAR; PG8_MMA(1, 0, At, B0); PG8_MMA(1, 1, At, B1); PG8_BAR; PG8_SCHED;
            PG8_LDB(B0, 1, 0); PG8_LDB(B1, 1, 1); PG8_SCHED; PG8_LDA(At, 1, 0); PG8_STAGE(PG8_SA(0, 1), a2 + hstepA, voffA);
            PG8_WAIT_V(8); PG8_WAIT_L(0); PG8_BAR; PG8_MMA(0, 0, At, B0); PG8_MMA(0, 1, At, B1); PG8_BAR; PG8_SCHED;
            PG8_LDA(At, 1, 1); PG8_STAGE(PG8_SB(1, 0), b3, voffB); PG8_STAGE(PG8_SB(1, 1), b3 + hstepB, voffB); PG8_STAGE(PG8_SA(1, 0), a3, voffA);
            PG8_WAIT_V(8); PG8_WAIT_L(0); PG8_BAR; PG8_MMA(1, 0, At, B0); PG8_MMA(1, 1, At, B1); PG8_BAR; PG8_SCHED;
        }
        if (wr == 0) PG8_BAR;
        epilogue(acc, C, cur, wr, wc, fr, fq, lane);
        if (!has_next) break;
#pragma unroll
        for (int a = 0; a < 2; ++a)
#pragma unroll
            for (int b = 0; b < 2; ++b)
#pragma unroll
                for (int m = 0; m < 4; ++m)
#pragma unroll
                    for (int n = 0; n < 2; ++n) acc[a][b][m][n] = (f32x4){0.f, 0.f, 0.f, 0.f};
        cur.pm = nxt.pm; cur.pn = nxt.pn; cur.kp0 = nxt.kp0; cur.np = nxt.np; cur.slice = nxt.slice; cA = nA; cB = nB; ++ui;
        if (wr == 1) PG8_BAR;
    }
    PG8_WAIT_V(0);
    PG8_BAR;
#undef PG8_SA
#undef PG8_SB
#undef PG8_STAGE
#undef PG8_LDA
#undef PG8_LDB
#undef PG8_MMA
#undef PG8_WAIT_V
#undef PG8_WAIT_L
#undef PG8_BAR
#undef PG8_SCHED
#undef PG8_APTR
#undef PG8_BPTR
}
}

__device__ __forceinline__ void tr_load(const float* src, int ldn, int lane, f32x4 (&v)[8]) {
    const int r8 = lane >> 3, c4 = lane & 7;
#pragma unroll
    for (int i = 0; i < 8; ++i) v[i] = *(const f32x4*)(src + (size_t)(8 * i + r8) * ldn + 4 * c4);
}
__device__ __forceinline__ void tr_finish(const f32x4 (&v)[8], bf16_t* dst, bf16_t* dst2, int ldk, LAS float* scr, int lane) {
    const int r8 = lane >> 3, c4 = lane & 7;
#pragma unroll
    for (int i = 0; i < 8; ++i) { LAS float* w = scr + (8 * i + r8) * 33 + 4 * c4; w[0] = v[i][0]; w[1] = v[i][1]; w[2] = v[i][2]; w[3] = v[i][3]; }
    LDS_WAIT(); asm volatile("" ::: "memory");
    const int c = lane & 7;
#pragma unroll
    for (int j = 0; j < 4; ++j) { const int n = (lane >> 3) + 8 * j; const LAS float* sp = scr + (8 * c) * 33 + n;
        u32x4 o; o.x = cvt_pk_bf16(sp[0 * 33], sp[1 * 33]); o.y = cvt_pk_bf16(sp[2 * 33], sp[3 * 33]); o.z = cvt_pk_bf16(sp[4 * 33], sp[5 * 33]); o.w = cvt_pk_bf16(sp[6 * 33], sp[7 * 33]);
        *(u32x4*)(dst + (size_t)n * ldk + 8 * c) = o; if (dst2) *(u32x4*)(dst2 + (size_t)n * ldk + 8 * c) = o; }
    LDS_WAIT(); asm volatile("" ::: "memory");
}

struct Args { const float* in[18]; float* out; unsigned char* ws; int ph_lo, ph_hi, dry, pad; };

__device__ __forceinline__ void mod_item(LAS unsigned char* lds, const Args& a, int item, int tid) {
    const int l = item >> 6, n0 = 96 * (item & 63);
    const float* cv = a.in[1]; const float* cc = a.in[3]; const float* mw = a.in[4] + (size_t)l * DM * 6144; const float* mb = a.in[5] + l * 6144;
    LAS float* sv = (LAS float*)lds; LAS float* red = (LAS float*)(lds + 40960);
    for (int i = tid; i < 9 * DM; i += NTHR) { const int r = i >> 10, k = i & 1023; const float v = r < 8 ? cv[r * DM + k] : cc[k]; sv[i] = v / (1.0f + __expf(-v)); }
    __syncthreads();
    const int col4 = tid % 24, kg = tid / 24;
    if (kg < 21) {
        f32x4 acc[9];
#pragma unroll
        for (int r = 0; r < 9; ++r) acc[r] = (f32x4){0.f, 0.f, 0.f, 0.f};
#pragma unroll 7
        for (int k = kg; k < DM; k += 21) {
            const f32x4 w = *(const f32x4*)(mw + (size_t)k * 6144 + n0 + 4 * col4);
#pragma unroll
            for (int r = 0; r < 9; ++r) acc[r] += w * sv[r * DM + k];
        }
#pragma unroll
        for (int r = 0; r < 9; ++r)
#pragma unroll
            for (int e = 0; e < 4; ++e) red[(kg * 9 + r) * 96 + 4 * col4 + e] = acc[r][e];
    }
    __syncthreads();
    float* modx = (float*)(a.ws + WS_MODX); float* modc = (float*)(a.ws + WS_MODC);
    for (int idx = tid; idx < 9 * 96; idx += NTHR) {
        const int r = idx / 96, n = idx % 96; float s = mb[n0 + n];
        for (int g = 0; g < 21; ++g) s += red[(g * 9 + r) * 96 + n];
        if (r < 8) modx[((size_t)(l * 8 + r)) * 6144 + n0 + n] = s; else modc[(size_t)l * 6144 + n0 + n] = s;
    }
    __syncthreads();
}

__device__ __forceinline__ void fold_in_item(LAS unsigned char* lds, const Args& a, int item, int tid) {
    const int o = item >> 6, g = (item >> 4) & 3, kc = item & 15;
    const float* W = a.in[11] + (size_t)o * DM * DM; bf16_t* WMI = (bf16_t*)(a.ws + WS_WMI + o * SZ_WMI);
    LAS float* Wl = (LAS float*)lds; const LAS float* tab = (const LAS float*)(lds + LDS_COSTAB);
    LAS float* tc = (LAS float*)(lds + 64 * 129 * 4); LAS float* ts = tc + 128;
    if (tid < 128) { tc[tid] = tab[16 * tid]; ts[tid] = tab[(16 * tid - 512) & 2047]; }
    {   f32x4 t[4];
#pragma unroll
        for (int i = 0; i < 4; ++i) { const int idx = tid + NTHR * i, kk = idx >> 5, j4 = idx & 31; t[i] = *(const f32x4*)(W + (size_t)(64 * kc + kk) * DM + 512 + 128 * g + 4 * j4); }
#pragma unroll
        for (int i = 0; i < 4; ++i) { const int idx = tid + NTHR * i, kk = idx >> 5, j4 = idx & 31; LAS float* w = Wl + kk * 129 + 4 * j4; w[0] = t[i][0]; w[1] = t[i][1]; w[2] = t[i][2]; w[3] = t[i][3]; } }
    __syncthreads();
    const int lane = tid & 63, wv = tid >> 6, i32 = lane & 31, hi = lane >> 5, kh = wv >> 2, jb = wv & 3, jp = 32 * jb + i32;
    f32x16 dc, ds;
#pragma unroll
    for (int r = 0; r < 16; ++r) { dc[r] = 0.f; ds[r] = 0.f; }
    const LAS float* arow = Wl + (32 * kh + i32) * 129 + hi;
#pragma unroll 8
    for (int st = 0; st < 64; ++st) {
        const float av = arow[2 * st]; const int ph = ((2 * st + hi) * jp) & 127;
        dc = __builtin_amdgcn_mfma_f32_32x32x2f32(av, tc[ph], dc, 0, 0, 0);
        ds = __builtin_amdgcn_mfma_f32_32x32x2f32(av, ts[ph], ds, 0, 0, 0);
    }
    bf16_t* oc = WMI + (size_t)(512 + 128 * g + jp) * DM + 64 * kc + 32 * kh + 4 * hi; bf16_t* os = oc + (size_t)512 * DM;
#pragma unroll
    for (int q = 0; q < 4; ++q) {
        u32x2 wc, ws_; wc.x = cvt_pk_bf16(dc[4 * q], dc[4 * q + 1]); wc.y = cvt_pk_bf16(dc[4 * q + 2], dc[4 * q + 3]); ws_.x = cvt_pk_bf16(ds[4 * q], ds[4 * q + 1]); ws_.y = cvt_pk_bf16(ds[4 * q + 2], ds[4 * q + 3]);
        *(u32x2*)(oc + 8 * q) = wc; *(u32x2*)(os + 8 * q) = ws_;
    }
    __syncthreads();
}
__device__ __forceinline__ void fold_out_item(LAS unsigned char* lds, const Args& a, int item, int tid) {
    const int o = item >> 6, g = (item >> 4) & 3, nc = item & 15;
    const float* WG = a.in[12] + (size_t)(o * 4 + g) * 128 * 128; const float* SC = a.in[13] + o * 512 + 128 * g; const float* WO = a.in[14] + (size_t)o * DM * DM + (size_t)(128 * g) * DM + 64 * nc;
    bf16_t* WMO = (bf16_t*)(a.ws + WS_WMO + o * SZ_WMO);
    LAS float* Wg = (LAS float*)lds; LAS float* Wo = (LAS float*)(lds + 66560);
    {   f32x4 t[8], u[4];
#pragma unroll
        for (int i = 0; i < 8; ++i) t[i] = *(const f32x4*)(WG + 4 * (tid + NTHR * i));
#pragma unroll
        for (int i = 0; i < 4; ++i) { const int idx = tid + NTHR * i, d = idx >> 4, n4 = idx & 15; u[i] = *(const f32x4*)(WO + (size_t)d * DM + 4 * n4) * SC[d]; }
#pragma unroll
        for (int i = 0; i < 8; ++i) { const int idx = 4 * (tid + NTHR * i), c = idx >> 7, d = idx & 127; LAS float* w = Wg + c * 129 + d; w[0] = t[i][0]; w[1] = t[i][1]; w[2] = t[i][2]; w[3] = t[i][3]; }
#pragma unroll
        for (int i = 0; i < 4; ++i) { const int idx = tid + NTHR * i, d = idx >> 4, n4 = idx & 15; LAS float* w = Wo + d * 65 + 4 * n4; w[0] = u[i][0]; w[1] = u[i][1]; w[2] = u[i][2]; w[3] = u[i][3]; } }
    __syncthreads();
    const int lane = tid & 63, wv = tid >> 6, i32 = lane & 31, hi = lane >> 5, cb = wv & 3, nb = wv >> 2;
    f32x16 dd;
#pragma unroll
    for (int r = 0; r < 16; ++r) dd[r] = 0.f;
    const LAS float* arow = Wg + (32 * cb + i32) * 129 + hi; const LAS float* bcol = Wo + hi * 65 + 32 * nb + i32;
#pragma unroll 8
    for (int st = 0; st < 64; ++st) dd = __builtin_amdgcn_mfma_f32_32x32x2f32(arow[2 * st], bcol[2 * st * 65], dd, 0, 0, 0);
    bf16_t* op = WMO + (size_t)(64 * nc + 32 * nb + i32) * WMOLD + 128 * g + 32 * cb + 4 * hi;
#pragma unroll
    for (int q = 0; q < 4; ++q) { u32x2 w; w.x = cvt_pk_bf16(dd[4 * q], dd[4 * q + 1]); w.y = cvt_pk_bf16(dd[4 * q + 2], dd[4 * q + 3]); *(u32x2*)(op + 8 * q) = w; }
    __syncthreads();
}

struct TrDesc { const float* src; bf16_t* dst; bf16_t* dst2; int ldn, ldk; };
__device__ __forceinline__ TrDesc tr_decode(const Args& a, int l, int it) {
    constexpr int I_WIN = 16 * 72, I_WOUT = 16 * 32, I_WMI = 16 * 16, I_WMO = 8 * 32, I_WUP = 16 * 176;
    const bool even = (l & 1) == 0; const int eo = l >> 1;
    const int n1 = even ? I_WIN : I_WMI, n2 = even ? I_WOUT : I_WMO;
    TrDesc d; d.dst2 = nullptr; int r = it;
    if (r < n1) {
        if (even) { const int kb = r / 72, nb = r % 72; d.src = a.in[7] + (size_t)eo * DM * ATT_IN + (size_t)(64 * kb) * ATT_IN + 32 * nb; d.ldn = ATT_IN; d.dst = (bf16_t*)(a.ws + WS_WIN + eo * SZ_WIN) + (size_t)(32 * nb) * DM + 64 * kb; d.ldk = DM; }
        else { const int kb = r / 16, nb = r % 16; d.src = a.in[11] + (size_t)eo * DM * DM + (size_t)(64 * kb) * DM + 32 * nb; d.ldn = DM; d.dst = (bf16_t*)(a.ws + WS_WMI + eo * SZ_WMI) + (size_t)(32 * nb) * DM + 64 * kb; d.ldk = DM; }
        return d; }
    r -= n1;
    if (r < n2) {
        const int kb = r / 32, nb = r % 32;
        if (even) { d.src = a.in[10] + (size_t)eo * DM * DM + (size_t)(64 * kb) * DM + 32 * nb; d.ldn = DM; d.dst = (bf16_t*)(a.ws + WS_WOUT + eo * SZ_WOUT) + (size_t)(32 * nb) * DM + 64 * kb; d.ldk = DM; }
        else { d.src = a.in[14] + (size_t)eo * DM * DM + (size_t)(512 + 64 * kb) * DM + 32 * nb; d.ldn = DM; d.dst = (bf16_t*)(a.ws + WS_WMO + eo * SZ_WMO) + (size_t)(32 * nb) * WMOLD + 512 + 64 * kb; d.ldk = WMOLD; }
        return d; }
    r -= n2;
    if (r < I_WUP) { const int kb = r / 176, nb = r % 176, j = nb >> 3, sub = nb & 7; const int scol = sub < 4 ? 128 * j + 32 * sub : DFF + 128 * j + 32 * (sub - 4);
        d.src = a.in[15] + (size_t)l * DM * NUP + (size_t)(64 * kb) * NUP + scol; d.ldn = NUP; d.dst = (bf16_t*)(a.ws + WS_WUP + l * SZ_WUP) + (size_t)(32 * nb) * DM + 64 * kb; d.ldk = DM; return d; }
    r -= I_WUP;
    { const int kb = r / 32, nb = r % 32; d.src = a.in[17] + (size_t)l * DFF * DM + (size_t)(64 * kb) * DM + 32 * nb; d.ldn = DM; d.dst = (bf16_t*)(a.ws + WS_WDN + l * SZ_WDN) + (size_t)(32 * nb) * DFF + 64 * kb; d.ldk = DFF; }
    return d;
}
__device__ __forceinline__ void tr_layer(LAS unsigned char* lds, const Args& a, int l, int wr, int nw, int lane, int wave) {
    LAS float* scr = (LAS float*)(lds + wave * 8448);
    const int NIT = ((l & 1) == 0 ? 16 * 72 + 16 * 32 : 16 * 16 + 8 * 32) + 16 * 176 + 44 * 32;
    for (int it = wr; it < NIT; it += 2 * nw) {
        const bool two = it + nw < NIT;
        const TrDesc d0 = tr_decode(a, l, it), d1 = tr_decode(a, l, two ? it + nw : it);
        f32x4 v0[8], v1[8];
        tr_load(d0.src, d0.ldn, lane, v0); tr_load(d1.src, d1.ldn, lane, v1);
        tr_finish(v0, d0.dst, d0.dst2, d0.ldk, scr, lane);
        if (two) tr_finish(v1, d1.dst, d1.dst2, d1.ldk, scr, lane);
    }
}
__device__ __forceinline__ void fold_layer(LAS unsigned char* lds, const Args& a, int o, int rk, int n, int tid) {
    { LAS float* tab = (LAS float*)(lds + LDS_COSTAB); for (int i = tid; i < 2048; i += NTHR) tab[i] = cospif((float)i * (1.0f / 1024.0f)); }
    __syncthreads();
    for (int it = rk; it < 64; it += n) fold_in_item(lds, a, o * 64 + it, tid);
    for (int it = rk; it < 64; it += n) fold_out_item(lds, a, o * 64 + (it + 64) % 64, tid);
    if (o == 0) {
        const LAS float* tab = (const LAS float*)(lds + LDS_COSTAB);
        const int gt = rk * NTHR + tid, NT = n * NTHR;
        bf16_t* FM = (bf16_t*)(a.ws + WS_FMAT);
        for (int idx = gt; idx < 2048 * 256; idx += NT) {
            const int k = idx >> 8, t0 = (idx & 255) * 8, ph0 = (k * t0) & 2047;
            float c = tab[ph0], sn = tab[(ph0 - 512) & 2047]; const float dc = tab[k], dsn = tab[(k - 512) & 2047];
            float vc[8], vs[8];
#pragma unroll
            for (int e = 0; e < 8; ++e) { vc[e] = c * (1.0f / 512.0f); vs[e] = sn * (-1.0f / 512.0f); const float c2 = c * dc - sn * dsn; sn = sn * dc + c * dsn; c = c2; }
            u32x4 w; w.x = cvt_pk_bf16(vc[0], vc[1]); w.y = cvt_pk_bf16(vc[2], vc[3]); w.z = cvt_pk_bf16(vc[4], vc[5]); w.w = cvt_pk_bf16(vc[6], vc[7]);
            *(u32x4*)(FM + (size_t)k * 4096 + t0) = w;
            w.x = cvt_pk_bf16(vs[0], vs[1]); w.y = cvt_pk_bf16(vs[2], vs[3]); w.z = cvt_pk_bf16(vs[4], vs[5]); w.w = cvt_pk_bf16(vs[6], vs[7]);
            *(u32x4*)(FM + (size_t)k * 4096 + 2048 + t0) = w;
        }
        bf16_t* FC = (bf16_t*)(a.ws + WS_FC); const float nc = 0.005524271728019903f;
        for (int idx = gt; idx < 256 * 64; idx += NT) {
            const int k = idx >> 6, ch = idx & 63, s = ch >> 5, t0 = (ch & 31) * 8; float v[8];
#pragma unroll
            for (int e = 0; e < 8; ++e) { const int ph = ((k * (t0 + e)) & 255) * 8; v[e] = s ? -tab[(ph - 512) & 2047] * nc : tab[ph] * nc; }
            u32x4 w; w.x = cvt_pk_bf16(v[0], v[1]); w.y = cvt_pk_bf16(v[2], v[3]); w.z = cvt_pk_bf16(v[4], v[5]); w.w = cvt_pk_bf16(v[6], v[7]);
            *(u32x4*)(FC + (size_t)k * 512 + ch * 8) = w;
        }
    }
    __syncthreads();
}
__device__ __forceinline__ void prologue_a(LAS unsigned char* lds, const Args& a, int tid, int lane, int wave, int G) {
    const int bx = blockIdx.x;
    for (int it = bx; it < 256; it += G) mod_item(lds, a, it, tid);
    tr_layer(lds, a, 0, bx * NWAVES + wave, G * NWAVES, lane, wave);
    { const int gt = bx * NTHR + tid, NT = G * NTHR; float* TC = (float*)(a.ws + WS_TAB); float* TS = TC + 1024;
      for (int idx = gt; idx < 1024; idx += NT) { const int pos = idx >> 4, j = idx & 15; const float inv = powf(10000.0f, -(float)j / 16.0f); const float ang = (float)pos * inv; TC[idx] = cosf(ang); TS[idx] = sinf(ang); } }
    __syncthreads();
}

__device__ __forceinline__ void ld_row_f32(const float* p, int lane, f32x4 (&v)[4]) {
#pragma unroll
    for (int j = 0; j < 4; ++j) v[j] = *(const f32x4*)(p + 4 * lane + 256 * j);
}
__device__ __forceinline__ float row_rs(const f32x4 (&v)[4]) {
    float s = 0.f;
#pragma unroll
    for (int j = 0; j < 4; ++j) s += (v[j][0] * v[j][0] + v[j][1] * v[j][1]) + (v[j][2] * v[j][2] + v[j][3] * v[j][3]);
    return __builtin_amdgcn_rsqf(wave_sum(s) * (1.0f / DM) + EPS);
}
__device__ __forceinline__ void norm_mod_store(const f32x4 (&x)[4], const float* gain, const float* sc, const float* sh, bf16_t* hrow, int lane) {
    const float rs = row_rs(x);
#pragma unroll
    for (int j = 0; j < 4; ++j) {
        const int c = 4 * lane + 256 * j;
        const f32x4 g = *(const f32x4*)(gain + c), s1 = *(const f32x4*)(sc + c), s0 = *(const f32x4*)(sh + c);
        const f32x4 h = (x[j] * rs * g) * (s1 + 1.0f) + s0;
        u32x2 w; w.x = cvt_pk_bf16(h[0], h[1]); w.y = cvt_pk_bf16(h[2], h[3]);
        *(u32x2*)(hrow + c) = w;
    }
}
typedef GAS const float* gcf;
struct RowRegs { f32x4 x[4], y[4], gt[4], sc[4], sh[4]; };
struct RowCtx { gcf xsX, xsC, modx, modc, slab; GAS const bf16_t* Y; int layer, which, ns, lane; bool do_norm; };
__device__ __forceinline__ void row_load(RowRegs& R, const RowCtx& c, int row) {
    const bool isx = row < MX; const int b = row >> 11, lane = c.lane;
    gcf xi = isx ? c.xsX + (size_t)row * DM : c.xsC + (size_t)(row - MX) * DM;
#pragma unroll
    for (int j = 0; j < 4; ++j) R.x[j] = *(const GAS f32x4*)(xi + 4 * lane + 256 * j);
    gcf mod = isx ? c.modx + (size_t)(c.layer * 8 + b) * 6144 : c.modc + (size_t)c.layer * 6144;
    gcf modn = (c.which == 2) ? mod + (isx ? 8 * 6144 : 6144) : mod;
    const int so = c.which == 1 ? 4096 : 1024, ho = c.which == 1 ? 3072 : 0;
    if (c.do_norm) {
#pragma unroll
        for (int j = 0; j < 4; ++j) { R.sc[j] = *(const GAS f32x4*)(modn + so + 4 * lane + 256 * j); R.sh[j] = *(const GAS f32x4*)(modn + ho + 4 * lane + 256 * j); }
    }
    if (c.which != 0) {
        gcf gate = mod + (c.which == 1 ? 2048 : 5120);
#pragma unroll
        for (int j = 0; j < 4; ++j) R.gt[j] = *(const GAS f32x4*)(gate + 4 * lane + 256 * j);
        if (isx) {
#pragma unroll
            for (int j = 0; j < 4; ++j) { const u32x2 w = *(const GAS u32x2*)(c.Y + (size_t)row * DM + 4 * lane + 256 * j); R.y[j] = (f32x4){bf_lo(w.x), bf_hi(w.x), bf_lo(w.y), bf_hi(w.y)}; }
        } else {
            gcf sl = c.slab + (size_t)(row - MX) * DM;
#pragma unroll
            for (int j = 0; j < 4; ++j) R.y[j] = *(const GAS f32x4*)(sl + 4 * lane + 256 * j);
            for (int k = 1; k < c.ns; ++k)
#pragma unroll
                for (int j = 0; j < 4; ++j) R.y[j] += *(const GAS f32x4*)(sl + (size_t)k * MC * DM + 4 * lane + 256 * j);
        }
    }
}
__device__ __forceinline__ void row_finish(RowRegs& R, const RowCtx& c, int row, const f32x4 (&gA)[4], const f32x4 (&gB)[4], GAS float* xo, GAS bf16_t* ho) {
    const int lane = c.lane;
    if (c.which != 0) {
        const float rsy = row_rs(R.y);
#pragma unroll
        for (int j = 0; j < 4; ++j) { R.x[j] = R.x[j] + R.gt[j] * (R.y[j] * rsy * gA[j]); *(GAS f32x4*)(xo + 4 * lane + 256 * j) = R.x[j]; }
    }
    if (c.do_norm) {
        const float rs = row_rs(R.x);
#pragma unroll
        for (int j = 0; j < 4; ++j) {
            const f32x4 h = (R.x[j] * rs * gB[j]) * (R.sc[j] + 1.0f) + R.sh[j];
            u32x2 w; w.x = cvt_pk_bf16(h[0], h[1]); w.y = cvt_pk_bf16(h[2], h[3]);
            *(GAS u32x2*)(ho + 4 * lane + 256 * j) = w;
        }
    }
}
__device__ __forceinline__ void row_phase(const Args& a, int layer, int which, int nrows, int lane, int gw, int NGW) {
    RowCtx c; c.layer = layer; c.which = which; c.lane = lane; c.do_norm = !(which == 2 && layer == DEPTH - 1);
    c.modx = (gcf)(a.ws + WS_MODX); c.modc = (gcf)(a.ws + WS_MODC); c.Y = (GAS const bf16_t*)(a.ws + WS_Y);
    c.slab = (gcf)(a.ws + (which == 1 ? WS_BIG : WS_MIX)); c.ns = which == 1 ? SL_OUT : SL_DN;
    GAS float* hctx = (GAS float*)(a.ws + WS_HCTX); GAS float* xoX = a.dry ? (GAS float*)(a.ws + WS_BIG) : (GAS float*)a.out; GAS bf16_t* HX = (GAS bf16_t*)(a.ws + WS_HX);
    const bool first = layer == 0 && which < 2;
    c.xsX = first ? (gcf)a.in[0] : (gcf)a.out; c.xsC = first ? (gcf)a.in[2] : (gcf)hctx;
    gcf gains = (gcf)a.in[6];
    f32x4 gA[4], gB[4];
    { gcf pa = gains + (layer * 4 + (which == 1 ? 1 : 3)) * DM; gcf pb = gains + ((which == 2 ? layer + 1 : layer) * 4 + (which == 1 ? 2 : 0)) * DM;
      if (!c.do_norm) pb = pa;
#pragma unroll
      for (int j = 0; j < 4; ++j) { gA[j] = *(const GAS f32x4*)(pa + 4 * lane + 256 * j); gB[j] = *(const GAS f32x4*)(pb + 4 * lane + 256 * j); } }
    const int nX = (MX + NGW - 1) / NGW, nC = nrows > MX ? (nrows - MX + NGW - 1) / NGW : 0;
    for (int i = 0; i < nX + nC; i += 2) {
        int rowA = i < nX ? gw * nX + i : MX + gw * nC + (i - nX); const int lim = i < nX ? MX : nrows;
        int rowB = i + 1 < nX ? gw * nX + i + 1 : MX + gw * nC + (i + 1 - nX); const int limB = i + 1 < nX ? MX : nrows;
        const bool okA = rowA < lim, two = okA && (i + 1 < nX + nC) && rowB < limB;
        if (!okA) { if (i + 1 < nX + nC && rowB < limB) { rowA = rowB; } else continue; }
        if (!two) rowB = rowA;
        RowRegs A, B;
        row_load(A, c, rowA); row_load(B, c, rowB);
        row_finish(A, c, rowA, gA, gB, rowA < MX ? xoX + (size_t)rowA * DM : hctx + (size_t)(rowA - MX) * DM, HX + (size_t)rowA * DM);
        if (two) row_finish(B, c, rowB, gA, gB, rowB < MX ? xoX + (size_t)rowB * DM : hctx + (size_t)(rowB - MX) * DM, HX + (size_t)rowB * DM);
    }
}

typedef short v4i16_t __attribute__((ext_vector_type(4)));
constexpr int AT_KP = 144, AT_VP = 192;
constexpr int AT_KB = 128 * AT_KP, AT_VB = 128 * AT_VP, AT_BUF = AT_KB + AT_VB, AT_STG = 2 * AT_BUF, AT_STGW = 32 * 144, AT_SCR = AT_STG + 8 * AT_STGW;
static_assert(AT_SCR + 8 * 256 <= RING_BYTES, "attention LDS map");
constexpr float AT_THR = 8.0f;
__device__ __forceinline__ int crow(int r, int hi) { return (r & 3) + 8 * (r >> 2) + 4 * hi; }

__device__ __forceinline__ void attn_unit(LAS unsigned char* lds, const bf16_t* U, bf16_t* MIXo, const float* sink8, int b, int hk, int qrow0, int qpos0, bool latent, int tid) {
    const int lane = tid & 63, r32 = lane & 31, hi = lane >> 5, wid = __builtin_amdgcn_readfirstlane(tid >> 6);
    const int hq = 4 * hk + (wid >> 1), rowoff = 32 * (wid & 1), qa = qpos0 + rowoff;
    const int ctxrow0 = MX + b * CTXL, nst = latent ? 5 : 2;
    bf16x8 qf[4];
#pragma unroll
    for (int d0 = 0; d0 < 4; ++d0) qf[d0] = *(const bf16x8*)(U + (size_t)(qrow0 + rowoff + r32) * ATT_IN + hq * 64 + 16 * d0 + 8 * hi);
    const float sink2 = sink8[hq] * LOG2E;
    float mref = sink2, lsum = hi == 0 ? 1.f : 0.f;
    f32x16 o0, o1, negm;
#pragma unroll
    for (int r = 0; r < 16; ++r) { o0[r] = 0.f; o1[r] = 0.f; negm[r] = -sink2; }
    volatile LAS float* scr = (volatile LAS float*)(lds + AT_SCR) + wid * 64;
    const int skey = tid >> 3, sch = tid & 7;
    u32x4 kr0, kr1, vr0, vr1;
#define AT_ROW(st, key) ((st) < 2 ? ctxrow0 + 128 * (st) + (key) : b * SEQ + min(max(qpos0 - 128 + 128 * ((st) - 2) + (key), 0), SEQ - 1))
#define AT_LOAD(st) do { const bf16_t* p0_ = U + (size_t)AT_ROW(st, skey) * ATT_IN + 512 + hk * 64 + 8 * sch; const bf16_t* p1_ = U + (size_t)AT_ROW(st, skey + 64) * ATT_IN + 512 + hk * 64 + 8 * sch; \
        kr0 = *(const u32x4*)p0_; vr0 = *(const u32x4*)(p0_ + 128); kr1 = *(const u32x4*)p1_; vr1 = *(const u32x4*)(p1_ + 128); } while (0)
#define AT_WRITE(bufi) do { LAS unsigned char* kb_ = lds + (bufi) * AT_BUF; LAS unsigned char* vb_ = kb_ + AT_KB; \
        *(LAS u32x4*)(kb_ + skey * AT_KP + sch * 16) = kr0; *(LAS u32x4*)(kb_ + (skey + 64) * AT_KP + sch * 16) = kr1; \
        *(LAS u32x4*)(vb_ + skey * AT_VP + sch * 16) = vr0; *(LAS u32x4*)(vb_ + (skey + 64) * AT_VP + sch * 16) = vr1; } while (0)
    AT_LOAD(0); AT_WRITE(0);
    __syncthreads();
    for (int st = 0; st < nst; ++st) {
        if (st + 1 < nst) AT_LOAD(st + 1);
        const LAS unsigned char* kbuf = lds + (st & 1) * AT_BUF; const LAS unsigned char* vbuf = kbuf + AT_KB;
        const bool win = st >= 2;
#pragma unroll
        for (int h = 0; h < 2; ++h) {
            const int kp = qpos0 - 128 + 128 * (st - 2) + 64 * h;
            if (win && (kp < 0 || kp >= SEQ || kp > qa + 159 || kp + 63 < qa - 128)) continue;
            const bool needmask = win && !(qa + 31 - kp <= 128 && kp + 63 - qa <= 128);
            const LAS unsigned char* kb = kbuf + (64 * h + r32) * AT_KP + 16 * hi;
            f32x16 p0 = negm, p1 = negm;
#pragma unroll
            for (int d0 = 0; d0 < 4; ++d0) {
                const bf16x8 k0 = *(const LAS bf16x8*)(kb + 32 * d0), k1 = *(const LAS bf16x8*)(kb + 32 * AT_KP + 32 * d0);
                p0 = __builtin_amdgcn_mfma_f32_32x32x16_bf16(k0, qf[d0], p0, 0, 0, 0); p1 = __builtin_amdgcn_mfma_f32_32x32x16_bf16(k1, qf[d0], p1, 0, 0, 0);
            }
            if (needmask) {
                const int qpos = qa + r32;
#pragma unroll
                for (int r = 0; r < 16; ++r) { const int kq = kp + crow(r, hi); int d0_ = qpos - kq; d0_ = d0_ < 0 ? -d0_ : d0_; int d1_ = qpos - (kq + 32); d1_ = d1_ < 0 ? -d1_ : d1_;
                    if (d0_ > 128) p0[r] = -INFINITY; if (d1_ > 128) p1[r] = -INFINITY; }
            }
            float mx = fmaxf(fmaxf(p0[0], p0[1]), p1[0]);
#pragma unroll
            for (int r = 2; r < 16; r += 2) mx = fmaxf(fmaxf(mx, p0[r]), p0[r + 1]);
#pragma unroll
            for (int r = 1; r < 15; r += 2) mx = fmaxf(fmaxf(mx, p1[r]), p1[r + 1]);
            mx = fmaxf(mx, p1[15]);
            mx = fmaxf(mx, __shfl_xor(mx, 32));
            if (__any(mx > AT_THR)) {
                const float dl = fmaxf(mx, 0.f), f = __builtin_amdgcn_exp2f(-dl);
                mref += dl; lsum *= f;
#pragma unroll
                for (int r = 0; r < 16; ++r) { p0[r] -= dl; p1[r] -= dl; negm[r] = -mref; }
                if (hi == 0) scr[r32] = f;
                LDS_WAIT();
#pragma unroll
                for (int r = 0; r < 16; ++r) { const float al = scr[crow(r, hi)]; o0[r] *= al; o1[r] *= al; }
                LDS_WAIT();
            }
            float rsum = 0.f;
#pragma unroll
            for (int r = 0; r < 16; ++r) { p0[r] = __builtin_amdgcn_exp2f(p0[r]); p1[r] = __builtin_amdgcn_exp2f(p1[r]); rsum += p0[r] + p1[r]; }
            lsum += rsum;
            bf16x8 pa[4];
#pragma unroll
            for (int s2 = 0; s2 < 2; ++s2) {
                u32x4 w0, w1;
                w0.x = cvt_pk_bf16(p0[8 * s2 + 0], p0[8 * s2 + 1]); w0.y = cvt_pk_bf16(p0[8 * s2 + 2], p0[8 * s2 + 3]); w0.z = cvt_pk_bf16(p0[8 * s2 + 4], p0[8 * s2 + 5]); w0.w = cvt_pk_bf16(p0[8 * s2 + 6], p0[8 * s2 + 7]);
                w1.x = cvt_pk_bf16(p1[8 * s2 + 0], p1[8 * s2 + 1]); w1.y = cvt_pk_bf16(p1[8 * s2 + 2], p1[8 * s2 + 3]); w1.z = cvt_pk_bf16(p1[8 * s2 + 4], p1[8 * s2 + 5]); w1.w = cvt_pk_bf16(p1[8 * s2 + 6], p1[8 * s2 + 7]);
                pa[s2] = __builtin_bit_cast(bf16x8, w0); pa[2 + s2] = __builtin_bit_cast(bf16x8, w1);
            }
            const LAS unsigned char* vb = vbuf + (64 * h + 4 * hi + ((lane & 15) >> 2)) * AT_VP + ((lane >> 4) & 1) * 32 + (lane & 3) * 8;
#pragma unroll
            for (int s = 0; s < 4; ++s) {
#pragma unroll
                for (int d = 0; d < 2; ++d) {
                    const v4i16_t lo = __builtin_amdgcn_ds_read_tr16_b64_v4i16((LAS v4i16_t*)(vb + 16 * s * AT_VP + 64 * d));
                    const v4i16_t hh = __builtin_amdgcn_ds_read_tr16_b64_v4i16((LAS v4i16_t*)(vb + (16 * s + 8) * AT_VP + 64 * d));
                    const bf16x8 vf = (bf16x8){lo[0], lo[1], lo[2], lo[3], hh[0], hh[1], hh[2], hh[3]};
                    if (d == 0) o0 = __builtin_amdgcn_mfma_f32_32x32x16_bf16(pa[s], vf, o0, 0, 0, 0); else o1 = __builtin_amdgcn_mfma_f32_32x32x16_bf16(pa[s], vf, o1, 0, 0, 0);
                }
            }
        }
        if (st + 1 < nst) AT_WRITE((st + 1) & 1);
        __syncthreads();
    }
    {
        const float lt = lsum + __shfl_xor(lsum, 32);
        if (hi == 0) scr[r32] = 1.0f / lt;
        LDS_WAIT();
        LAS unsigned short* stg = (LAS unsigned short*)(lds + AT_STG + wid * AT_STGW);
#pragma unroll
        for (int r = 0; r < 16; ++r) { const int q = crow(r, hi); const float il = scr[q];
            stg[q * 72 + r32] = (unsigned short)(cvt_pk_bf16(o0[r] * il, 0.f) & 0xffffu); stg[q * 72 + 32 + r32] = (unsigned short)(cvt_pk_bf16(o1[r] * il, 0.f) & 0xffffu); }
        LDS_WAIT();
#pragma unroll
        for (int i = 0; i < 4; ++i) { const int row = i * 8 + (lane >> 3), ch = lane & 7; const u32x4 v = *(const LAS u32x4*)((const LAS unsigned char*)stg + row * 144 + ch * 16);
            *(u32x4*)(MIXo + (size_t)(qrow0 + rowoff + row) * KMO + hq * 64 + 8 * ch) = v; }
        LDS_WAIT();
    }
#undef AT_ROW
#undef AT_LOAD
#undef AT_WRITE
}

__device__ __forceinline__ u32x4 ld16(const bf16_t* p) { return *(const u32x4*)p; }
__device__ __forceinline__ void unpack8(const u32x4& w, float (&f)[8]) { f[0] = bf_lo(w.x); f[1] = bf_hi(w.x); f[2] = bf_lo(w.y); f[3] = bf_hi(w.y); f[4] = bf_lo(w.z); f[5] = bf_hi(w.z); f[6] = bf_lo(w.w); f[7] = bf_hi(w.w); }

__device__ __forceinline__ void sconv_pass(const Args& a, int e, int nrows, int gt, int NT) {
    const bf16_t* U = (const bf16_t*)(a.ws + WS_BIG); bf16_t* MIXo = (bf16_t*)(a.ws + WS_MIX); const float* cw = a.in[9] + (size_t)e * 3 * 512;
    for (int idx = gt; idx < nrows * 64; idx += NT) {
        const int row = idx >> 6, ch = idx & 63;
        const int t = row < MX ? (row & (SEQ - 1)) : ((row - MX) & (CTXL - 1)), T = row < MX ? SEQ : CTXL;
        const bf16_t* up = U + (size_t)row * ATT_IN + 8 * ch;
        float bv[8], acc[8];
        unpack8(ld16(up + 768), bv);
#pragma unroll
        for (int q = 0; q < 8; ++q) acc[q] = 0.f;
#pragma unroll
        for (int j = 0; j < 3; ++j) {
            const int tt = t + j - 1;
            if (tt >= 0 && tt < T) {
                float cvv[8], zv[8];
                unpack8(ld16(up + (ptrdiff_t)(j - 1) * ATT_IN + 1280), cvv); unpack8(ld16(up + (ptrdiff_t)(j - 1) * ATT_IN + 1792), zv);
                const f32x4 w0 = *(const f32x4*)(cw + j * 512 + 8 * ch), w1 = *(const f32x4*)(cw + j * 512 + 8 * ch + 4);
#pragma unroll
                for (int q = 0; q < 4; ++q) { acc[q] += w0[q] * (cvv[q] * zv[q]); acc[4 + q] += w1[q] * (cvv[4 + q] * zv[4 + q]); }
            }
        }
        u32x4 w; w.x = cvt_pk_bf16(bv[0] * acc[0], bv[1] * acc[1]); w.y = cvt_pk_bf16(bv[2] * acc[2], bv[3] * acc[3]); w.z = cvt_pk_bf16(bv[4] * acc[4], bv[5] * acc[5]); w.w = cvt_pk_bf16(bv[6] * acc[6], bv[7] * acc[7]);
        *(u32x4*)(MIXo + (size_t)row * KMO + 512 + 8 * ch) = w;
    }
}
__device__ __forceinline__ void pool_pass(const Args& a, int nrows, int gt, int NT) {
    const bf16_t* UP = (const bf16_t*)(a.ws + WS_UPOOL); bf16_t* MIXo = (bf16_t*)(a.ws + WS_MIX);
    for (int idx = gt; idx < nrows * 64; idx += NT) {
        const int row = idx >> 6, ch = idx & 63, g = ch >> 4, hw = 1 << g;
        const int t = row < MX ? (row & (SEQ - 1)) : ((row - MX) & (CTXL - 1)), T = row < MX ? SEQ : CTXL;
        const int lo = t - hw < 0 ? 0 : t - hw, hi = t + hw > T ? T : t + hw;
        const bf16_t* up = UP + (size_t)row * 512 + 8 * ch;
        float acc[8], f[8];
#pragma unroll
        for (int q = 0; q < 8; ++q) acc[q] = 0.f;
        for (int s = lo; s < hi; ++s) { unpack8(ld16(up + (ptrdiff_t)(s - t) * 512), f);
#pragma unroll
            for (int q = 0; q < 8; ++q) acc[q] += f[q]; }
        unpack8(ld16(up), f);
        const float inv = 1.0f / (float)(hi - lo);
#pragma unroll
        for (int q = 0; q < 8; ++q) acc[q] = acc[q] * inv - f[q];
        u32x4 w; w.x = cvt_pk_bf16(acc[0], acc[1]); w.y = cvt_pk_bf16(acc[2], acc[3]); w.z = cvt_pk_bf16(acc[4], acc[5]); w.w = cvt_pk_bf16(acc[6], acc[7]);
        *(u32x4*)(MIXo + (size_t)row * KMO + 8 * ch) = w;
    }
}
__device__ __forceinline__ void dft_combine(const Args& a, int gt, int NT, int lane, int gw, int NGW) {
    const float* SL = (const float*)(a.ws + WS_DSLAB); bf16_t* MIXo = (bf16_t*)(a.ws + WS_MIX); const size_t SS = (size_t)1024 * 4096;
    for (int idx = gt; idx < 1024 * 512; idx += NT) {
        const int k = idx >> 9, cc = idx & 511, b = cc >> 6, c8 = (cc & 63) * 8;
        const float* p = SL + (size_t)k * 4096 + b * 512 + c8;
        f32x4 P0 = *(const f32x4*)p + *(const f32x4*)(p + SS), P1 = *(const f32x4*)(p + 4) + *(const f32x4*)(p + SS + 4);
        f32x4 Q0 = *(const f32x4*)(p + 2 * SS) + *(const f32x4*)(p + 3 * SS), Q1 = *(const f32x4*)(p + 2 * SS + 4) + *(const f32x4*)(p + 3 * SS + 4);
        *(u32x4*)(MIXo + (size_t)(b * SEQ + k) * KMO + 512 + c8) = gm::pack8(P0 + Q0, P1 + Q1);
        if (k > 0) *(u32x4*)(MIXo + (size_t)(b * SEQ + SEQ - k) * KMO + 512 + c8) = gm::pack8(P0 - Q0, P1 - Q1);
    }
    const bf16_t* VT = (const bf16_t*)(a.ws + WS_VT);
    for (int r = gw; r < NBATCH * 512; r += NGW) {
        const bf16_t* v = VT + (size_t)r * 2 * SEQ + 8 * lane; float s = 0.f;
#pragma unroll
        for (int j = 0; j < 4; ++j) { float f[8]; unpack8(ld16(v + 512 * j), f); s += (f[0] - f[1]) + (f[2] - f[3]) + (f[4] - f[5]) + (f[6] - f[7]); }
        s = wave_sum(s) * (1.0f / 512.0f);
        if (lane == 0) MIXo[(size_t)((r >> 9) * SEQ + 1024) * KMO + 512 + (r & 511)] = (bf16_t)(cvt_pk_bf16(s, 0.f) & 0xffffu);
    }
}
__device__ __forceinline__ void ffn_fixup(const Args& a, int layer, int nrows, int gt, int NT) {
    const float* SIDE = (const float*)(a.ws + WS_SIDE); bf16_t* ACT = (bf16_t*)(a.ws + WS_BIG); const float* cw = a.in[16] + (size_t)layer * 3 * DFF;
    const int nblk = nrows >> 6;
    for (int idx = gt; idx < nblk * 2 * (DFF / 4); idx += NT) {
        const int c4 = idx % (DFF / 4), bw = idx / (DFF / 4), blk = bw >> 1, which = bw & 1, col = 4 * c4;
        const int row = blk * 64 + (which ? 63 : 0);
        const int sb = row < MX ? (blk & 31) : ((blk - MX / 64) & 3), nsb = row < MX ? 32 : 4;
        const float* sp = SIDE + ((size_t)(blk * 2 + which) * 3) * DFF + col;
        f32x4 cv = *(const f32x4*)sp; const f32x4 vv = *(const f32x4*)(sp + 2 * DFF);
        if (which == 0 && sb > 0) { const f32x4 gl = *(const f32x4*)(SIDE + ((size_t)((blk - 1) * 2 + 1) * 3 + 1) * DFF + col); cv += *(const f32x4*)(cw + col) * gl; }
        if (which == 1 && sb < nsb - 1) { const f32x4 gf = *(const f32x4*)(SIDE + ((size_t)((blk + 1) * 2 + 0) * 3 + 1) * DFF + col); cv += *(const f32x4*)(cw + 2 * DFF + col) * gf; }
        u32x2 w; w.x = cvt_pk_bf16(silu_f(cv[0]) * vv[0], silu_f(cv[1]) * vv[1]); w.y = cvt_pk_bf16(silu_f(cv[2]) * vv[2], silu_f(cv[3]) * vv[3]);
        *(u32x2*)(ACT + (size_t)row * DFF + col) = w;
    }
}

constexpr int STEPS_PER_LAYER = 13, N_STEPS = 2 + STEPS_PER_LAYER * DEPTH;
enum { ST_NOP = 0, ST_PRO, ST_ROW, ST_GEMM, ST_ATT, ST_POOL, ST_FIX };

__global__ void __launch_bounds__(NTHR, 2) dit_fwd(Args args) {
    extern __shared__ __attribute__((aligned(16))) unsigned char lds_raw[];
    LAS unsigned char* lds = (LAS unsigned char*)lds_raw;
    for (int u = threadIdx.x; u < (LDS_BYTES - LDSCTL_OFF) / 4; u += NTHR) ((LAS unsigned*)(lds + LDSCTL_OFF))[u] = 0u;
    __syncthreads();
    XcdBarrier bar; bar.bar = (unsigned*)(args.ws + WS_CTL) + CW_BAR; bar.x = 0; bar.st = nullptr;
    if (!MK_PER_PHASE) bar = xcd_barrier_post((unsigned*)(args.ws + WS_CTL) + CW_BAR, (volatile LAS unsigned*)(lds + MISC_OFF) + 8);

    for (int st = args.ph_lo; st < args.ph_hi; ++st) {
        int tid = threadIdx.x; asm volatile("" : "+v"(tid));
        int G = gridDim.x, bx = blockIdx.x; asm volatile("" : "+s"(G), "+s"(bx));
        unsigned char* ws = args.ws; asm volatile("" : "+s"(ws));
        const int lane = tid & 63, wave = __builtin_amdgcn_readfirstlane(tid >> 6);
        bf16_t* HX = (bf16_t*)(ws + WS_HX); bf16_t* Yb = (bf16_t*)(ws + WS_Y); bf16_t* MIXb = (bf16_t*)(ws + WS_MIX); bf16_t* BIG = (bf16_t*)(ws + WS_BIG);
        int kind = ST_NOP, l = 0, sub = -1, rw = 0, coff = 0; bool seam = false;
        if (st == 0) { kind = ST_PRO; seam = true; }
        else if (st == 1) { kind = ST_ROW; rw = 0; seam = true; }
        else if (st >= N_STEPS) { seam = true; }
        else { l = (st - 2) / STEPS_PER_LAYER; sub = (st - 2) % STEPS_PER_LAYER; }
        const bool even = (l & 1) == 0; const int eo = l >> 1;
        const bool ctx_live = l < 2;
        const int nrows = ctx_live ? MT : MX, nMt = nrows / 256;
        gm::Call C{}; C.G = G;
        if (sub == 0) {
            kind = ST_GEMM; C.K = DM; C.lda = DM; C.ldb = DM;
            if (even) C.j0 = gm::Job{HX, (const bf16_t*)(ws + WS_WIN + eo * SZ_WIN), BIG, (const float*)(ws + WS_TAB), nullptr, nMt, ATT_IN / 256, gm::K_ROPE, ATT_IN, 0, 0, 0, 0, 1, nullptr};
            else C.j0 = gm::Job{(const bf16_t*)(ws + WS_WMI + eo * SZ_WMI) + (size_t)512 * DM, HX, ws + WS_VT, nullptr, ws + WS_VTC, 4, nMt, gm::K_VT, 0, 0, 0, 0, 0, 1, nullptr};
        } else if (sub == 1) {
            seam = true; C.K = DM; C.lda = DM; C.ldb = DM;
            if (!even) { kind = ST_GEMM; coff = (4 * nMt) % G; C.j0 = gm::Job{HX, (const bf16_t*)(ws + WS_WMI + eo * SZ_WMI), ws + WS_UPOOL, nullptr, nullptr, nMt, 2, gm::K_PLAIN, 512, 0, 0, 0, 0, 1, nullptr}; }
            else if (l == 2) { kind = ST_GEMM; coff = (64 * 9) % G;
                C.j0 = gm::Job{HX + (size_t)MX * DM, (const bf16_t*)(ws + WS_WIN + eo * SZ_WIN) + (size_t)512 * DM, BIG, (const float*)(ws + WS_TAB), nullptr, MC / 256, 1, gm::K_ROPE, ATT_IN, MX, 512, 0, 0, 1, nullptr}; }
        } else if (sub == 2) {
            if (even) { kind = ST_ATT; seam = true; }
            else { kind = ST_GEMM; C.K = SEQ; C.lda = 2 * SEQ; C.ldb = 2 * SEQ;
                C.j0 = gm::Job{(const bf16_t*)(ws + WS_FMAT), (const bf16_t*)(ws + WS_VT), nullptr, nullptr, nullptr, 0, 16, gm::K_PLAIN, 0, 0, 0, 0, 4, 2, (float*)(ws + WS_DSLAB)}; }
        } else if (sub == 3) {
            if (!even) { kind = ST_GEMM; coff = 128 % G; C.K = SEQ; C.lda = 2 * SEQ; C.ldb = 2 * SEQ;
                C.j0 = gm::Job{(const bf16_t*)(ws + WS_FMAT) + SEQ, (const bf16_t*)(ws + WS_VT) + SEQ, nullptr, nullptr, nullptr, 0, 16, gm::K_PLAIN, 0, 0, 0, 0, 4, 2, (float*)(ws + WS_DSLAB) + (size_t)2 * 1024 * 4096}; }
        } else if (sub == 4) {
            if (!even && ctx_live) { kind = ST_GEMM; C.K = 2 * CTXL; C.lda = 2 * CTXL; C.ldb = 2 * CTXL;
                C.j0 = gm::Job{(const bf16_t*)(ws + WS_FC), (const bf16_t*)(ws + WS_VTC), MIXb, nullptr, nullptr, 1, 16, gm::K_DFT, KMO, MX, 512, 1, 0, 1, nullptr}; }
        } else if (sub == 5) {
            if (!even) seam = true;
        } else if (sub == 6) {
            if (!even) { kind = ST_POOL; seam = true; }
        } else if (sub == 7) {
            kind = ST_GEMM; seam = true; C.lda = KMO;
            if (even) { C.K = DM; C.ldb = DM; C.j0 = gm::Job{MIXb, (const bf16_t*)(ws + WS_WOUT + eo * SZ_WOUT), Yb, nullptr, nullptr, MX / 256, 4, gm::K_PLAIN, DM, 0, 0, 0, nMt - MX / 256, SL_OUT, (float*)(ws + WS_BIG)}; }
            else { C.K = WMOLD; C.ldb = WMOLD; C.j0 = gm::Job{MIXb, (const bf16_t*)(ws + WS_WMO + eo * SZ_WMO), Yb, nullptr, nullptr, MX / 256, 4, gm::K_PLAIN, DM, 0, 0, 0, nMt - MX / 256, SL_OUT, (float*)(ws + WS_BIG)}; }
        } else if (sub == 8) { kind = ST_ROW; rw = 1; seam = true; }
        else if (sub == 9) {
            kind = ST_GEMM; seam = true; C.K = DM; C.lda = DM; C.ldb = DM;
            C.j0 = gm::Job{HX, (const bf16_t*)(ws + WS_WUP + l * SZ_WUP), BIG, args.in[16] + (size_t)l * 3 * DFF, ws + WS_SIDE, nMt, NUP / 256, gm::K_FFN, DFF, 0, 0, 0, 0, 1, nullptr};
        } else if (sub == 10) { kind = ST_FIX; seam = true; }
        else if (sub == 11) {
            kind = ST_GEMM; seam = true; C.K = DFF; C.lda = DFF; C.ldb = DFF;
            C.j0 = gm::Job{BIG, (const bf16_t*)(ws + WS_WDN + l * SZ_WDN), Yb, nullptr, nullptr, MX / 256, 4, gm::K_PLAIN, DM, 0, 0, 0, nMt - MX / 256, SL_DN, (float*)(ws + WS_MIX)};
        } else if (sub == 12) { kind = ST_ROW; rw = 2; seam = true; }
        C.c = bx >= coff ? bx - coff : bx - coff + G;

        if (kind == ST_GEMM) {
            gm::gemm_phase(lds, C, tid);
            const bool hostA = (sub == 0 && even && l + 1 < DEPTH), hostB = (sub == 9 && l + 1 < DEPTH);
            if (hostA || hostB) {
                const int total = C.j0.nM * C.j0.nN, rem = total % G;
                const int rk = rem ? C.c - rem : C.c, n = rem ? G - rem : G;
                if (rk >= 0) { if (hostA) fold_layer(lds, args, l >> 1, rk, n, tid); else tr_layer(lds, args, l + 1, rk * NWAVES + wave, n * NWAVES, lane, wave); __syncthreads(); }
            }
        }
        else if (kind == ST_PRO) prologue_a(lds, args, tid, lane, wave, G);
        else if (kind == ST_ROW) row_phase(args, l, rw, rw == 0 ? MT : nrows, lane, bx * NWAVES + wave, G * NWAVES);
        else if (kind == ST_ATT) {
            const float* sink = args.in[8] + eo * 8;
            for (int u = bx; u < 512 + (l == 0 ? 64 : 0); u += G) {
                if (u < 512) { const int bh = u >> 5, i = u & 31, b = bh >> 1, hk = bh & 1; attn_unit(lds, BIG, MIXb, sink, b, hk, b * SEQ + 64 * i, 64 * i, true, tid); }
                else { const int v = u - 512, bh = v >> 2, i = v & 3, b = bh >> 1, hk = bh & 1; attn_unit(lds, BIG, MIXb, sink, b, hk, MX + b * CTXL + 64 * i, 0, false, tid); }
            }
            sconv_pass(args, eo, nrows, bx * NTHR + tid, G * NTHR);
        }
        else if (kind == ST_POOL) { pool_pass(args, nrows, bx * NTHR + tid, G * NTHR); dft_combine(args, bx * NTHR + tid, G * NTHR, lane, bx * NWAVES + wave, G * NWAVES); }
        else if (kind == ST_FIX) ffn_fixup(args, l, nrows, bx * NTHR + tid, G * NTHR);
        if (!MK_PER_PHASE && seam && st + 1 < args.ph_hi) xcd_barrier(bar);
    }
}

extern "C" void kernel_launch(void* const* d_in, const int* in_sizes, int n_in, void* d_out, int out_size, void* d_ws, size_t ws_size, hipStream_t stream) {
    static int grid = 0;
    if (grid == 0) {
        if (n_in != 18 || out_size != MX * DM || ws_size < WS_END) { fprintf(stderr, "kernel_launch: unexpected shapes (n_in %d, out %d, ws %zu)\n", n_in, out_size, ws_size); grid = -1; return; }
        int dev = 0, cus = 0;
        if (hipGetDevice(&dev) != hipSuccess || hipDeviceGetAttribute(&cus, hipDeviceAttributeMultiprocessorCount, dev) != hipSuccess) { grid = -1; return; }
        if (hipFuncSetAttribute((const void*)dit_fwd, hipFuncAttributeMaxDynamicSharedMemorySize, LDS_BYTES) != hipSuccess) { grid = -1; return; }
        (void)hipGetLastError();
        grid = cus;
    }
    if (grid < 0) return;
    if (hipMemsetAsync((char*)d_ws + WS_CTL, 0, CTL_ZERO_BYTES, stream) != hipSuccess) return;
    Args a{};
    for (int i = 0; i < 18; ++i) a.in[i] = (const float*)d_in[i];
    a.out = (float*)d_out; a.ws = (unsigned char*)d_ws;
#if MK_PER_PHASE
    for (int p = 0; p < N_STEPS; ++p) { a.ph_lo = p; a.ph_hi = p + 1; hipLaunchKernelGGL(dit_fwd, dim3(grid), dim3(NTHR), LDS_BYTES, stream, a); }
#else
    a.ph_lo = 0; a.ph_hi = N_STEPS;
    hipLaunchKernelGGL(dit_fwd, dim3(grid), dim3(NTHR), LDS_BYTES, stream, a);
#if PROBE_CLASS
    for (int r = 0; r < PROBE_REPS; ++r)
        for (int l = 0; l < DEPTH; ++l) {
            const int base = 2 + STEPS_PER_LAYER * l; const bool ev = (l & 1) == 0;
            int lo = -1, hi = -1;
            switch (PROBE_CLASS) {
                case 1: lo = base + 9; hi = lo + 1; break;
                case 2: lo = base + 11; hi = lo + 1; break;
                case 3: lo = base + 0; hi = base + 2; break;
                case 4: lo = base + 7; hi = lo + 1; break;
                case 5: if (ev) { lo = base + 2; hi = lo + 1; } break;
                case 6: if (!ev) { lo = base + 2; hi = base + 7; } break;
                case 7: if (l == 0) { lo = 0; hi = 1; } break;
                case 8: lo = 1; hi = 2; break;
                case 9: lo = base + 10; hi = lo + 1; break;
                case 10: lo = 2 + 3; hi = lo + 1; break;
                case 11: lo = base + 8; hi = lo + 1; a.dry = 1; break;
                case 12: lo = base + 12; hi = lo + 1; a.dry = 1; break;
                case 13: lo = N_STEPS; hi = N_STEPS + 9; break;
            }
            if (lo >= 0) { a.ph_lo = lo; a.ph_hi = hi; hipLaunchKernelGGL(dit_fwd, dim3(grid), dim3(NTHR), LDS_BYTES, stream, a); }
        }
#endif
#endif
}
```

```cpp
#include <hip/hip_runtime.h>
#include <cstdio>
#include <cstdint>

#ifndef MK_PER_PHASE
#define MK_PER_PHASE 0
#endif

#ifndef PROBE_CLASS
#define PROBE_CLASS 0
#endif
#define PROBE_REPS 3
#define GAS __attribute__((address_space(1)))
#define LAS __attribute__((address_space(3)))
typedef unsigned short bf16_t;
typedef short bf16x8 __attribute__((ext_vector_type(8)));
typedef float f32x4 __attribute__((ext_vector_type(4)));
typedef float f32x16 __attribute__((ext_vector_type(16)));
typedef unsigned u32x4 __attribute__((ext_vector_type(4)));
typedef unsigned u32x2 __attribute__((ext_vector_type(2)));
typedef GAS unsigned gu32;
#define RLX_AGENT __ATOMIC_RELAXED, __HIP_MEMORY_SCOPE_AGENT
#define LDS_WAIT() asm volatile("s_waitcnt lgkmcnt(0)" ::: "memory")
#define VM_WAIT() asm volatile("s_waitcnt vmcnt(0)" ::: "memory")

constexpr int DM = 1024, NBATCH = 8, SEQ = 2048, CTXL = 256, DEPTH = 4;
constexpr int MX = NBATCH * SEQ, MC = NBATCH * CTXL, MT = MX + MC;
constexpr int ATT_IN = 2304, DFF = 2816, NUP = 2 * DFF, KMO = 1536  , WMOLD = 1024  ;
constexpr float EPS = 1e-6f;
constexpr float QSCALE = 0.125f * 1.4426950408889634f;
constexpr float LOG2E = 1.4426950408889634f;
constexpr int NWAVES = 8, NTHR = 512;

constexpr size_t MiB = 1u << 20;
constexpr size_t WS_CTL = 0, CTL_ZERO_BYTES = 1 * MiB;
constexpr size_t WS_MODX = 1 * MiB, WS_MODC = WS_MODX + (size_t)4 * 8 * 6144 * 4;
constexpr size_t WS_TAB = 2 * MiB;
constexpr size_t WS_WIN = 4 * MiB, SZ_WIN = (size_t)ATT_IN * DM * 2;
constexpr size_t WS_WOUT = 13 * MiB, SZ_WOUT = (size_t)DM * DM * 2;
constexpr size_t WS_WMI = 17 * MiB, SZ_WMI = (size_t)1536 * DM * 2;
constexpr size_t WS_WMO = 23 * MiB, SZ_WMO = (size_t)DM * WMOLD * 2;
constexpr size_t WS_WUP = 29 * MiB, SZ_WUP = (size_t)NUP * DM * 2;
constexpr size_t WS_WDN = 73 * MiB, SZ_WDN = (size_t)DM * DFF * 2;
constexpr size_t WS_FMAT = 96 * MiB;
constexpr size_t WS_FC = 112 * MiB;
constexpr size_t WS_HCTX = 113 * MiB;
constexpr size_t WS_HX = 122 * MiB;
constexpr size_t WS_DSLAB = WS_HX;
constexpr size_t WS_Y = 158 * MiB;
constexpr size_t WS_BIG = 194 * MiB;
constexpr size_t WS_UPOOL = WS_BIG, WS_VT = WS_BIG + 20 * MiB, WS_VTC = WS_BIG + 52 * MiB;
constexpr size_t WS_MIX = 293 * MiB;
constexpr size_t WS_SIDE = 348 * MiB;
constexpr size_t WS_END = 368 * MiB;
constexpr int CW_BAR = 4096;
constexpr int SL_OUT = 4, SL_DN = 6;

constexpr int RING_BYTES = 131072, LDSCTL_OFF = RING_BYTES, MISC_OFF = LDSCTL_OFF + 320, LDS_BYTES = 147456;
constexpr int LDS_COSTAB = 122880;

__device__ __forceinline__ unsigned cvt_pk_bf16(float lo, float hi) { unsigned r; asm("v_cvt_pk_bf16_f32 %0, %1, %2" : "=v"(r) : "v"(lo), "v"(hi)); return r; }
__device__ __forceinline__ float bf_lo(unsigned w) { return __uint_as_float(w << 16); }
__device__ __forceinline__ float bf_hi(unsigned w) { return __uint_as_float(w & 0xffff0000u); }
__device__ __forceinline__ float wave_sum(float v) {
#pragma unroll
    for (int o = 1; o < 64; o <<= 1) v += __shfl_xor(v, o);
    return v;
}
__device__ __forceinline__ float silu_f(float x) { return x * __builtin_amdgcn_rcpf(1.0f + __builtin_amdgcn_exp2f(-x * LOG2E)); }

#define XB_TMO      128
#define XB_XCNT(j)  (256  + 64 * (j))
#define XB_XSUB(j)  (1280 + 64 * (j))
#define XB_XGEN(j)  (2304 + 64 * (j))
#define XB_TOP      3328
#define XB_TOPGEN   3392
#define XCD_BAR_WORDS 3456
#define XB_SPIN_CAP (1u << 18)
__device__ __forceinline__ unsigned xb_ld(unsigned* p)              { return __hip_atomic_load(p, __ATOMIC_RELAXED, __HIP_MEMORY_SCOPE_AGENT); }
__device__ __forceinline__ unsigned xb_add(unsigned* p, unsigned v) { return __hip_atomic_fetch_add(p, v, __ATOMIC_RELAXED, __HIP_MEMORY_SCOPE_AGENT); }
__device__ __forceinline__ unsigned xb_xcc_id() { return (unsigned)__builtin_amdgcn_s_getreg((3 << 11) | 20) & 0xFu; }
#define XB_SPIN(cond, bar) do { unsigned _sp = 0; while (cond) { __builtin_amdgcn_s_sleep(1); \
    if ((++_sp & 255u) == 0u) { if (xb_ld(&(bar)[XB_TMO])) break; if (_sp > XB_SPIN_CAP) { atomicAdd(&(bar)[XB_TMO], 1u); break; } } } } while (0)
struct XcdBarrier { unsigned* bar; unsigned x; volatile LAS unsigned* st; };
__device__ __forceinline__ XcdBarrier xcd_barrier_post(unsigned* bar, volatile LAS unsigned* st) {
    XcdBarrier b; b.bar = bar; b.x = xb_xcc_id(); b.st = st;
    if (threadIdx.x == 0) (void)xb_add(&bar[XB_XCNT(b.x)], 1u);
    return b;
}
__device__ __forceinline__ void xcd_barrier_complete(unsigned* bar, unsigned x, unsigned& nloc, unsigned& nx) {
    const unsigned G = gridDim.x * gridDim.y * gridDim.z;
    unsigned sum, cnt, mine, sp = 0u;
    for (;;) {
        sum = 0u; cnt = 0u; mine = 0u;
#pragma unroll
        for (unsigned j = 0; j < 16; ++j) { const unsigned c = xb_ld(&bar[XB_XCNT(j)]); sum += c; cnt += (c > 0u) ? 1u : 0u; mine = (j == x) ? c : mine; }
        if (sum == G) break;
        __builtin_amdgcn_s_sleep(1);
        if ((++sp & 255u) == 0u) { if (xb_ld(&bar[XB_TMO])) break; if (sp > XB_SPIN_CAP) { atomicAdd(&bar[XB_TMO], 1u); break; } }
    }
    nloc = mine > 0u ? mine : 1u; nx = cnt > 0u ? cnt : 1u;
}
__device__ __forceinline__ void xcd_barrier(const XcdBarrier& b) {
    asm volatile("s_waitcnt vmcnt(0)" ::: "memory");
    __syncthreads();
    if (threadIdx.x == 0) {
        unsigned* bar = b.bar; asm volatile("" : "+s"(bar));
        __builtin_amdgcn_s_waitcnt(0);
        unsigned nloc = b.st[0], nx = b.st[1];
        if (nloc == 0u) { xcd_barrier_complete(bar, b.x, nloc, nx); b.st[0] = nloc; b.st[1] = nx; }
        const unsigned old = xb_add(&bar[XB_XSUB(b.x)], 1u);
        const unsigned gen = old / nloc;
        if (old + 1u == (gen + 1u) * nloc) {
            __builtin_amdgcn_fence(__ATOMIC_RELEASE, "agent");
            asm volatile("s_waitcnt vmcnt(0)" ::: "memory");
            const unsigned og = xb_add(&bar[XB_TOP], 1u);
            const unsigned tg = og / nx;
            if (og + 1u == (tg + 1u) * nx) xb_add(&bar[XB_TOPGEN], 1u);
            else XB_SPIN(xb_ld(&bar[XB_TOPGEN]) == tg, bar);
            __builtin_amdgcn_fence(__ATOMIC_ACQUIRE, "agent");
            xb_add(&bar[XB_XGEN(b.x)], 1u);
            asm volatile("s_waitcnt vmcnt(0)" ::: "memory");
        } else {
            XB_SPIN(xb_ld(&bar[XB_XGEN(b.x)]) == gen, bar);
            __builtin_amdgcn_fence(__ATOMIC_ACQUIRE, "agent");
            asm volatile("s_waitcnt vmcnt(0)" ::: "memory");
        }
    }
    __syncthreads();
}

namespace gm {
constexpr int BM = 256, BK = 64, HALF = 128, HTB = HALF * BK * 2, NXCD = 8, WGM = 8;
__device__ __forceinline__ int lds_byte(int r, int c) { const int st = (r >> 4) * 2 + (c >> 5), rr = r & 15, cc = c & 31, ob = rr * 64 + cc * 2; return st * 1024 + (ob ^ (((ob >> 9) & 1) << 5)); }
__device__ __forceinline__ void stage_rc(int b, int& R, int& C) { const int st = b / 1024, sb = b % 1024, swz = sb ^ (((sb >> 9) & 1) << 5); R = (st >> 1) * 16 + swz / 64; C = (st & 1) * 32 + (swz % 64) / 2; }
__device__ __forceinline__ int perm32(int rho) { const int n = rho >> 4, i = rho & 15; return 8 * (i >> 2) + 4 * n + (i & 3); }

enum { K_PLAIN = 0, K_DFT = 1, K_ROPE = 2, K_VT = 3, K_FFN = 4 };
struct Job { const bf16_t* A; const bf16_t* B; void* out; const float* aux; void* out2; int nM, nN, kind, ldc, row0, col0, p0; int cM, S; float* slab; };
struct Call { int K, lda, ldb, G, c; Job j0; };
struct Unit { int pm, pn, kp0, np, slice; };

__device__ __forceinline__ void next_unit(const Call& C, int i, int& pm, int& pn, int& kp0, int& np, int& slice) {
    const long L = (long)i * C.G + C.c;
    const int nM = C.j0.nM, nN = C.j0.nN, nwg = nM * nN, P = C.K / (2 * BK);
    const int S = C.j0.S, nsl = C.j0.cM * nN * S;
    pm = -1; pn = 0; kp0 = 0; np = P; slice = -1;
    if (L < nwg) {
        int wgid = (int)L; { const int q = nwg / NXCD, r = nwg % NXCD, xcd = wgid % NXCD, off = wgid / NXCD; wgid = (xcd < r ? xcd * (q + 1) : r * (q + 1) + (xcd - r) * q) + off; }
        const int nig = WGM * nN, gid = wgid / nig, fm = gid * WGM, gsz = (nM - fm) < WGM ? (nM - fm) : WGM;
        pm = fm + ((wgid % nig) % gsz); pn = (wgid % nig) / gsz;
    } else if (L < (long)nwg + nsl) {
        const int Ls = (int)(L - nwg);
        const int tile = Ls / S, sl = Ls - tile * S, base = P / S, rem = P - base * S;
        pm = nM + tile / nN; pn = tile % nN; slice = sl; np = base + (sl < rem ? 1 : 0); kp0 = sl * base + (sl < rem ? sl : rem);
    }
}

__device__ __forceinline__ u32x4 pack8(const f32x4& a, const f32x4& b) { u32x4 w; w.x = cvt_pk_bf16(a[0], a[1]); w.y = cvt_pk_bf16(a[2], a[3]); w.z = cvt_pk_bf16(b[0], b[1]); w.w = cvt_pk_bf16(b[2], b[3]); return w; }

__device__ __forceinline__ void epi_plain(const f32x4 (&acc)[2][2][4][2], const Job& J, int rowt, int colb, int wr, int wc, int fr, int fq) {
    bf16_t* O = (bf16_t*)J.out;
#pragma unroll
    for (int ai = 0; ai < 2; ++ai)
#pragma unroll
        for (int m = 0; m < 4; ++m) {
            bf16_t* rowp = O + (size_t)(rowt + ai * HALF + wr * 64 + m * 16 + fr) * J.ldc + colb + wc * 32 + 8 * fq;
#pragma unroll
            for (int bj = 0; bj < 2; ++bj) *(u32x4*)(rowp + bj * HALF) = pack8(acc[ai][bj][m][0], acc[ai][bj][m][1]);
        }
}
__device__ __forceinline__ void epi_rope(const f32x4 (&acc)[2][2][4][2], const Job& J, int rowt, int colb, int wr, int wc, int fr, int fq) {
    bf16_t* O = (bf16_t*)J.out; const float* TC = J.aux; const float* TS = J.aux + 1024;
    const bool anyrope = (rowt < MX) && (colb < 640); const int half = wc & 1, j0 = 8 * (fq & 1); const float sgn = fq < 2 ? -1.f : 1.f;
#pragma unroll
    for (int ai = 0; ai < 2; ++ai)
#pragma unroll
        for (int m = 0; m < 4; ++m) {
            const int grow = rowt + ai * HALF + wr * 64 + m * 16 + fr;
            f32x4 c0 = {1.f, 1.f, 1.f, 1.f}, c1 = c0, s0 = {0.f, 0.f, 0.f, 0.f}, s1 = s0;
            if (anyrope) {
                const int t = grow & (SEQ - 1), pos = half ? (t & 63) : (t >> 6);
                c0 = *(const f32x4*)(TC + pos * 16 + j0); c1 = *(const f32x4*)(TC + pos * 16 + j0 + 4);
                s0 = *(const f32x4*)(TS + pos * 16 + j0); s1 = *(const f32x4*)(TS + pos * 16 + j0 + 4);
            }
#pragma unroll
            for (int bj = 0; bj < 2; ++bj) {
                const int cs = colb + bj * HALF; const bool isq = cs < 512, isk = (cs >= 512) && (cs < 640);
                f32x4 v0 = acc[ai][bj][m][0], v1 = acc[ai][bj][m][1];
                if ((isq || isk) && anyrope) {
                    f32x4 p0, p1;
#pragma unroll
                    for (int e = 0; e < 4; ++e) { p0[e] = __shfl_xor(v0[e], 32); p1[e] = __shfl_xor(v1[e], 32); }
                    v0 = v0 * c0 + (p0 * sgn) * s0; v1 = v1 * c1 + (p1 * sgn) * s1;
                }
                if (isq) { v0 = v0 * QSCALE; v1 = v1 * QSCALE; }
                *(u32x4*)(O + (size_t)grow * J.ldc + cs + wc * 32 + 8 * fq) = pack8(v0, v1);
            }
            asm volatile("" ::: "memory");
        }
}
__device__ __forceinline__ void epi_vt(const f32x4 (&acc)[2][2][4][2], const Job& J, int pm, int pn, int wr, int wc, int fr, int fq) {
    const int s = pm >> 1, c0 = (pm & 1) * 256;
    bf16_t* base; size_t cstride;
    if (pn < MX / 256) { const int b = pn >> 3, t0 = (pn & 7) * 256; base = (bf16_t*)J.out + ((size_t)(b * 512) * 2 + s) * SEQ + t0; cstride = 2 * SEQ; }
    else { const int b = pn - MX / 256; base = (bf16_t*)J.out2 + ((size_t)(b * 512) * 2 + s) * CTXL; cstride = 2 * CTXL; }
#pragma unroll
    for (int ai = 0; ai < 2; ++ai)
#pragma unroll
        for (int m = 0; m < 4; ++m) {
            bf16_t* rowp = base + (size_t)(c0 + ai * HALF + wr * 64 + m * 16 + fr) * cstride + wc * 32 + 8 * fq;
#pragma unroll
            for (int bj = 0; bj < 2; ++bj) *(u32x4*)(rowp + bj * HALF) = pack8(acc[ai][bj][m][0], acc[ai][bj][m][1]);
        }
}
__device__ __forceinline__ void epi_ffn(const f32x4 (&acc)[2][2][4][2], const Job& J, int rowt, int pn, int wr, int wc, int fr, int fq, int lane) {
    bf16_t* O = (bf16_t*)J.out; float* SIDE = (float*)J.out2; const float* cw = J.aux;
    const int col = 128 * pn + 32 * wc + 8 * fq;
    f32x4 w0[2], w1[2], w2[2];
#pragma unroll
    for (int n = 0; n < 2; ++n) { w0[n] = *(const f32x4*)(cw + col + 4 * n); w1[n] = *(const f32x4*)(cw + DFF + col + 4 * n); w2[n] = *(const f32x4*)(cw + 2 * DFF + col + 4 * n); }
    const int srcdn = (lane & 48) | ((fr + 15) & 15), srcup = (lane & 48) | ((fr + 1) & 15);
#pragma unroll
    for (int ai = 0; ai < 2; ++ai) {
        const int blk = (rowt + ai * HALF + wr * 64) >> 6;
        f32x4 cv[4][2];
#pragma unroll
        for (int n = 0; n < 2; ++n)
#pragma unroll
            for (int e = 0; e < 4; ++e) {
                float g[4], dn[4], up[4];
#pragma unroll
                for (int m = 0; m < 4; ++m) { g[m] = acc[ai][0][m][n][e]; dn[m] = __shfl(g[m], srcdn); up[m] = __shfl(g[m], srcup); }
#pragma unroll
                for (int m = 0; m < 4; ++m) {
                    const float pv = fr > 0 ? dn[m] : (m > 0 ? dn[m - 1] : 0.f);
                    const float nx = fr < 15 ? up[m] : (m < 3 ? up[m + 1] : 0.f);
                    cv[m][n][e] = w0[n][e] * pv + w1[n][e] * g[m] + w2[n][e] * nx;
                }
            }
#pragma unroll
        for (int m = 0; m < 4; ++m) {
            const int grow = rowt + ai * HALF + wr * 64 + m * 16 + fr;
            const bool first = (m == 0 && fr == 0), last = (m == 3 && fr == 15);
            if (first || last) {
                float* sp = SIDE + ((size_t)(blk * 2 + (last ? 1 : 0)) * 3) * DFF + col;
#pragma unroll
                for (int n = 0; n < 2; ++n) { *(f32x4*)(sp + 4 * n) = cv[m][n]; *(f32x4*)(sp + DFF + 4 * n) = acc[ai][0][m][n]; *(f32x4*)(sp + 2 * DFF + 4 * n) = acc[ai][1][m][n]; }
            } else {
                f32x4 a0, a1;
#pragma unroll
                for (int e = 0; e < 4; ++e) { a0[e] = silu_f(cv[m][0][e]) * acc[ai][1][m][0][e]; a1[e] = silu_f(cv[m][1][e]) * acc[ai][1][m][1][e]; }
                *(u32x4*)(O + (size_t)grow * DFF + col) = pack8(a0, a1);
            }
        }
    }
}
__device__ __forceinline__ void epi_slab(const f32x4 (&acc)[2][2][4][2], const Job& J, const Unit& u, int wr, int wc, int fr, int fq) {
    const int ld = J.nN * BM;
    float* O = J.slab + ((size_t)u.slice * J.cM * BM + (size_t)(u.pm - J.nM) * BM) * ld + u.pn * BM;
#pragma unroll
    for (int ai = 0; ai < 2; ++ai)
#pragma unroll
        for (int m = 0; m < 4; ++m) {
            float* rowp = O + (size_t)(ai * HALF + wr * 64 + m * 16 + fr) * ld + wc * 32 + 8 * fq;
#pragma unroll
            for (int bj = 0; bj < 2; ++bj) { *(f32x4*)(rowp + bj * HALF) = acc[ai][bj][m][0]; *(f32x4*)(rowp + bj * HALF + 4) = acc[ai][bj][m][1]; }
        }
}
__device__ __forceinline__ void epilogue(const f32x4 (&acc)[2][2][4][2], const Call& C, const Unit& u, int wr, int wc, int fr_, int fq_, int lane) {
    asm volatile("" : "+v"(lane));
    const int fr = lane & 15, fq = lane >> 4;
    const Job& J = C.j0;
    if (u.slice >= 0) epi_slab(acc, J, u, wr, wc, fr, fq);
    else if (J.kind == K_PLAIN) epi_plain(acc, J, J.row0 + u.pm * BM, J.col0 + u.pn * BM, wr, wc, fr, fq);
    else if (J.kind == K_DFT) epi_plain(acc, J, J.row0 + ((u.pn >> 1) * J.p0 + u.pm) * BM, J.col0 + (u.pn & 1) * BM, wr, wc, fr, fq);
    else if (J.kind == K_ROPE) epi_rope(acc, J, J.row0 + u.pm * BM, J.col0 + u.pn * BM, wr, wc, fr, fq);
    else if (J.kind == K_VT) epi_vt(acc, J, u.pm, u.pn, wr, wc, fr, fq);
    else epi_ffn(acc, J, J.row0 + u.pm * BM, u.pn, wr, wc, fr, fq, lane);
}

__device__ __forceinline__ void gemm_phase(LAS unsigned char* lds, const Call& C, const int tid) {
    const int wid = __builtin_amdgcn_readfirstlane(tid >> 6), lane = tid & 63, wr = wid >> 2, wc = wid & 3, fr = lane & 15, fq = lane >> 4;
    unsigned voffA[2], voffB[2];
#pragma unroll
    for (int i = 0; i < 2; ++i) { int R, Cc; stage_rc(tid * 16 + i * 8192, R, Cc); const int Rb = (R & ~31) + perm32(R & 31);
        voffA[i] = (unsigned)(R * C.lda + Cc) * 2u; voffB[i] = (unsigned)(Rb * C.ldb + Cc) * 2u; }
    const size_t kstep = (size_t)(BK * 2);
    const size_t hstepA = (size_t)HALF * C.lda * 2, hstepB = (size_t)HALF * C.ldb * 2;
    const unsigned ldsw = (unsigned)wid * 1024u;
    const int aoff = lds_byte(wr * 64 + fr, fq * 8), boff = lds_byte(wc * 32 + fr, fq * 8);
#define PG8_SA(b, h) (((b) * 2 + (h)) * HTB)
#define PG8_SB(b, h) ((4 + (b) * 2 + (h)) * HTB)
#define PG8_STAGE(bufoff, gbase, voff) do { _Pragma("unroll") for (int _i = 0; _i < 2; ++_i) { unsigned _vo = (voff)[_i]; asm volatile("" : "+v"(_vo));   \
        __builtin_amdgcn_global_load_lds((const unsigned*)((const char*)(gbase) + _vo), (LAS unsigned*)(lds + (bufoff) + ldsw + _i * 8192), 16, 0, 0); } } while (0)
#define PG8_LDA(dst, b, h) do { _Pragma("unroll") for (int m = 0; m < 4; ++m) _Pragma("unroll") for (int k = 0; k < 2; ++k) dst[m][k] = *(const LAS bf16x8*)(lds + PG8_SA(b, h) + aoff + m * 2048 + k * 1024); } while (0)
#define PG8_LDB(dst, b, h) do { _Pragma("unroll") for (int n = 0; n < 2; ++n) _Pragma("unroll") for (int k = 0; k < 2; ++k) dst[n][k] = *(const LAS bf16x8*)(lds + PG8_SB(b, h) + boff + n * 2048 + k * 1024); } while (0)
#define PG8_MMA(ai, bj, At, Bt) do { __builtin_amdgcn_s_setprio(1); _Pragma("unroll") for (int m = 0; m < 4; ++m) _Pragma("unroll") for (int n = 0; n < 2; ++n) _Pragma("unroll") for (int k = 0; k < 2; ++k) \
        acc[ai][bj][m][n] = __builtin_amdgcn_mfma_f32_16x16x32_bf16(Bt[n][k], At[m][k], acc[ai][bj][m][n], 0, 0, 0); __builtin_amdgcn_s_setprio(0); } while (0)
#define PG8_WAIT_V(n) asm volatile("s_waitcnt vmcnt(" #n ")" ::: "memory")
#define PG8_WAIT_L(n) asm volatile("s_waitcnt lgkmcnt(" #n ")" ::: "memory")
#define PG8_BAR __builtin_amdgcn_s_barrier()
#define PG8_SCHED __builtin_amdgcn_sched_barrier(0)
#define PG8_APTR(u) ((const char*)C.j0.A + (size_t)(u).pm * 2 * hstepA + (size_t)(u).kp0 * (4 * BK))
#define PG8_BPTR(u) ((const char*)C.j0.B + (size_t)(u).pn * 2 * hstepB + (size_t)(u).kp0 * (4 * BK))
    Unit cur, nxt; int ui = 0;
    next_unit(C, 0, cur.pm, cur.pn, cur.kp0, cur.np, cur.slice);
    if (cur.pm < 0) return;
    f32x4 acc[2][2][4][2];
#pragma unroll
    for (int a = 0; a < 2; ++a)
#pragma unroll
        for (int b = 0; b < 2; ++b)
#pragma unroll
            for (int m = 0; m < 4; ++m)
#pragma unroll
                for (int n = 0; n < 2; ++n) acc[a][b][m][n] = (f32x4){0.f, 0.f, 0.f, 0.f};
    bf16x8 At[4][2], B0[2][2], B1[2][2];
    const char* cA = PG8_APTR(cur); const char* cB = PG8_BPTR(cur);
    PG8_STAGE(PG8_SB(0, 0), cB, voffB); PG8_STAGE(PG8_SB(0, 1), cB + hstepB, voffB); PG8_STAGE(PG8_SA(0, 0), cA, voffA); PG8_STAGE(PG8_SA(0, 1), cA + hstepA, voffA);
    if (wr == 1) PG8_BAR;
    PG8_WAIT_V(2); PG8_BAR;
    PG8_STAGE(PG8_SB(1, 0), cB + kstep, voffB); PG8_STAGE(PG8_SA(1, 0), cA + kstep, voffA); PG8_STAGE(PG8_SB(1, 1), cB + hstepB + kstep, voffB);
    PG8_WAIT_V(6); PG8_BAR;
    for (;;) {
        next_unit(C, ui + 1, nxt.pm, nxt.pn, nxt.kp0, nxt.np, nxt.slice);
        const bool has_next = nxt.pm >= 0;
        const char* nA = has_next ? PG8_APTR(nxt) : cA; const char* nB = has_next ? PG8_BPTR(nxt) : cB;
        const int nt = 2 * cur.np;
        for (int t = 0; t < nt; t += 2) {
            const bool last = (t == nt - 2);
            const char* a1 = cA + (size_t)(t + 1) * kstep;
            const char* a2 = last ? nA : cA + (size_t)(t + 2) * kstep; const char* b2 = last ? nB : cB + (size_t)(t + 2) * kstep;
            const char* a3 = a2 + kstep; const char* b3 = b2 + kstep;
            PG8_LDB(B0, 0, 0); PG8_LDB(B1, 0, 1); PG8_SCHED; PG8_LDA(At, 0, 0); PG8_STAGE(PG8_SA(1, 1), a1 + hstepA, voffA);
            PG8_WAIT_V(8); PG8_WAIT_L(0); PG8_BAR; PG8_MMA(0, 0, At, B0); PG8_MMA(0, 1, At, B1); PG8_BAR; PG8_SCHED;
            PG8_LDA(At, 0, 1); PG8_STAGE(PG8_SB(0, 0), b2, voffB); PG8_STAGE(PG8_SB(0, 1), b2 + hstepB, voffB); PG8_STAGE(PG8_SA(0, 0), a2, voffA);
            PG8_WAIT_V(8); PG8_WAIT_L(0); PG8_BAR; PG8_MMA(1, 0, At, B0); PG8_MMA(1, 1, At, B1); PG8_BAR; PG8_SCHED;
            PG8_LDB(B0, 1, 0); PG8_LDB(B1, 1, 1); PG8_SCHED; PG8_LDA(At, 1, 0); PG8_STAGE(PG8_SA(0, 1), a2 + hstepA, voffA);
            PG8_WAIT_V(8); PG8_WAIT_L(0); PG8_BAR; PG8_MMA(0, 0, At, B0); PG8_MMA(0, 1, At, B1); PG8_BAR; PG8_SCHED;
            PG8_LDA(At, 1, 1); PG8_STAGE(PG8_SB(1, 0), b3, voffB); PG8_STAGE(PG8_SB(1, 1), b3 + hstepB, voffB); PG8_STAGE(PG8_SA(1, 0), a3, voffA);
            PG8_WAIT_V(8); PG8_WAIT_L(0); PG8_BAR; PG8_MMA(1, 0, At, B0); PG8_MMA(1, 1, At, B1); PG8_BAR; PG8_SCHED;
        }
        if (wr == 0) PG8_BAR;
        epilogue(acc, C, cur, wr, wc, fr, fq, lane);
        if (!has_next) break;
#pragma unroll
        for (int a = 0; a < 2; ++a)
#pragma unroll
            for (int b = 0; b < 2; ++b)
#pragma unroll
                for (int m = 0; m < 4; ++m)
#pragma unroll
                    for (int n = 0; n < 2; ++n) acc[a][b][m][n] = (f32x4){0.f, 0.f, 0.f, 0.f};
        cur.pm = nxt.pm; cur.pn = nxt.pn; cur.kp0 = nxt.kp0; cur.np = nxt.np; cur.slice = nxt.slice; cA = nA; cB = nB; ++ui;
        if (wr == 1) PG8_BAR;
    }
    PG8_WAIT_V(0);
    PG8_BAR;
#undef PG8_SA
#undef PG8_SB
#undef PG8_STAGE
#undef PG8_LDA
#undef PG8_LDB
#undef PG8_MMA
#undef PG8_WAIT_V
#undef PG8_WAIT_L
#undef PG8_BAR
#undef PG8_SCHED
#undef PG8_APTR
#undef PG8_BPTR
}
}

__device__ __forceinline__ void tr_load(const float* src, int ldn, int lane, f32x4 (&v)[8]) {
    const int r8 = lane >> 3, c4 = lane & 7;
#pragma unroll
    for (int i = 0; i < 8; ++i) v[i] = *(const f32x4*)(src + (size_t)(8 * i + r8) * ldn + 4 * c4);
}
__device__ __forceinline__ void tr_finish(const f32x4 (&v)[8], bf16_t* dst, bf16_t* dst2, int ldk, LAS float* scr, int lane) {
    const int r8 = lane >> 3, c4 = lane & 7;
#pragma unroll
    for (int i = 0; i < 8; ++i) { LAS float* w = scr + (8 * i + r8) * 33 + 4 * c4; w[0] = v[i][0]; w[1] = v[i][1]; w[2] = v[i][2]; w[3] = v[i][3]; }
    LDS_WAIT(); asm volatile("" ::: "memory");
    const int c = lane & 7;
#pragma unroll
    for (int j = 0; j < 4; ++j) { const int n = (lane >> 3) + 8 * j; const LAS float* sp = scr + (8 * c) * 33 + n;
        u32x4 o; o.x = cvt_pk_bf16(sp[0 * 33], sp[1 * 33]); o.y = cvt_pk_bf16(sp[2 * 33], sp[3 * 33]); o.z = cvt_pk_bf16(sp[4 * 33], sp[5 * 33]); o.w = cvt_pk_bf16(sp[6 * 33], sp[7 * 33]);
        *(u32x4*)(dst + (size_t)n * ldk + 8 * c) = o; if (dst2) *(u32x4*)(dst2 + (size_t)n * ldk + 8 * c) = o; }
    LDS_WAIT(); asm volatile("" ::: "memory");
}

struct Args { const float* in[18]; float* out; unsigned char* ws; int ph_lo, ph_hi, dry, pad; };

__device__ __forceinline__ void mod_item(LAS unsigned char* lds, const Args& a, int item, int tid) {
    const int l = item >> 6, n0 = 96 * (item & 63);
    const float* cv = a.in[1]; const float* cc = a.in[3]; const float* mw = a.in[4] + (size_t)l * DM * 6144; const float* mb = a.in[5] + l * 6144;
    LAS float* sv = (LAS float*)lds; LAS float* red = (LAS float*)(lds + 40960);
    for (int i = tid; i < 9 * DM; i += NTHR) { const int r = i >> 10, k = i & 1023; const float v = r < 8 ? cv[r * DM + k] : cc[k]; sv[i] = v / (1.0f + __expf(-v)); }
    __syncthreads();
    const int col4 = tid % 24, kg = tid / 24;
    if (kg < 21) {
        f32x4 acc[9];
#pragma unroll
        for (int r = 0; r < 9; ++r) acc[r] = (f32x4){0.f, 0.f, 0.f, 0.f};
#pragma unroll 7
        for (int k = kg; k < DM; k += 21) {
            const f32x4 w = *(const f32x4*)(mw + (size_t)k * 6144 + n0 + 4 * col4);
#pragma unroll
            for (int r = 0; r < 9; ++r) acc[r] += w * sv[r * DM + k];
        }
#pragma unroll
        for (int r = 0; r < 9; ++r)
#pragma unroll
            for (int e = 0; e < 4; ++e) red[(kg * 9 + r) * 96 + 4 * col4 + e] = acc[r][e];
    }
    __syncthreads();
    float* modx = (float*)(a.ws + WS_MODX); float* modc = (float*)(a.ws + WS_MODC);
    for (int idx = tid; idx < 9 * 96; idx += NTHR) {
        const int r = idx / 96, n = idx % 96; float s = mb[n0 + n];
        for (int g = 0; g < 21; ++g) s += red[(g * 9 + r) * 96 + n];
        if (r < 8) modx[((size_t)(l * 8 + r)) * 6144 + n0 + n] = s; else modc[(size_t)l * 6144 + n0 + n] = s;
    }
    __syncthreads();
}

__device__ __forceinline__ void fold_in_item(LAS unsigned char* lds, const Args& a, int item, int tid) {
    const int o = item >> 6, g = (item >> 4) & 3, kc = item & 15;
    const float* W = a.in[11] + (size_t)o * DM * DM; bf16_t* WMI = (bf16_t*)(a.ws + WS_WMI + o * SZ_WMI);
    LAS float* Wl = (LAS float*)lds; const LAS float* tab = (const LAS float*)(lds + LDS_COSTAB);
    LAS float* tc = (LAS float*)(lds + 64 * 129 * 4); LAS float* ts = tc + 128;
    if (tid < 128) { tc[tid] = tab[16 * tid]; ts[tid] = tab[(16 * tid - 512) & 2047]; }
    {   f32x4 t[4];
#pragma unroll
        for (int i = 0; i < 4; ++i) { const int idx = tid + NTHR * i, kk = idx >> 5, j4 = idx & 31; t[i] = *(const f32x4*)(W + (size_t)(64 * kc + kk) * DM + 512 + 128 * g + 4 * j4); }
#pragma unroll
        for (int i = 0; i < 4; ++i) { const int idx = tid + NTHR * i, kk = idx >> 5, j4 = idx & 31; LAS float* w = Wl + kk * 129 + 4 * j4; w[0] = t[i][0]; w[1] = t[i][1]; w[2] = t[i][2]; w[3] = t[i][3]; } }
    __syncthreads();
    const int lane = tid & 63, wv = tid >> 6, i32 = lane & 31, hi = lane >> 5, kh = wv >> 2, jb = wv & 3, jp = 32 * jb + i32;
    f32x16 dc, ds;
#pragma unroll
    for (int r = 0; r < 16; ++r) { dc[r] = 0.f; ds[r] = 0.f; }
    const LAS float* arow = Wl + (32 * kh + i32) * 129 + hi;
#pragma unroll 8
    for (int st = 0; st < 64; ++st) {
        const float av = arow[2 * st]; const int ph = ((2 * st + hi) * jp) & 127;
        dc = __builtin_amdgcn_mfma_f32_32x32x2f32(av, tc[ph], dc, 0, 0, 0);
        ds = __builtin_amdgcn_mfma_f32_32x32x2f32(av, ts[ph], ds, 0, 0, 0);
    }
    bf16_t* oc = WMI + (size_t)(512 + 128 * g + jp) * DM + 64 * kc + 32 * kh + 4 * hi; bf16_t* os = oc + (size_t)512 * DM;
#pragma unroll
    for (int q = 0; q < 4; ++q) {
        u32x2 wc, ws_; wc.x = cvt_pk_bf16(dc[4 * q], dc[4 * q + 1]); wc.y = cvt_pk_bf16(dc[4 * q + 2], dc[4 * q + 3]); ws_.x = cvt_pk_bf16(ds[4 * q], ds[4 * q + 1]); ws_.y = cvt_pk_bf16(ds[4 * q + 2], ds[4 * q + 3]);
        *(u32x2*)(oc + 8 * q) = wc; *(u32x2*)(os + 8 * q) = ws_;
    }
    __syncthreads();
}
__device__ __forceinline__ void fold_out_item(LAS unsigned char* lds, const Args& a, int item, int tid) {
    const int o = item >> 6, g = (item >> 4) & 3, nc = item & 15;
    const float* WG = a.in[12] + (size_t)(o * 4 + g) * 128 * 128; const float* SC = a.in[13] + o * 512 + 128 * g; const float* WO = a.in[14] + (size_t)o * DM * DM + (size_t)(128 * g) * DM + 64 * nc;
    bf16_t* WMO = (bf16_t*)(a.ws + WS_WMO + o * SZ_WMO);
    LAS float* Wg = (LAS float*)lds; LAS float* Wo = (LAS float*)(lds + 66560);
    {   f32x4 t[8], u[4];
#pragma unroll
        for (int i = 0; i < 8; ++i) t[i] = *(const f32x4*)(WG + 4 * (tid + NTHR * i));
#pragma unroll
        for (int i = 0; i < 4; ++i) { const int idx = tid + NTHR * i, d = idx >> 4, n4 = idx & 15; u[i] = *(const f32x4*)(WO + (size_t)d * DM + 4 * n4) * SC[d]; }
#pragma unroll
        for (int i = 0; i < 8; ++i) { const int idx = 4 * (tid + NTHR * i), c = idx >> 7, d = idx & 127; LAS float* w = Wg + c * 129 + d; w[0] = t[i][0]; w[1] = t[i][1]; w[2] = t[i][2]; w[3] = t[i][3]; }
#pragma unroll
        for (int i = 0; i < 4; ++i) { const int idx = tid + NTHR * i, d = idx >> 4, n4 = idx & 15; LAS float* w = Wo + d * 65 + 4 * n4; w[0] = u[i][0]; w[1] = u[i][1]; w[2] = u[i][2]; w[3] = u[i][3]; } }
    __syncthreads();
    const int lane = tid & 63, wv = tid >> 6, i32 = lane & 31, hi = lane >> 5, cb = wv & 3, nb = wv >> 2;
    f32x16 dd;
#pragma unroll
    for (int r = 0; r < 16; ++r) dd[r] = 0.f;
    const LAS float* arow = Wg + (32 * cb + i32) * 129 + hi; const LAS float* bcol = Wo + hi * 65 + 32 * nb + i32;
#pragma unroll 8
    for (int st = 0; st < 64; ++st) dd = __builtin_amdgcn_mfma_f32_32x32x2f32(arow[2 * st], bcol[2 * st * 65], dd, 0, 0, 0);
    bf16_t* op = WMO + (size_t)(64 * nc + 32 * nb + i32) * WMOLD + 128 * g + 32 * cb + 4 * hi;
#pragma unroll
    for (int q = 0; q < 4; ++q) { u32x2 w; w.x = cvt_pk_bf16(dd[4 * q], dd[4 * q + 1]); w.y = cvt_pk_bf16(dd[4 * q + 2], dd[4 * q + 3]); *(u32x2*)(op + 8 * q) = w; }
    __syncthreads();
}

struct TrDesc { const float* src; bf16_t* dst; bf16_t* dst2; int ldn, ldk; };
__device__ __forceinline__ TrDesc tr_decode(const Args& a, int l, int it) {
    constexpr int I_WIN = 16 * 72, I_WOUT = 16 * 32, I_WMI = 16 * 16, I_WMO = 8 * 32, I_WUP = 16 * 176;
    const bool even = (l & 1) == 0; const int eo = l >> 1;
    const int n1 = even ? I_WIN : I_WMI, n2 = even ? I_WOUT : I_WMO;
    TrDesc d; d.dst2 = nullptr; int r = it;
    if (r < n1) {
        if (even) { const int kb = r / 72, nb = r % 72; d.src = a.in[7] + (size_t)eo * DM * ATT_IN + (size_t)(64 * kb) * ATT_IN + 32 * nb; d.ldn = ATT_IN; d.dst = (bf16_t*)(a.ws + WS_WIN + eo * SZ_WIN) + (size_t)(32 * nb) * DM + 64 * kb; d.ldk = DM; }
        else { const int kb = r / 16, nb = r % 16; d.src = a.in[11] + (size_t)eo * DM * DM + (size_t)(64 * kb) * DM + 32 * nb; d.ldn = DM; d.dst = (bf16_t*)(a.ws + WS_WMI + eo * SZ_WMI) + (size_t)(32 * nb) * DM + 64 * kb; d.ldk = DM; }
        return d; }
    r -= n1;
    if (r < n2) {
        const int kb = r / 32, nb = r % 32;
        if (even) { d.src = a.in[10] + (size_t)eo * DM * DM + (size_t)(64 * kb) * DM + 32 * nb; d.ldn = DM; d.dst = (bf16_t*)(a.ws + WS_WOUT + eo * SZ_WOUT) + (size_t)(32 * nb) * DM + 64 * kb; d.ldk = DM; }
        else { d.src = a.in[14] + (size_t)eo * DM * DM + (size_t)(512 + 64 * kb) * DM + 32 * nb; d.ldn = DM; d.dst = (bf16_t*)(a.ws + WS_WMO + eo * SZ_WMO) + (size_t)(32 * nb) * WMOLD + 512 + 64 * kb; d.ldk = WMOLD; }
        return d; }
    r -= n2;
    if (r < I_WUP) { const int kb = r / 176, nb = r % 176, j = nb >> 3, sub = nb & 7; const int scol = sub < 4 ? 128 * j + 32 * sub : DFF + 128 * j + 32 * (sub - 4);
        d.src = a.in[15] + (size_t)l * DM * NUP + (size_t)(64 * kb) * NUP + scol; d.ldn = NUP; d.dst = (bf16_t*)(a.ws + WS_WUP + l * SZ_WUP) + (size_t)(32 * nb) * DM + 64 * kb; d.ldk = DM; return d; }
    r -= I_WUP;
    { const int kb = r / 32, nb = r % 32; d.src = a.in[17] + (size_t)l * DFF * DM + (size_t)(64 * kb) * DM + 32 * nb; d.ldn = DM; d.dst = (bf16_t*)(a.ws + WS_WDN + l * SZ_WDN) + (size_t)(32 * nb) * DFF + 64 * kb; d.ldk = DFF; }
    return d;
}
__device__ __forceinline__ void tr_layer(LAS unsigned char* lds, const Args& a, int l, int wr, int nw, int lane, int wave) {
    LAS float* scr = (LAS float*)(lds + wave * 8448);
    const int NIT = ((l & 1) == 0 ? 16 * 72 + 16 * 32 : 16 * 16 + 8 * 32) + 16 * 176 + 44 * 32;
    for (int it = wr; it < NIT; it += 2 * nw) {
        const bool two = it + nw < NIT;
        const TrDesc d0 = tr_decode(a, l, it), d1 = tr_decode(a, l, two ? it + nw : it);
        f32x4 v0[8], v1[8];
        tr_load(d0.src, d0.ldn, lane, v0); tr_load(d1.src, d1.ldn, lane, v1);
        tr_finish(v0, d0.dst, d0.dst2, d0.ldk, scr, lane);
        if (two) tr_finish(v1, d1.dst, d1.dst2, d1.ldk, scr, lane);
    }
}
__device__ __forceinline__ void fold_layer(LAS unsigned char* lds, const Args& a, int o, int rk, int n, int tid) {
    { LAS float* tab = (LAS float*)(lds + LDS_COSTAB); for (int i = tid; i < 2048; i += NTHR) tab[i] = cospif((float)i * (1.0f / 1024.0f)); }
    __syncthreads();
    for (int it = rk; it < 64; it += n) fold_in_item(lds, a, o * 64 + it, tid);
    for (int it = rk; it < 64; it += n) fold_out_item(lds, a, o * 64 + (it + 64) % 64, tid);
    if (o == 0) {
        const LAS float* tab = (const LAS float*)(lds + LDS_COSTAB);
        const int gt = rk * NTHR + tid, NT = n * NTHR;
        bf16_t* FM = (bf16_t*)(a.ws + WS_FMAT);
        for (int idx = gt; idx < 2048 * 256; idx += NT) {
            const int k = idx >> 8, t0 = (idx & 255) * 8, ph0 = (k * t0) & 2047;
            float c = tab[ph0], sn = tab[(ph0 - 512) & 2047]; const float dc = tab[k], dsn = tab[(k - 512) & 2047];
            float vc[8], vs[8];
#pragma unroll
            for (int e = 0; e < 8; ++e) { vc[e] = c * (1.0f / 512.0f); vs[e] = sn * (-1.0f / 512.0f); const float c2 = c * dc - sn * dsn; sn = sn * dc + c * dsn; c = c2; }
            u32x4 w; w.x = cvt_pk_bf16(vc[0], vc[1]); w.y = cvt_pk_bf16(vc[2], vc[3]); w.z = cvt_pk_bf16(vc[4], vc[5]); w.w = cvt_pk_bf16(vc[6], vc[7]);
            *(u32x4*)(FM + (size_t)k * 4096 + t0) = w;
            w.x = cvt_pk_bf16(vs[0], vs[1]); w.y = cvt_pk_bf16(vs[2], vs[3]); w.z = cvt_pk_bf16(vs[4], vs[5]); w.w = cvt_pk_bf16(vs[6], vs[7]);
            *(u32x4*)(FM + (size_t)k * 4096 + 2048 + t0) = w;
        }
        bf16_t* FC = (bf16_t*)(a.ws + WS_FC); const float nc = 0.005524271728019903f;
        for (int idx = gt; idx < 256 * 64; idx += NT) {
            const int k = idx >> 6, ch = idx & 63, s = ch >> 5, t0 = (ch & 31) * 8; float v[8];
#pragma unroll
            for (int e = 0; e < 8; ++e) { const int ph = ((k * (t0 + e)) & 255) * 8; v[e] = s ? -tab[(ph - 512) & 2047] * nc : tab[ph] * nc; }
            u32x4 w; w.x = cvt_pk_bf16(v[0], v[1]); w.y = cvt_pk_bf16(v[2], v[3]); w.z = cvt_pk_bf16(v[4], v[5]); w.w = cvt_pk_bf16(v[6], v[7]);
            *(u32x4*)(FC + (size_t)k * 512 + ch * 8) = w;
        }
    }
    __syncthreads();
}
__device__ __forceinline__ void prologue_a(LAS unsigned char* lds, const Args& a, int tid, int lane, int wave, int G) {
    const int bx = blockIdx.x;
    for (int it = bx; it < 256; it += G) mod_item(lds, a, it, tid);
    tr_layer(lds, a, 0, bx * NWAVES + wave, G * NWAVES, lane, wave);
    { const int gt = bx * NTHR + tid, NT = G * NTHR; float* TC = (float*)(a.ws + WS_TAB); float* TS = TC + 1024;
      for (int idx = gt; idx < 1024; idx += NT) { const int pos = idx >> 4, j = idx & 15; const float inv = powf(10000.0f, -(float)j / 16.0f); const float ang = (float)pos * inv; TC[idx] = cosf(ang); TS[idx] = sinf(ang); } }
    __syncthreads();
}

__device__ __forceinline__ void ld_row_f32(const float* p, int lane, f32x4 (&v)[4]) {
#pragma unroll
    for (int j = 0; j < 4; ++j) v[j] = *(const f32x4*)(p + 4 * lane + 256 * j);
}
__device__ __forceinline__ float row_rs(const f32x4 (&v)[4]) {
    float s = 0.f;
#pragma unroll
    for (int j = 0; j < 4; ++j) s += (v[j][0] * v[j][0] + v[j][1] * v[j][1]) + (v[j][2] * v[j][2] + v[j][3] * v[j][3]);
    return __builtin_amdgcn_rsqf(wave_sum(s) * (1.0f / DM) + EPS);
}
__device__ __forceinline__ void norm_mod_store(const f32x4 (&x)[4], const float* gain, const float* sc, const float* sh, bf16_t* hrow, int lane) {
    const float rs = row_rs(x);
#pragma unroll
    for (int j = 0; j < 4; ++j) {
        const int c = 4 * lane + 256 * j;
        const f32x4 g = *(const f32x4*)(gain + c), s1 = *(const f32x4*)(sc + c), s0 = *(const f32x4*)(sh + c);
        const f32x4 h = (x[j] * rs * g) * (s1 + 1.0f) + s0;
        u32x2 w; w.x = cvt_pk_bf16(h[0], h[1]); w.y = cvt_pk_bf16(h[2], h[3]);
        *(u32x2*)(hrow + c) = w;
    }
}
typedef GAS const float* gcf;
struct RowRegs { f32x4 x[4], y[4], gt[4], sc[4], sh[4]; };
struct RowCtx { gcf xsX, xsC, modx, modc, slab; GAS const bf16_t* Y; int layer, which, ns, lane; bool do_norm; };
__device__ __forceinline__ void row_load(RowRegs& R, const RowCtx& c, int row) {
    const bool isx = row < MX; const int b = row >> 11, lane = c.lane;
    gcf xi = isx ? c.xsX + (size_t)row * DM : c.xsC + (size_t)(row - MX) * DM;
#pragma unroll
    for (int j = 0; j < 4; ++j) R.x[j] = *(const GAS f32x4*)(xi + 4 * lane + 256 * j);
    gcf mod = isx ? c.modx + (size_t)(c.layer * 8 + b) * 6144 : c.modc + (size_t)c.layer * 6144;
    gcf modn = (c.which == 2) ? mod + (isx ? 8 * 6144 : 6144) : mod;
    const int so = c.which == 1 ? 4096 : 1024, ho = c.which == 1 ? 3072 : 0;
    if (c.do_norm) {
#pragma unroll
        for (int j = 0; j < 4; ++j) { R.sc[j] = *(const GAS f32x4*)(modn + so + 4 * lane + 256 * j); R.sh[j] = *(const GAS f32x4*)(modn + ho + 4 * lane + 256 * j); }
    }
    if (c.which != 0) {
        gcf gate = mod + (c.which == 1 ? 2048 : 5120);
#pragma unroll
        for (int j = 0; j < 4; ++j) R.gt[j] = *(const GAS f32x4*)(gate + 4 * lane + 256 * j);
        if (isx) {
#pragma unroll
            for (int j = 0; j < 4; ++j) { const u32x2 w = *(const GAS u32x2*)(c.Y + (size_t)row * DM + 4 * lane + 256 * j); R.y[j] = (f32x4){bf_lo(w.x), bf_hi(w.x), bf_lo(w.y), bf_hi(w.y)}; }
        } else {
            gcf sl = c.slab + (size_t)(row - MX) * DM;
#pragma unroll
            for (int j = 0; j < 4; ++j) R.y[j] = *(const GAS f32x4*)(sl + 4 * lane + 256 * j);
            for (int k = 1; k < c.ns; ++k)
#pragma unroll
                for (int j = 0; j < 4; ++j) R.y[j] += *(const GAS f32x4*)(sl + (size_t)k * MC * DM + 4 * lane + 256 * j);
        }
    }
}
__device__ __forceinline__ void row_finish(RowRegs& R, const RowCtx& c, int row, const f32x4 (&gA)[4], const f32x4 (&gB)[4], GAS float* xo, GAS bf16_t* ho) {
    const int lane = c.lane;
    if (c.which != 0) {
        const float rsy = row_rs(R.y);
#pragma unroll
        for (int j = 0; j < 4; ++j) { R.x[j] = R.x[j] + R.gt[j] * (R.y[j] * rsy * gA[j]); *(GAS f32x4*)(xo + 4 * lane + 256 * j) = R.x[j]; }
    }
    if (c.do_norm) {
        const float rs = row_rs(R.x);
#pragma unroll
        for (int j = 0; j < 4; ++j) {
            const f32x4 h = (R.x[j] * rs * gB[j]) * (R.sc[j] + 1.0f) + R.sh[j];
            u32x2 w; w.x = cvt_pk_bf16(h[0], h[1]); w.y = cvt_pk_bf16(h[2], h[3]);
            *(GAS u32x2*)(ho + 4 * lane + 256 * j) = w;
        }
    }
}
__device__ __forceinline__ void row_phase(const Args& a, int layer, int which, int nrows, int lane, int gw, int NGW) {
    RowCtx c; c.layer = layer; c.which = which; c.lane = lane; c.do_norm = !(which == 2 && layer == DEPTH - 1);
    c.modx = (gcf)(a.ws + WS_MODX); c.modc = (gcf)(a.ws + WS_MODC); c.Y = (GAS const bf16_t*)(a.ws + WS_Y);
    c.slab = (gcf)(a.ws + (which == 1 ? WS_BIG : WS_MIX)); c.ns = which == 1 ? SL_OUT : SL_DN;
    GAS float* hctx = (GAS float*)(a.ws + WS_HCTX); GAS float* xoX = a.dry ? (GAS float*)(a.ws + WS_BIG) : (GAS float*)a.out; GAS bf16_t* HX = (GAS bf16_t*)(a.ws + WS_HX);
    const bool first = layer == 0 && which < 2;
    c.xsX = first ? (gcf)a.in[0] : (gcf)a.out; c.xsC = first ? (gcf)a.in[2] : (gcf)hctx;
    gcf gains = (gcf)a.in[6];
    f32x4 gA[4], gB[4];
    { gcf pa = gains + (layer * 4 + (which == 1 ? 1 : 3)) * DM; gcf pb = gains + ((which == 2 ? layer + 1 : layer) * 4 + (which == 1 ? 2 : 0)) * DM;
      if (!c.do_norm) pb = pa;
#pragma unroll
      for (int j = 0; j < 4; ++j) { gA[j] = *(const GAS f32x4*)(pa + 4 * lane + 256 * j); gB[j] = *(const GAS f32x4*)(pb + 4 * lane + 256 * j); } }
    const int nX = (MX + NGW - 1) / NGW, nC = nrows > MX ? (nrows - MX + NGW - 1) / NGW : 0;
    for (int i = 0; i < nX + nC; i += 2) {
        int rowA = i < nX ? gw * nX + i : MX + gw * nC + (i - nX); const int lim = i < nX ? MX : nrows;
        int rowB = i + 1 < nX ? gw * nX + i + 1 : MX + gw * nC + (i + 1 - nX); const int limB = i + 1 < nX ? MX : nrows;
        const bool okA = rowA < lim, two = okA && (i + 1 < nX + nC) && rowB < limB;
        if (!okA) { if (i + 1 < nX + nC && rowB < limB) { rowA = rowB; } else continue; }
        if (!two) rowB = rowA;
        RowRegs A, B;
        row_load(A, c, rowA); row_load(B, c, rowB);
        row_finish(A, c, rowA, gA, gB, rowA < MX ? xoX + (size_t)rowA * DM : hctx + (size_t)(rowA - MX) * DM, HX + (size_t)rowA * DM);
        if (two) row_finish(B, c, rowB, gA, gB, rowB < MX ? xoX + (size_t)rowB * DM : hctx + (size_t)(rowB - MX) * DM, HX + (size_t)rowB * DM);
    }
}

typedef short v4i16_t __attribute__((ext_vector_type(4)));
constexpr int AT_KP = 144, AT_VP = 192;
constexpr int AT_KB = 128 * AT_KP, AT_VB = 128 * AT_VP, AT_BUF = AT_KB + AT_VB, AT_STG = 2 * AT_BUF, AT_STGW = 32 * 144, AT_SCR = AT_STG + 8 * AT_STGW;
static_assert(AT_SCR + 8 * 256 <= RING_BYTES, "attention LDS map");
constexpr float AT_THR = 8.0f;
__device__ __forceinline__ int crow(int r, int hi) { return (r & 3) + 8 * (r >> 2) + 4 * hi; }

__device__ __forceinline__ void attn_unit(LAS unsigned char* lds, const bf16_t* U, bf16_t* MIXo, const float* sink8, int b, int hk, int qrow0, int qpos0, bool latent, int tid) {
    const int lane = tid & 63, r32 = lane & 31, hi = lane >> 5, wid = __builtin_amdgcn_readfirstlane(tid >> 6);
    const int hq = 4 * hk + (wid >> 1), rowoff = 32 * (wid & 1), qa = qpos0 + rowoff;
    const int ctxrow0 = MX + b * CTXL, nst = latent ? 5 : 2;
    bf16x8 qf[4];
#pragma unroll
    for (int d0 = 0; d0 < 4; ++d0) qf[d0] = *(const bf16x8*)(U + (size_t)(qrow0 + rowoff + r32) * ATT_IN + hq * 64 + 16 * d0 + 8 * hi);
    const float sink2 = sink8[hq] * LOG2E;
    float mref = sink2, lsum = hi == 0 ? 1.f : 0.f;
    f32x16 o0, o1, negm;
#pragma unroll
    for (int r = 0; r < 16; ++r) { o0[r] = 0.f; o1[r] = 0.f; negm[r] = -sink2; }
    volatile LAS float* scr = (volatile LAS float*)(lds + AT_SCR) + wid * 64;
    const int skey = tid >> 3, sch = tid & 7;
    u32x4 kr0, kr1, vr0, vr1;
#define AT_ROW(st, key) ((st) < 2 ? ctxrow0 + 128 * (st) + (key) : b * SEQ + min(max(qpos0 - 128 + 128 * ((st) - 2) + (key), 0), SEQ - 1))
#define AT_LOAD(st) do { const bf16_t* p0_ = U + (size_t)AT_ROW(st, skey) * ATT_IN + 512 + hk * 64 + 8 * sch; const bf16_t* p1_ = U + (size_t)AT_ROW(st, skey + 64) * ATT_IN + 512 + hk * 64 + 8 * sch; \
        kr0 = *(const u32x4*)p0_; vr0 = *(const u32x4*)(p0_ + 128); kr1 = *(const u32x4*)p1_; vr1 = *(const u32x4*)(p1_ + 128); } while (0)
#define AT_WRITE(bufi) do { LAS unsigned char* kb_ = lds + (bufi) * AT_BUF; LAS unsigned char* vb_ = kb_ + AT_KB; \
        *(LAS u32x4*)(kb_ + skey * AT_KP + sch * 16) = kr0; *(LAS u32x4*)(kb_ + (skey + 64) * AT_KP + sch * 16) = kr1; \
        *(LAS u32x4*)(vb_ + skey * AT_VP + sch * 16) = vr0; *(LAS u32x4*)(vb_ + (skey + 64) * AT_VP + sch * 16) = vr1; } while (0)
    AT_LOAD(0); AT_WRITE(0);
    __syncthreads();
    for (int st = 0; st < nst; ++st) {
        if (st + 1 < nst) AT_LOAD(st + 1);
        const LAS unsigned char* kbuf = lds + (st & 1) * AT_BUF; const LAS unsigned char* vbuf = kbuf + AT_KB;
        const bool win = st >= 2;
#pragma unroll
        for (int h = 0; h < 2; ++h) {
            const int kp = qpos0 - 128 + 128 * (st - 2) + 64 * h;
            if (win && (kp < 0 || kp >= SEQ || kp > qa + 159 || kp + 63 < qa - 128)) continue;
            const bool needmask = win && !(qa + 31 - kp <= 128 && kp + 63 - qa <= 128);
            const LAS unsigned char* kb = kbuf + (64 * h + r32) * AT_KP + 16 * hi;
            f32x16 p0 = negm, p1 = negm;
#pragma unroll
            for (int d0 = 0; d0 < 4; ++d0) {
                const bf16x8 k0 = *(const LAS bf16x8*)(kb + 32 * d0), k1 = *(const LAS bf16x8*)(kb + 32 * AT_KP + 32 * d0);
                p0 = __builtin_amdgcn_mfma_f32_32x32x16_bf16(k0, qf[d0], p0, 0, 0, 0); p1 = __builtin_amdgcn_mfma_f32_32x32x16_bf16(k1, qf[d0], p1, 0, 0, 0);
            }
            if (needmask) {
                const int qpos = qa + r32;
#pragma unroll
                for (int r = 0; r < 16; ++r) { const int kq = kp + crow(r, hi); int d0_ = qpos - kq; d0_ = d0_ < 0 ? -d0_ : d0_; int d1_ = qpos - (kq + 32); d1_ = d1_ < 0 ? -d1_ : d1_;
                    if (d0_ > 128) p0[r] = -INFINITY; if (d1_ > 128) p1[r] = -INFINITY; }
            }
            float mx = fmaxf(fmaxf(p0[0], p0[1]), p1[0]);
#pragma unroll
            for (int r = 2; r < 16; r += 2) mx = fmaxf(fmaxf(mx, p0[r]), p0[r + 1]);
#pragma unroll
            for (int r = 1; r < 15; r += 2) mx = fmaxf(fmaxf(mx, p1[r]), p1[r + 1]);
            mx = fmaxf(mx, p1[15]);
            mx = fmaxf(mx, __shfl_xor(mx, 32));
            if (__any(mx > AT_THR)) {
                const float dl = fmaxf(mx, 0.f), f = __builtin_amdgcn_exp2f(-dl);
                mref += dl; lsum *= f;
#pragma unroll
                for (int r = 0; r < 16; ++r) { p0[r] -= dl; p1[r] -= dl; negm[r] = -mref; }
                if (hi == 0) scr[r32] = f;
                LDS_WAIT();
#pragma unroll
                for (int r = 0; r < 16; ++r) { const float al = scr[crow(r, hi)]; o0[r] *= al; o1[r] *= al; }
                LDS_WAIT();
            }
            float rsum = 0.f;
#pragma unroll
            for (int r = 0; r < 16; ++r) { p0[r] = __builtin_amdgcn_exp2f(p0[r]); p1[r] = __builtin_amdgcn_exp2f(p1[r]); rsum += p0[r] + p1[r]; }
            lsum += rsum;
            bf16x8 pa[4];
#pragma unroll
            for (int s2 = 0; s2 < 2; ++s2) {
                u32x4 w0, w1;
                w0.x = cvt_pk_bf16(p0[8 * s2 + 0], p0[8 * s2 + 1]); w0.y = cvt_pk_bf16(p0[8 * s2 + 2], p0[8 * s2 + 3]); w0.z = cvt_pk_bf16(p0[8 * s2 + 4], p0[8 * s2 + 5]); w0.w = cvt_pk_bf16(p0[8 * s2 + 6], p0[8 * s2 + 7]);
                w1.x = cvt_pk_bf16(p1[8 * s2 + 0], p1[8 * s2 + 1]); w1.y = cvt_pk_bf16(p1[8 * s2 + 2], p1[8 * s2 + 3]); w1.z = cvt_pk_bf16(p1[8 * s2 + 4], p1[8 * s2 + 5]); w1.w = cvt_pk_bf16(p1[8 * s2 + 6], p1[8 * s2 + 7]);
                pa[s2] = __builtin_bit_cast(bf16x8, w0); pa[2 + s2] = __builtin_bit_cast(bf16x8, w1);
            }
            const LAS unsigned char* vb = vbuf + (64 * h + 4 * hi + ((lane & 15) >> 2)) * AT_VP + ((lane >> 4) & 1) * 32 + (lane & 3) * 8;
#pragma unroll
            for (int s = 0; s < 4; ++s) {
#pragma unroll
                for (int d = 0; d < 2; ++d) {
                    const v4i16_t lo = __builtin_amdgcn_ds_read_tr16_b64_v4i16((LAS v4i16_t*)(vb + 16 * s * AT_VP + 64 * d));
                    const v4i16_t hh = __builtin_amdgcn_ds_read_tr16_b64_v4i16((LAS v4i16_t*)(vb + (16 * s + 8) * AT_VP + 64 * d));
                    const bf16x8 vf = (bf16x8){lo[0], lo[1], lo[2], lo[3], hh[0], hh[1], hh[2], hh[3]};
                    if (d == 0) o0 = __builtin_amdgcn_mfma_f32_32x32x16_bf16(pa[s], vf, o0, 0, 0, 0); else o1 = __builtin_amdgcn_mfma_f32_32x32x16_bf16(pa[s], vf, o1, 0, 0, 0);
                }
            }
        }
        if (st + 1 < nst) AT_WRITE((st + 1) & 1);
        __syncthreads();
    }
    {
        const float lt = lsum + __shfl_xor(lsum, 32);
        if (hi == 0) scr[r32] = 1.0f / lt;
        LDS_WAIT();
        LAS unsigned short* stg = (LAS unsigned short*)(lds + AT_STG + wid * AT_STGW);
#pragma unroll
        for (int r = 0; r < 16; ++r) { const int q = crow(r, hi); const float il = scr[q];
            stg[q * 72 + r32] = (unsigned short)(cvt_pk_bf16(o0[r] * il, 0.f) & 0xffffu); stg[q * 72 + 32 + r32] = (unsigned short)(cvt_pk_bf16(o1[r] * il, 0.f) & 0xffffu); }
        LDS_WAIT();
#pragma unroll
        for (int i = 0; i < 4; ++i) { const int row = i * 8 + (lane >> 3), ch = lane & 7; const u32x4 v = *(const LAS u32x4*)((const LAS unsigned char*)stg + row * 144 + ch * 16);
            *(u32x4*)(MIXo + (size_t)(qrow0 + rowoff + row) * KMO + hq * 64 + 8 * ch) = v; }
        LDS_WAIT();
    }
#undef AT_ROW
#undef AT_LOAD
#undef AT_WRITE
}

__device__ __forceinline__ u32x4 ld16(const bf16_t* p) { return *(const u32x4*)p; }
__device__ __forceinline__ void unpack8(const u32x4& w, float (&f)[8]) { f[0] = bf_lo(w.x); f[1] = bf_hi(w.x); f[2] = bf_lo(w.y); f[3] = bf_hi(w.y); f[4] = bf_lo(w.z); f[5] = bf_hi(w.z); f[6] = bf_lo(w.w); f[7] = bf_hi(w.w); }

__device__ __forceinline__ void sconv_pass(const Args& a, int e, int nrows, int gt, int NT) {
    const bf16_t* U = (const bf16_t*)(a.ws + WS_BIG); bf16_t* MIXo = (bf16_t*)(a.ws + WS_MIX); const float* cw = a.in[9] + (size_t)e * 3 * 512;
    for (int idx = gt; idx < nrows * 64; idx += NT) {
        const int row = idx >> 6, ch = idx & 63;
        const int t = row < MX ? (row & (SEQ - 1)) : ((row - MX) & (CTXL - 1)), T = row < MX ? SEQ : CTXL;
        const bf16_t* up = U + (size_t)row * ATT_IN + 8 * ch;
        float bv[8], acc[8];
        unpack8(ld16(up + 768), bv);
#pragma unroll
        for (int q = 0; q < 8; ++q) acc[q] = 0.f;
#pragma unroll
        for (int j = 0; j < 3; ++j) {
            const int tt = t + j - 1;
            if (tt >= 0 && tt < T) {
                float cvv[8], zv[8];
                unpack8(ld16(up + (ptrdiff_t)(j - 1) * ATT_IN + 1280), cvv); unpack8(ld16(up + (ptrdiff_t)(j - 1) * ATT_IN + 1792), zv);
                const f32x4 w0 = *(const f32x4*)(cw + j * 512 + 8 * ch), w1 = *(const f32x4*)(cw + j * 512 + 8 * ch + 4);
#pragma unroll
                for (int q = 0; q < 4; ++q) { acc[q] += w0[q] * (cvv[q] * zv[q]); acc[4 + q] += w1[q] * (cvv[4 + q] * zv[4 + q]); }
            }
        }
        u32x4 w; w.x = cvt_pk_bf16(bv[0] * acc[0], bv[1] * acc[1]); w.y = cvt_pk_bf16(bv[2] * acc[2], bv[3] * acc[3]); w.z = cvt_pk_bf16(bv[4] * acc[4], bv[5] * acc[5]); w.w = cvt_pk_bf16(bv[6] * acc[6], bv[7] * acc[7]);
        *(u32x4*)(MIXo + (size_t)row * KMO + 512 + 8 * ch) = w;
    }
}
template <int HW> __device__ __forceinline__ void pool_item(const bf16_t* UP, bf16_t* MIXo, int row, int c8, int g) {
    const int t = row < MX ? (row & (SEQ - 1)) : ((row - MX) & (CTXL - 1)), T = row < MX ? SEQ : CTXL;
    const bf16_t* up = UP + (size_t)row * 512 + 128 * g + c8;
    u32x4 w[2 * HW];
#pragma unroll
    for (int j = 0; j < 2 * HW; ++j) { const int s = t - HW + j; const int sc = s < 0 ? 0 : (s >= T ? T - 1 : s); w[j] = ld16(up + (ptrdiff_t)(sc - t) * 512); }
    float acc[8], f[8];
#pragma unroll
    for (int q = 0; q < 8; ++q) acc[q] = 0.f;
    int cnt = 0;
#pragma unroll
    for (int j = 0; j < 2 * HW; ++j) { const int s = t - HW + j; const bool ok = s >= 0 && s < T; cnt += ok ? 1 : 0; unpack8(w[j], f);
#pragma unroll
        for (int q = 0; q < 8; ++q) acc[q] += ok ? f[q] : 0.f; }
    unpack8(w[HW], f);
    const float inv = 1.0f / (float)cnt;
#pragma unroll
    for (int q = 0; q < 8; ++q) acc[q] = acc[q] * inv - f[q];
    u32x4 o; o.x = cvt_pk_bf16(acc[0], acc[1]); o.y = cvt_pk_bf16(acc[2], acc[3]); o.z = cvt_pk_bf16(acc[4], acc[5]); o.w = cvt_pk_bf16(acc[6], acc[7]);
    *(u32x4*)(MIXo + (size_t)row * KMO + 128 * g + c8) = o;
}
__device__ __forceinline__ void pool_pass(const Args& a, int nrows, int lane, int gw, int NGW) {
    const bf16_t* UP = (const bf16_t*)(a.ws + WS_UPOOL); bf16_t* MIXo = (bf16_t*)(a.ws + WS_MIX);
    for (int wi = gw; wi < nrows; wi += NGW) {
        const int g = wi & 3, row = 4 * (wi >> 2) + (lane >> 4), c8 = 8 * (lane & 15);
        if (g == 0) pool_item<1>(UP, MIXo, row, c8, 0); else if (g == 1) pool_item<2>(UP, MIXo, row, c8, 1); else if (g == 2) pool_item<4>(UP, MIXo, row, c8, 2); else pool_item<8>(UP, MIXo, row, c8, 3);
    }
}
__device__ __forceinline__ void dft_combine(const Args& a, int gt, int NT, int lane, int gw, int NGW) {
    const float* SL = (const float*)(a.ws + WS_DSLAB); bf16_t* MIXo = (bf16_t*)(a.ws + WS_MIX); const size_t SS = (size_t)1024 * 4096;
    for (int idx0 = gt; idx0 < 1024 * 512; idx0 += 2 * NT) {
        f32x4 v[2][8]; int kk[2], bb[2], cc8[2]; bool okk[2];
#pragma unroll
        for (int u = 0; u < 2; ++u) {
            const int idx = idx0 + u * NT; okk[u] = idx < 1024 * 512; const int id = okk[u] ? idx : idx0;
            kk[u] = id >> 9; const int cc = id & 511; bb[u] = cc >> 6; cc8[u] = (cc & 63) * 8;
            const float* p = SL + (size_t)kk[u] * 4096 + bb[u] * 512 + cc8[u];
#pragma unroll
            for (int q = 0; q < 4; ++q) { v[u][2 * q] = *(const f32x4*)(p + q * SS); v[u][2 * q + 1] = *(const f32x4*)(p + q * SS + 4); }
        }
#pragma unroll
        for (int u = 0; u < 2; ++u) {
            if (!okk[u]) continue;
            const f32x4 P0 = v[u][0] + v[u][2], P1 = v[u][1] + v[u][3], Q0 = v[u][4] + v[u][6], Q1 = v[u][5] + v[u][7];
            *(u32x4*)(MIXo + (size_t)(bb[u] * SEQ + kk[u]) * KMO + 512 + cc8[u]) = gm::pack8(P0 + Q0, P1 + Q1);
            if (kk[u] > 0) *(u32x4*)(MIXo + (size_t)(bb[u] * SEQ + SEQ - kk[u]) * KMO + 512 + cc8[u]) = gm::pack8(P0 - Q0, P1 - Q1);
        }
    }
    const bf16_t* VT = (const bf16_t*)(a.ws + WS_VT);
    for (int r = gw; r < NBATCH * 512; r += NGW) {
        const bf16_t* v = VT + (size_t)r * 2 * SEQ + 8 * lane; float s = 0.f;
#pragma unroll
        for (int j = 0; j < 4; ++j) { float f[8]; unpack8(ld16(v + 512 * j), f); s += (f[0] - f[1]) + (f[2] - f[3]) + (f[4] - f[5]) + (f[6] - f[7]); }
        s = wave_sum(s) * (1.0f / 512.0f);
        if (lane == 0) MIXo[(size_t)((r >> 9) * SEQ + 1024) * KMO + 512 + (r & 511)] = (bf16_t)(cvt_pk_bf16(s, 0.f) & 0xffffu);
    }
}
__device__ __forceinline__ void ffn_fixup(const Args& a, int layer, int nrows, int gt, int NT) {
    const float* SIDE = (const float*)(a.ws + WS_SIDE); bf16_t* ACT = (bf16_t*)(a.ws + WS_BIG); const float* cw = a.in[16] + (size_t)layer * 3 * DFF;
    const int nblk = nrows >> 6;
    for (int idx = gt; idx < nblk * 2 * (DFF / 4); idx += NT) {
        const int c4 = idx % (DFF / 4), bw = idx / (DFF / 4), blk = bw >> 1, which = bw & 1, col = 4 * c4;
        const int row = blk * 64 + (which ? 63 : 0);
        const int sb = row < MX ? (blk & 31) : ((blk - MX / 64) & 3), nsb = row < MX ? 32 : 4;
        const float* sp = SIDE + ((size_t)(blk * 2 + which) * 3) * DFF + col;
        f32x4 cv = *(const f32x4*)sp; const f32x4 vv = *(const f32x4*)(sp + 2 * DFF);
        if (which == 0 && sb > 0) { const f32x4 gl = *(const f32x4*)(SIDE + ((size_t)((blk - 1) * 2 + 1) * 3 + 1) * DFF + col); cv += *(const f32x4*)(cw + col) * gl; }
        if (which == 1 && sb < nsb - 1) { const f32x4 gf = *(const f32x4*)(SIDE + ((size_t)((blk + 1) * 2 + 0) * 3 + 1) * DFF + col); cv += *(const f32x4*)(cw + 2 * DFF + col) * gf; }
        u32x2 w; w.x = cvt_pk_bf16(silu_f(cv[0]) * vv[0], silu_f(cv[1]) * vv[1]); w.y = cvt_pk_bf16(silu_f(cv[2]) * vv[2], silu_f(cv[3]) * vv[3]);
        *(u32x2*)(ACT + (size_t)row * DFF + col) = w;
    }
}

constexpr int STEPS_PER_LAYER = 13, N_STEPS = 2 + STEPS_PER_LAYER * DEPTH;
enum { ST_NOP = 0, ST_PRO, ST_ROW, ST_GEMM, ST_ATT, ST_POOL, ST_FIX };

__global__ void __launch_bounds__(NTHR, 2) dit_fwd(Args args) {
    extern __shared__ __attribute__((aligned(16))) unsigned char lds_raw[];
    LAS unsigned char* lds = (LAS unsigned char*)lds_raw;
    for (int u = threadIdx.x; u < (LDS_BYTES - LDSCTL_OFF) / 4; u += NTHR) ((LAS unsigned*)(lds + LDSCTL_OFF))[u] = 0u;
    __syncthreads();
    XcdBarrier bar; bar.bar = (unsigned*)(args.ws + WS_CTL) + CW_BAR; bar.x = 0; bar.st = nullptr;
    if (!MK_PER_PHASE) bar = xcd_barrier_post((unsigned*)(args.ws + WS_CTL) + CW_BAR, (volatile LAS unsigned*)(lds + MISC_OFF) + 8);

    for (int st = args.ph_lo; st < args.ph_hi; ++st) {
        int tid = threadIdx.x; asm volatile("" : "+v"(tid));
        int G = gridDim.x, bx = blockIdx.x; asm volatile("" : "+s"(G), "+s"(bx));
        unsigned char* ws = args.ws; asm volatile("" : "+s"(ws));
        const int lane = tid & 63, wave = __builtin_amdgcn_readfirstlane(tid >> 6);
        bf16_t* HX = (bf16_t*)(ws + WS_HX); bf16_t* Yb = (bf16_t*)(ws + WS_Y); bf16_t* MIXb = (bf16_t*)(ws + WS_MIX); bf16_t* BIG = (bf16_t*)(ws + WS_BIG);
        int kind = ST_NOP, l = 0, sub = -1, rw = 0, coff = 0; bool seam = false;
        if (st == 0) { kind = ST_PRO; seam = true; }
        else if (st == 1) { kind = ST_ROW; rw = 0; seam = true; }
        else if (st >= N_STEPS) { seam = true; }
        else { l = (st - 2) / STEPS_PER_LAYER; sub = (st - 2) % STEPS_PER_LAYER; }
        const bool even = (l & 1) == 0; const int eo = l >> 1;
        const bool ctx_live = l < 2;
        const int nrows = ctx_live ? MT : MX, nMt = nrows / 256;
        gm::Call C{}; C.G = G;
        if (sub == 0) {
            kind = ST_GEMM; C.K = DM; C.lda = DM; C.ldb = DM;
            if (even) C.j0 = gm::Job{HX, (const bf16_t*)(ws + WS_WIN + eo * SZ_WIN), BIG, (const float*)(ws + WS_TAB), nullptr, nMt, ATT_IN / 256, gm::K_ROPE, ATT_IN, 0, 0, 0, 0, 1, nullptr};
            else C.j0 = gm::Job{(const bf16_t*)(ws + WS_WMI + eo * SZ_WMI) + (size_t)512 * DM, HX, ws + WS_VT, nullptr, ws + WS_VTC, 4, nMt, gm::K_VT, 0, 0, 0, 0, 0, 1, nullptr};
        } else if (sub == 1) {
            seam = true; C.K = DM; C.lda = DM; C.ldb = DM;
            if (!even) { kind = ST_GEMM; coff = (4 * nMt) % G; C.j0 = gm::Job{HX, (const bf16_t*)(ws + WS_WMI + eo * SZ_WMI), ws + WS_UPOOL, nullptr, nullptr, nMt, 2, gm::K_PLAIN, 512, 0, 0, 0, 0, 1, nullptr}; }
            else if (l == 2) { kind = ST_GEMM; coff = (64 * 9) % G;
                C.j0 = gm::Job{HX + (size_t)MX * DM, (const bf16_t*)(ws + WS_WIN + eo * SZ_WIN) + (size_t)512 * DM, BIG, (const float*)(ws + WS_TAB), nullptr, MC / 256, 1, gm::K_ROPE, ATT_IN, MX, 512, 0, 0, 1, nullptr}; }
        } else if (sub == 2) {
            if (even) { kind = ST_ATT; seam = true; }
            else { kind = ST_GEMM; C.K = SEQ; C.lda = 2 * SEQ; C.ldb = 2 * SEQ;
                C.j0 = gm::Job{(const bf16_t*)(ws + WS_FMAT), (const bf16_t*)(ws + WS_VT), nullptr, nullptr, nullptr, 0, 16, gm::K_PLAIN, 0, 0, 0, 0, 4, 2, (float*)(ws + WS_DSLAB)}; }
        } else if (sub == 3) {
            if (!even) { kind = ST_GEMM; coff = 128 % G; C.K = SEQ; C.lda = 2 * SEQ; C.ldb = 2 * SEQ;
                C.j0 = gm::Job{(const bf16_t*)(ws + WS_FMAT) + SEQ, (const bf16_t*)(ws + WS_VT) + SEQ, nullptr, nullptr, nullptr, 0, 16, gm::K_PLAIN, 0, 0, 0, 0, 4, 2, (float*)(ws + WS_DSLAB) + (size_t)2 * 1024 * 4096}; }
        } else if (sub == 4) {
            if (!even && ctx_live) { kind = ST_GEMM; C.K = 2 * CTXL; C.lda = 2 * CTXL; C.ldb = 2 * CTXL;
                C.j0 = gm::Job{(const bf16_t*)(ws + WS_FC), (const bf16_t*)(ws + WS_VTC), MIXb, nullptr, nullptr, 1, 16, gm::K_DFT, KMO, MX, 512, 1, 0, 1, nullptr}; }
        } else if (sub == 5) {
            if (!even) seam = true;
        } else if (sub == 6) {
            if (!even) { kind = ST_POOL; seam = true; }
        } else if (sub == 7) {
            kind = ST_GEMM; seam = true; C.lda = KMO;
            if (even) { C.K = DM; C.ldb = DM; C.j0 = gm::Job{MIXb, (const bf16_t*)(ws + WS_WOUT + eo * SZ_WOUT), Yb, nullptr, nullptr, MX / 256, 4, gm::K_PLAIN, DM, 0, 0, 0, nMt - MX / 256, SL_OUT, (float*)(ws + WS_BIG)}; }
            else { C.K = WMOLD; C.ldb = WMOLD; C.j0 = gm::Job{MIXb, (const bf16_t*)(ws + WS_WMO + eo * SZ_WMO), Yb, nullptr, nullptr, MX / 256, 4, gm::K_PLAIN, DM, 0, 0, 0, nMt - MX / 256, SL_OUT, (float*)(ws + WS_BIG)}; }
        } else if (sub == 8) { kind = ST_ROW; rw = 1; seam = true; }
        else if (sub == 9) {
            kind = ST_GEMM; seam = true; C.K = DM; C.lda = DM; C.ldb = DM;
            C.j0 = gm::Job{HX, (const bf16_t*)(ws + WS_WUP + l * SZ_WUP), BIG, args.in[16] + (size_t)l * 3 * DFF, ws + WS_SIDE, nMt, NUP / 256, gm::K_FFN, DFF, 0, 0, 0, 0, 1, nullptr};
        } else if (sub == 10) { kind = ST_FIX; seam = true; }
        else if (sub == 11) {
            kind = ST_GEMM; seam = true; C.K = DFF; C.lda = DFF; C.ldb = DFF;
            C.j0 = gm::Job{BIG, (const bf16_t*)(ws + WS_WDN + l * SZ_WDN), Yb, nullptr, nullptr, MX / 256, 4, gm::K_PLAIN, DM, 0, 0, 0, nMt - MX / 256, SL_DN, (float*)(ws + WS_MIX)};
        } else if (sub == 12) { kind = ST_ROW; rw = 2; seam = true; }
        C.c = bx >= coff ? bx - coff : bx - coff + G;

        if (kind == ST_GEMM) {
            gm::gemm_phase(lds, C, tid);
            const bool hostA = (sub == 0 && even && l + 1 < DEPTH), hostB = (sub == 9 && l + 1 < DEPTH);
            if (hostA || hostB) {
                const int total = C.j0.nM * C.j0.nN, rem = total % G;
                const int rk = rem ? C.c - rem : C.c, n = rem ? G - rem : G;
                if (rk >= 0) { if (hostA) fold_layer(lds, args, l >> 1, rk, n, tid); else tr_layer(lds, args, l + 1, rk * NWAVES + wave, n * NWAVES, lane, wave); __syncthreads(); }
            }
        }
        else if (kind == ST_PRO) prologue_a(lds, args, tid, lane, wave, G);
        else if (kind == ST_ROW) row_phase(args, l, rw, rw == 0 ? MT : nrows, lane, bx * NWAVES + wave, G * NWAVES);
        else if (kind == ST_ATT) {
            const float* sink = args.in[8] + eo * 8;
            for (int u = bx; u < 512 + (l == 0 ? 64 : 0); u += G) {
                if (u < 512) { const int bh = u >> 5, i = u & 31, b = bh >> 1, hk = bh & 1; attn_unit(lds, BIG, MIXb, sink, b, hk, b * SEQ + 64 * i, 64 * i, true, tid); }
                else { const int v = u - 512, bh = v >> 2, i = v & 3, b = bh >> 1, hk = bh & 1; attn_unit(lds, BIG, MIXb, sink, b, hk, MX + b * CTXL + 64 * i, 0, false, tid); }
            }
            sconv_pass(args, eo, nrows, bx * NTHR + tid, G * NTHR);
        }
        else if (kind == ST_POOL) { pool_pass(args, nrows, lane, bx * NWAVES + wave, G * NWAVES); dft_combine(args, bx * NTHR + tid, G * NTHR, lane, bx * NWAVES + wave, G * NWAVES); }
        else if (kind == ST_FIX) ffn_fixup(args, l, nrows, bx * NTHR + tid, G * NTHR);
        if (!MK_PER_PHASE && seam && st + 1 < args.ph_hi) xcd_barrier(bar);
    }
}

extern "C" void kernel_launch(void* const* d_in, const int* in_sizes, int n_in, void* d_out, int out_size, void* d_ws, size_t ws_size, hipStream_t stream) {
    static int grid = 0;
    if (grid == 0) {
        if (n_in != 18 || out_size != MX * DM || ws_size < WS_END) { fprintf(stderr, "kernel_launch: unexpected shapes (n_in %d, out %d, ws %zu)\n", n_in, out_size, ws_size); grid = -1; return; }
        int dev = 0, cus = 0;
        if (hipGetDevice(&dev) != hipSuccess || hipDeviceGetAttribute(&cus, hipDeviceAttributeMultiprocessorCount, dev) != hipSuccess) { grid = -1; return; }
        if (hipFuncSetAttribute((const void*)dit_fwd, hipFuncAttributeMaxDynamicSharedMemorySize, LDS_BYTES) != hipSuccess) { grid = -1; return; }
        (void)hipGetLastError();
        grid = cus;
    }
    if (grid < 0) return;
    if (hipMemsetAsync((char*)d_ws + WS_CTL, 0, CTL_ZERO_BYTES, stream) != hipSuccess) return;
    Args a{};
    for (int i = 0; i < 18; ++i) a.in[i] = (const float*)d_in[i];
    a.out = (float*)d_out; a.ws = (unsigned char*)d_ws;
#if MK_PER_PHASE
    for (int p = 0; p < N_STEPS; ++p) { a.ph_lo = p; a.ph_hi = p + 1; hipLaunchKernelGGL(dit_fwd, dim3(grid), dim3(NTHR), LDS_BYTES, stream, a); }
#else
    a.ph_lo = 0; a.ph_hi = N_STEPS;
    hipLaunchKernelGGL(dit_fwd, dim3(grid), dim3(NTHR), LDS_BYTES, stream, a);
#if PROBE_CLASS
    for (int r = 0; r < PROBE_REPS; ++r)
        for (int l = 0; l < DEPTH; ++l) {
            const int base = 2 + STEPS_PER_LAYER * l; const bool ev = (l & 1) == 0;
            int lo = -1, hi = -1;
            switch (PROBE_CLASS) {
                case 1: lo = base + 9; hi = lo + 1; break;
                case 2: lo = base + 11; hi = lo + 1; break;
                case 3: lo = base + 0; hi = base + 2; break;
                case 4: lo = base + 7; hi = lo + 1; break;
                case 5: if (ev) { lo = base + 2; hi = lo + 1; } break;
                case 6: if (!ev) { lo = base + 2; hi = base + 5; } break;
                case 14: if (!ev) { lo = base + 6; hi = base + 7; } break;
                case 7: if (l == 0) { lo = 0; hi = 1; } break;
                case 8: lo = 1; hi = 2; break;
                case 9: lo = base + 10; hi = lo + 1; break;
                case 10: lo = 2 + 3; hi = lo + 1; break;
                case 11: lo = base + 8; hi = lo + 1; a.dry = 1; break;
                case 12: lo = base + 12; hi = lo + 1; a.dry = 1; break;
                case 13: lo = N_STEPS; hi = N_STEPS + 9; break;
            }
            if (lo >= 0) { a.ph_lo = lo; a.ph_hi = hi; hipLaunchKernelGGL(dit_fwd, dim3(grid), dim3(NTHR), LDS_BYTES, stream, a); }
        }
#endif
#endif
}
```

```cpp
#include <hip/hip_runtime.h>
#include <cstdio>
#include <cstdint>

#ifndef MK_PER_PHASE
#define MK_PER_PHASE 0
#endif

#ifndef PROBE_CLASS
#define PROBE_CLASS 0
#endif
#define PROBE_REPS 3
#define GAS __attribute__((address_space(1)))
#define LAS __attribute__((address_space(3)))
typedef unsigned short bf16_t;
typedef short bf16x8 __attribute__((ext_vector_type(8)));
typedef float f32x4 __attribute__((ext_vector_type(4)));
typedef float f32x16 __attribute__((ext_vector_type(16)));
typedef unsigned u32x4 __attribute__((ext_vector_type(4)));
typedef unsigned u32x2 __attribute__((ext_vector_type(2)));
typedef GAS unsigned gu32;
#define RLX_AGENT __ATOMIC_RELAXED, __HIP_MEMORY_SCOPE_AGENT
#define LDS_WAIT() asm volatile("s_waitcnt lgkmcnt(0)" ::: "memory")
#define VM_WAIT() asm volatile("s_waitcnt vmcnt(0)" ::: "memory")

constexpr int DM = 1024, NBATCH = 8, SEQ = 2048, CTXL = 256, DEPTH = 4;
constexpr int MX = NBATCH * SEQ, MC = NBATCH * CTXL, MT = MX + MC;
constexpr int ATT_IN = 2304, DFF = 2816, NUP = 2 * DFF, KMO = 1536  , WMOLD = 1024  ;
constexpr float EPS = 1e-6f;
constexpr float QSCALE = 0.125f * 1.4426950408889634f;
constexpr float LOG2E = 1.4426950408889634f;
constexpr int NWAVES = 8, NTHR = 512;

constexpr size_t MiB = 1u << 20;
constexpr size_t WS_CTL = 0, CTL_ZERO_BYTES = 1 * MiB;
constexpr size_t WS_MODX = 1 * MiB, WS_MODC = WS_MODX + (size_t)4 * 8 * 6144 * 4;
constexpr size_t WS_TAB = 2 * MiB;
constexpr size_t WS_WIN = 4 * MiB, SZ_WIN = (size_t)ATT_IN * DM * 2;
constexpr size_t WS_WOUT = 13 * MiB, SZ_WOUT = (size_t)DM * DM * 2;
constexpr size_t WS_WMI = 17 * MiB, SZ_WMI = (size_t)1536 * DM * 2;
constexpr size_t WS_WMO = 23 * MiB, SZ_WMO = (size_t)DM * WMOLD * 2;
constexpr size_t WS_WUP = 29 * MiB, SZ_WUP = (size_t)NUP * DM * 2;
constexpr size_t WS_WDN = 73 * MiB, SZ_WDN = (size_t)DM * DFF * 2;
constexpr size_t WS_FMAT = 96 * MiB;
constexpr size_t WS_FC = 112 * MiB;
constexpr size_t WS_HCTX = 113 * MiB;
constexpr size_t WS_HX = 122 * MiB;
constexpr size_t WS_DSLAB = WS_HX;
constexpr size_t WS_Y = 158 * MiB;
constexpr size_t WS_BIG = 194 * MiB;
constexpr size_t WS_UPOOL = WS_BIG, WS_VT = WS_BIG + 20 * MiB, WS_VTC = WS_BIG + 52 * MiB;
constexpr size_t WS_MIX = 293 * MiB;
constexpr size_t WS_SIDE = 348 * MiB;
constexpr size_t WS_END = 368 * MiB;
constexpr int CW_BAR = 4096;
constexpr int SL_OUT = 4, SL_DN = 6;

constexpr int RING_BYTES = 131072, LDSCTL_OFF = RING_BYTES, MISC_OFF = LDSCTL_OFF + 320, LDS_BYTES = 147456;
constexpr int LDS_COSTAB = 122880;

__device__ __forceinline__ unsigned cvt_pk_bf16(float lo, float hi) { unsigned r; asm("v_cvt_pk_bf16_f32 %0, %1, %2" : "=v"(r) : "v"(lo), "v"(hi)); return r; }
__device__ __forceinline__ float bf_lo(unsigned w) { return __uint_as_float(w << 16); }
__device__ __forceinline__ float bf_hi(unsigned w) { return __uint_as_float(w & 0xffff0000u); }
__device__ __forceinline__ float wave_sum(float v) {
#pragma unroll
    for (int o = 1; o < 64; o <<= 1) v += __shfl_xor(v, o);
    return v;
}
__device__ __forceinline__ float silu_f(float x) { return x * __builtin_amdgcn_rcpf(1.0f + __builtin_amdgcn_exp2f(-x * LOG2E)); }

#define XB_TMO      128
#define XB_XCNT(j)  (256  + 64 * (j))
#define XB_XSUB(j)  (1280 + 64 * (j))
#define XB_XGEN(j)  (2304 + 64 * (j))
#define XB_TOP      3328
#define XB_TOPGEN   3392
#define XCD_BAR_WORDS 3456
#define XB_SPIN_CAP (1u << 18)
__device__ __forceinline__ unsigned xb_ld(unsigned* p)              { return __hip_atomic_load(p, __ATOMIC_RELAXED, __HIP_MEMORY_SCOPE_AGENT); }
__device__ __forceinline__ unsigned xb_add(unsigned* p, unsigned v) { return __hip_atomic_fetch_add(p, v, __ATOMIC_RELAXED, __HIP_MEMORY_SCOPE_AGENT); }
__device__ __forceinline__ unsigned xb_xcc_id() { return (unsigned)__builtin_amdgcn_s_getreg((3 << 11) | 20) & 0xFu; }
#define XB_SPIN(cond, bar) do { unsigned _sp = 0; while (cond) { __builtin_amdgcn_s_sleep(1); \
    if ((++_sp & 255u) == 0u) { if (xb_ld(&(bar)[XB_TMO])) break; if (_sp > XB_SPIN_CAP) { atomicAdd(&(bar)[XB_TMO], 1u); break; } } } } while (0)
struct XcdBarrier { unsigned* bar; unsigned x; volatile LAS unsigned* st; };
__device__ __forceinline__ XcdBarrier xcd_barrier_post(unsigned* bar, volatile LAS unsigned* st) {
    XcdBarrier b; b.bar = bar; b.x = xb_xcc_id(); b.st = st;
    if (threadIdx.x == 0) (void)xb_add(&bar[XB_XCNT(b.x)], 1u);
    return b;
}
__device__ __forceinline__ void xcd_barrier_complete(unsigned* bar, unsigned x, unsigned& nloc, unsigned& nx) {
    const unsigned G = gridDim.x * gridDim.y * gridDim.z;
    unsigned sum, cnt, mine, sp = 0u;
    for (;;) {
        sum = 0u; cnt = 0u; mine = 0u;
#pragma unroll
        for (unsigned j = 0; j < 16; ++j) { const unsigned c = xb_ld(&bar[XB_XCNT(j)]); sum += c; cnt += (c > 0u) ? 1u : 0u; mine = (j == x) ? c : mine; }
        if (sum == G) break;
        __builtin_amdgcn_s_sleep(1);
        if ((++sp & 255u) == 0u) { if (xb_ld(&bar[XB_TMO])) break; if (sp > XB_SPIN_CAP) { atomicAdd(&bar[XB_TMO], 1u); break; } }
    }
    nloc = mine > 0u ? mine : 1u; nx = cnt > 0u ? cnt : 1u;
}
__device__ __forceinline__ void xcd_barrier(const XcdBarrier& b) {
    asm volatile("s_waitcnt vmcnt(0)" ::: "memory");
    __syncthreads();
    if (threadIdx.x == 0) {
        unsigned* bar = b.bar; asm volatile("" : "+s"(bar));
        __builtin_amdgcn_s_waitcnt(0);
        unsigned nloc = b.st[0], nx = b.st[1];
        if (nloc == 0u) { xcd_barrier_complete(bar, b.x, nloc, nx); b.st[0] = nloc; b.st[1] = nx; }
        const unsigned old = xb_add(&bar[XB_XSUB(b.x)], 1u);
        const unsigned gen = old / nloc;
        if (old + 1u == (gen + 1u) * nloc) {
            __builtin_amdgcn_fence(__ATOMIC_RELEASE, "agent");
            asm volatile("s_waitcnt vmcnt(0)" ::: "memory");
            const unsigned og = xb_add(&bar[XB_TOP], 1u);
            const unsigned tg = og / nx;
            if (og + 1u == (tg + 1u) * nx) xb_add(&bar[XB_TOPGEN], 1u);
            else XB_SPIN(xb_ld(&bar[XB_TOPGEN]) == tg, bar);
            __builtin_amdgcn_fence(__ATOMIC_ACQUIRE, "agent");
            xb_add(&bar[XB_XGEN(b.x)], 1u);
            asm volatile("s_waitcnt vmcnt(0)" ::: "memory");
        } else {
            XB_SPIN(xb_ld(&bar[XB_XGEN(b.x)]) == gen, bar);
            __builtin_amdgcn_fence(__ATOMIC_ACQUIRE, "agent");
            asm volatile("s_waitcnt vmcnt(0)" ::: "memory");
        }
    }
    __syncthreads();
}

namespace gm {
constexpr int BM = 256, BK = 64, HALF = 128, HTB = HALF * BK * 2, NXCD = 8, WGM = 8;
__device__ __forceinline__ int lds_byte(int r, int c) { const int st = (r >> 4) * 2 + (c >> 5), rr = r & 15, cc = c & 31, ob = rr * 64 + cc * 2; return st * 1024 + (ob ^ (((ob >> 9) & 1) << 5)); }
__device__ __forceinline__ void stage_rc(int b, int& R, int& C) { const int st = b / 1024, sb = b % 1024, swz = sb ^ (((sb >> 9) & 1) << 5); R = (st >> 1) * 16 + swz / 64; C = (st & 1) * 32 + (swz % 64) / 2; }
__device__ __forceinline__ int perm32(int rho) { const int n = rho >> 4, i = rho & 15; return 8 * (i >> 2) + 4 * n + (i & 3); }

enum { K_PLAIN = 0, K_DFT = 1, K_ROPE = 2, K_VT = 3, K_FFN = 4 };
struct Job { const bf16_t* A; const bf16_t* B; void* out; const float* aux; void* out2; int nM, nN, kind, ldc, row0, col0, p0; int cM, S; float* slab; };
struct Call { int K, lda, ldb, G, c; Job j0; };
struct Unit { int pm, pn, kp0, np, slice; };

__device__ __forceinline__ void next_unit(const Call& C, int i, int& pm, int& pn, int& kp0, int& np, int& slice) {
    const long L = (long)i * C.G + C.c;
    const int nM = C.j0.nM, nN = C.j0.nN, nwg = nM * nN, P = C.K / (2 * BK);
    const int S = C.j0.S, nsl = C.j0.cM * nN * S;
    pm = -1; pn = 0; kp0 = 0; np = P; slice = -1;
    if (L < nwg) {
        int wgid = (int)L; { const int q = nwg / NXCD, r = nwg % NXCD, xcd = wgid % NXCD, off = wgid / NXCD; wgid = (xcd < r ? xcd * (q + 1) : r * (q + 1) + (xcd - r) * q) + off; }
        const int nig = WGM * nN, gid = wgid / nig, fm = gid * WGM, gsz = (nM - fm) < WGM ? (nM - fm) : WGM;
        pm = fm + ((wgid % nig) % gsz); pn = (wgid % nig) / gsz;
    } else if (L < (long)nwg + nsl) {
        const int Ls = (int)(L - nwg);
        const int tile = Ls / S, sl = Ls - tile * S, base = P / S, rem = P - base * S;
        pm = nM + tile / nN; pn = tile % nN; slice = sl; np = base + (sl < rem ? 1 : 0); kp0 = sl * base + (sl < rem ? sl : rem);
    }
}

__device__ __forceinline__ u32x4 pack8(const f32x4& a, const f32x4& b) { u32x4 w; w.x = cvt_pk_bf16(a[0], a[1]); w.y = cvt_pk_bf16(a[2], a[3]); w.z = cvt_pk_bf16(b[0], b[1]); w.w = cvt_pk_bf16(b[2], b[3]); return w; }

__device__ __forceinline__ void epi_plain(const f32x4 (&acc)[2][2][4][2], const Job& J, int rowt, int colb, int wr, int wc, int fr, int fq) {
    bf16_t* O = (bf16_t*)J.out;
#pragma unroll
    for (int ai = 0; ai < 2; ++ai)
#pragma unroll
        for (int m = 0; m < 4; ++m) {
            bf16_t* rowp = O + (size_t)(rowt + ai * HALF + wr * 64 + m * 16 + fr) * J.ldc + colb + wc * 32 + 8 * fq;
#pragma unroll
            for (int bj = 0; bj < 2; ++bj) *(u32x4*)(rowp + bj * HALF) = pack8(acc[ai][bj][m][0], acc[ai][bj][m][1]);
        }
}
__device__ __forceinline__ void epi_rope(const f32x4 (&acc)[2][2][4][2], const Job& J, int rowt, int colb, int wr, int wc, int fr, int fq) {
    bf16_t* O = (bf16_t*)J.out; const float* TC = J.aux; const float* TS = J.aux + 1024;
    const bool anyrope = (rowt < MX) && (colb < 640); const int half = wc & 1, j0 = 8 * (fq & 1); const float sgn = fq < 2 ? -1.f : 1.f;
#pragma unroll
    for (int ai = 0; ai < 2; ++ai)
#pragma unroll
        for (int m = 0; m < 4; ++m) {
            const int grow = rowt + ai * HALF + wr * 64 + m * 16 + fr;
            f32x4 c0 = {1.f, 1.f, 1.f, 1.f}, c1 = c0, s0 = {0.f, 0.f, 0.f, 0.f}, s1 = s0;
            if (anyrope) {
                const int t = grow & (SEQ - 1), pos = half ? (t & 63) : (t >> 6);
                c0 = *(const f32x4*)(TC + pos * 16 + j0); c1 = *(const f32x4*)(TC + pos * 16 + j0 + 4);
                s0 = *(const f32x4*)(TS + pos * 16 + j0); s1 = *(const f32x4*)(TS + pos * 16 + j0 + 4);
            }
#pragma unroll
            for (int bj = 0; bj < 2; ++bj) {
                const int cs = colb + bj * HALF; const bool isq = cs < 512, isk = (cs >= 512) && (cs < 640);
                f32x4 v0 = acc[ai][bj][m][0], v1 = acc[ai][bj][m][1];
                if ((isq || isk) && anyrope) {
                    f32x4 p0, p1;
#pragma unroll
                    for (int e = 0; e < 4; ++e) { p0[e] = __shfl_xor(v0[e], 32); p1[e] = __shfl_xor(v1[e], 32); }
                    v0 = v0 * c0 + (p0 * sgn) * s0; v1 = v1 * c1 + (p1 * sgn) * s1;
                }
                if (isq) { v0 = v0 * QSCALE; v1 = v1 * QSCALE; }
                *(u32x4*)(O + (size_t)grow * J.ldc + cs + wc * 32 + 8 * fq) = pack8(v0, v1);
            }
            asm volatile("" ::: "memory");
        }
}
__device__ __forceinline__ void epi_vt(const f32x4 (&acc)[2][2][4][2], const Job& J, int pm, int pn, int wr, int wc, int fr, int fq) {
    const int s = pm >> 1, c0 = (pm & 1) * 256;
    bf16_t* base; size_t cstride;
    if (pn < MX / 256) { const int b = pn >> 3, t0 = (pn & 7) * 256; base = (bf16_t*)J.out + ((size_t)(b * 512) * 2 + s) * SEQ + t0; cstride = 2 * SEQ; }
    else { const int b = pn - MX / 256; base = (bf16_t*)J.out2 + ((size_t)(b * 512) * 2 + s) * CTXL; cstride = 2 * CTXL; }
#pragma unroll
    for (int ai = 0; ai < 2; ++ai)
#pragma unroll
        for (int m = 0; m < 4; ++m) {
            bf16_t* rowp = base + (size_t)(c0 + ai * HALF + wr * 64 + m * 16 + fr) * cstride + wc * 32 + 8 * fq;
#pragma unroll
            for (int bj = 0; bj < 2; ++bj) *(u32x4*)(rowp + bj * HALF) = pack8(acc[ai][bj][m][0], acc[ai][bj][m][1]);
        }
}
__device__ __forceinline__ void epi_ffn(const f32x4 (&acc)[2][2][4][2], const Job& J, int rowt, int pn, int wr, int wc, int fr, int fq, int lane) {
    bf16_t* O = (bf16_t*)J.out; float* SIDE = (float*)J.out2; const float* cw = J.aux;
    const int col = 128 * pn + 32 * wc + 8 * fq;
    f32x4 w0[2], w1[2], w2[2];
#pragma unroll
    for (int n = 0; n < 2; ++n) { w0[n] = *(const f32x4*)(cw + col + 4 * n); w1[n] = *(const f32x4*)(cw + DFF + col + 4 * n); w2[n] = *(const f32x4*)(cw + 2 * DFF + col + 4 * n); }
    const int srcdn = (lane & 48) | ((fr + 15) & 15), srcup = (lane & 48) | ((fr + 1) & 15);
#pragma unroll
    for (int ai = 0; ai < 2; ++ai) {
        const int blk = (rowt + ai * HALF + wr * 64) >> 6;
        f32x4 cv[4][2];
#pragma unroll
        for (int n = 0; n < 2; ++n)
#pragma unroll
            for (int e = 0; e < 4; ++e) {
                float g[4], dn[4], up[4];
#pragma unroll
                for (int m = 0; m < 4; ++m) { g[m] = acc[ai][0][m][n][e]; dn[m] = __shfl(g[m], srcdn); up[m] = __shfl(g[m], srcup); }
#pragma unroll
                for (int m = 0; m < 4; ++m) {
                    const float pv = fr > 0 ? dn[m] : (m > 0 ? dn[m - 1] : 0.f);
                    const float nx = fr < 15 ? up[m] : (m < 3 ? up[m + 1] : 0.f);
                    cv[m][n][e] = w0[n][e] * pv + w1[n][e] * g[m] + w2[n][e] * nx;
                }
            }
#pragma unroll
        for (int m = 0; m < 4; ++m) {
            const int grow = rowt + ai * HALF + wr * 64 + m * 16 + fr;
            const bool first = (m == 0 && fr == 0), last = (m == 3 && fr == 15);
            if (first || last) {
                float* sp = SIDE + ((size_t)(blk * 2 + (last ? 1 : 0)) * 3) * DFF + col;
#pragma unroll
                for (int n = 0; n < 2; ++n) { *(f32x4*)(sp + 4 * n) = cv[m][n]; *(f32x4*)(sp + DFF + 4 * n) = acc[ai][0][m][n]; *(f32x4*)(sp + 2 * DFF + 4 * n) = acc[ai][1][m][n]; }
            } else {
                f32x4 a0, a1;
#pragma unroll
                for (int e = 0; e < 4; ++e) { a0[e] = silu_f(cv[m][0][e]) * acc[ai][1][m][0][e]; a1[e] = silu_f(cv[m][1][e]) * acc[ai][1][m][1][e]; }
                *(u32x4*)(O + (size_t)grow * DFF + col) = pack8(a0, a1);
            }
        }
    }
}
__device__ __forceinline__ void epi_slab(const f32x4 (&acc)[2][2][4][2], const Job& J, const Unit& u, int wr, int wc, int fr, int fq) {
    const int ld = J.nN * BM;
    float* O = J.slab + ((size_t)u.slice * J.cM * BM + (size_t)(u.pm - J.nM) * BM) * ld + u.pn * BM;
#pragma unroll
    for (int ai = 0; ai < 2; ++ai)
#pragma unroll
        for (int m = 0; m < 4; ++m) {
            float* rowp = O + (size_t)(ai * HALF + wr * 64 + m * 16 + fr) * ld + wc * 32 + 8 * fq;
#pragma unroll
            for (int bj = 0; bj < 2; ++bj) { *(f32x4*)(rowp + bj * HALF) = acc[ai][bj][m][0]; *(f32x4*)(rowp + bj * HALF + 4) = acc[ai][bj][m][1]; }
        }
}
__device__ __forceinline__ void epilogue(const f32x4 (&acc)[2][2][4][2], const Call& C, const Unit& u, int wr, int wc, int fr_, int fq_, int lane) {
    asm volatile("" : "+v"(lane));
    const int fr = lane & 15, fq = lane >> 4;
    const Job& J = C.j0;
    if (u.slice >= 0) epi_slab(acc, J, u, wr, wc, fr, fq);
    else if (J.kind == K_PLAIN) epi_plain(acc, J, J.row0 + u.pm * BM, J.col0 + u.pn * BM, wr, wc, fr, fq);
    else if (J.kind == K_DFT) epi_plain(acc, J, J.row0 + ((u.pn >> 1) * J.p0 + u.pm) * BM, J.col0 + (u.pn & 1) * BM, wr, wc, fr, fq);
    else if (J.kind == K_ROPE) epi_rope(acc, J, J.row0 + u.pm * BM, J.col0 + u.pn * BM, wr, wc, fr, fq);
    else if (J.kind == K_VT) epi_vt(acc, J, u.pm, u.pn, wr, wc, fr, fq);
    else epi_ffn(acc, J, J.row0 + u.pm * BM, u.pn, wr, wc, fr, fq, lane);
}

__device__ __forceinline__ void gemm_phase(LAS unsigned char* lds, const Call& C, const int tid) {
    const int wid = __builtin_amdgcn_readfirstlane(tid >> 6), lane = tid & 63, wr = wid >> 2, wc = wid & 3, fr = lane & 15, fq = lane >> 4;
    unsigned voffA[2], voffB[2];
#pragma unroll
    for (int i = 0; i < 2; ++i) { int R, Cc; stage_rc(tid * 16 + i * 8192, R, Cc); const int Rb = (R & ~31) + perm32(R & 31);
        voffA[i] = (unsigned)(R * C.lda + Cc) * 2u; voffB[i] = (unsigned)(Rb * C.ldb + Cc) * 2u; }
    const size_t kstep = (size_t)(BK * 2);
    const size_t hstepA = (size_t)HALF * C.lda * 2, hstepB = (size_t)HALF * C.ldb * 2;
    const unsigned ldsw = (unsigned)wid * 1024u;
    const int aoff = lds_byte(wr * 64 + fr, fq * 8), boff = lds_byte(wc * 32 + fr, fq * 8);
#define PG8_SA(b, h) (((b) * 2 + (h)) * HTB)
#define PG8_SB(b, h) ((4 + (b) * 2 + (h)) * HTB)
#define PG8_STAGE(bufoff, gbase, voff) do { _Pragma("unroll") for (int _i = 0; _i < 2; ++_i) { unsigned _vo = (voff)[_i]; asm volatile("" : "+v"(_vo));   \
        __builtin_amdgcn_global_load_lds((const unsigned*)((const char*)(gbase) + _vo), (LAS unsigned*)(lds + (bufoff) + ldsw + _i * 8192), 16, 0, 0); } } while (0)
#define PG8_LDA(dst, b, h) do { _Pragma("unroll") for (int m = 0; m < 4; ++m) _Pragma("unroll") for (int k = 0; k < 2; ++k) dst[m][k] = *(const LAS bf16x8*)(lds + PG8_SA(b, h) + aoff + m * 2048 + k * 1024); } while (0)
#define PG8_LDB(dst, b, h) do { _Pragma("unroll") for (int n = 0; n < 2; ++n) _Pragma("unroll") for (int k = 0; k < 2; ++k) dst[n][k] = *(const LAS bf16x8*)(lds + PG8_SB(b, h) + boff + n * 2048 + k * 1024); } while (0)
#define PG8_MMA(ai, bj, At, Bt) do { __builtin_amdgcn_s_setprio(1); _Pragma("unroll") for (int m = 0; m < 4; ++m) _Pragma("unroll") for (int n = 0; n < 2; ++n) _Pragma("unroll") for (int k = 0; k < 2; ++k) \
        acc[ai][bj][m][n] = __builtin_amdgcn_mfma_f32_16x16x32_bf16(Bt[n][k], At[m][k], acc[ai][bj][m][n], 0, 0, 0); __builtin_amdgcn_s_setprio(0); } while (0)
#define PG8_WAIT_V(n) asm volatile("s_waitcnt vmcnt(" #n ")" ::: "memory")
#define PG8_WAIT_L(n) asm volatile("s_waitcnt lgkmcnt(" #n ")" ::: "memory")
#define PG8_BAR __builtin_amdgcn_s_barrier()
#define PG8_SCHED __builtin_amdgcn_sched_barrier(0)
#define PG8_APTR(u) ((const char*)C.j0.A + (size_t)(u).pm * 2 * hstepA + (size_t)(u).kp0 * (4 * BK))
#define PG8_BPTR(u) ((const char*)C.j0.B + (size_t)(u).pn * 2 * hstepB + (size_t)(u).kp0 * (4 * BK))
    Unit cur, nxt; int ui = 0;
    next_unit(C, 0, cur.pm, cur.pn, cur.kp0, cur.np, cur.slice);
    if (cur.pm < 0) return;
    f32x4 acc[2][2][4][2];
#pragma unroll
    for (int a = 0; a < 2; ++a)
#pragma unroll
        for (int b = 0; b < 2; ++b)
#pragma unroll
            for (int m = 0; m < 4; ++m)
#pragma unroll
                for (int n = 0; n < 2; ++n) acc[a][b][m][n] = (f32x4){0.f, 0.f, 0.f, 0.f};
    bf16x8 At[4][2], B0[2][2], B1[2][2];
    const char* cA = PG8_APTR(cur); const char* cB = PG8_BPTR(cur);
    PG8_STAGE(PG8_SB(0, 0), cB, voffB); PG8_STAGE(PG8_SB(0, 1), cB + hstepB, voffB); PG8_STAGE(PG8_SA(0, 0), cA, voffA); PG8_STAGE(PG8_SA(0, 1), cA + hstepA, voffA);
    if (wr == 1) PG8_BAR;
    PG8_WAIT_V(2); PG8_BAR;
    PG8_STAGE(PG8_SB(1, 0), cB + kstep, voffB); PG8_STAGE(PG8_SA(1, 0), cA + kstep, voffA); PG8_STAGE(PG8_SB(1, 1), cB + hstepB + kstep, voffB);
    PG8_WAIT_V(6); PG8_BAR;
    for (;;) {
        next_unit(C, ui + 1, nxt.pm, nxt.pn, nxt.kp0, nxt.np, nxt.slice);
        const bool has_next = nxt.pm >= 0;
        const char* nA = has_next ? PG8_APTR(nxt) : cA; const char* nB = has_next ? PG8_BPTR(nxt) : cB;
        const int nt = 2 * cur.np;
        for (int t = 0; t < nt; t += 2) {
            const bool last = (t == nt - 2);
            const char* a1 = cA + (size_t)(t + 1) * kstep;
            const char* a2 = last ? nA : cA + (size_t)(t + 2) * kstep; const char* b2 = last ? nB : cB + (size_t)(t + 2) * kstep;
            const char* a3 = a2 + kstep; const char* b3 = b2 + kstep;
            PG8_LDB(B0, 0, 0); PG8_LDB(B1, 0, 1); PG8_SCHED; PG8_LDA(At, 0, 0); PG8_STAGE(PG8_SA(1, 1), a1 + hstepA, voffA);
            PG8_WAIT_V(8); PG8_WAIT_L(0); PG8_BAR; PG8_MMA(0, 0, At, B0); PG8_MMA(0, 1, At, B1); PG8_BAR; PG8_SCHED;
            PG8_LDA(At, 0, 1); PG8_STAGE(PG8_SB(0, 0), b2, voffB); PG8_STAGE(PG8_SB(0, 1), b2 + hstepB, voffB); PG8_STAGE(PG8_SA(0, 0), a2, voffA);
            PG8_WAIT_V(8); PG8_WAIT_L(0); PG8_BAR; PG8_MMA(1, 0, At, B0); PG8_MMA(1, 1, At, B1); PG8_BAR; PG8_SCHED;
            PG8_LDB(B0, 1, 0); PG8_LDB(B1, 1, 1); PG8_SCHED; PG8_LDA(At, 1, 0); PG8_STAGE(PG8_SA(0, 1), a2 + hstepA, voffA);
            PG8_WAIT_V(8); PG8_WAIT_L(0); PG8_BAR; PG8_MMA(0, 0, At, B0); PG8_MMA(0, 1, At, B1); PG8_BAR; PG8_SCHED;
            PG8_LDA(At, 1, 1); PG8_STAGE(PG8_SB(1, 0), b3, voffB); PG8_STAGE(PG8_SB(1, 1), b3 + hstepB, voffB); PG8_STAGE(PG8_SA(1, 0), a3, voffA);
            PG8_WAIT_V(8); PG8_WAIT_L(0); PG8_BAR; PG8_MMA(1, 0, At, B0); PG8_MMA(1, 1, At, B1); PG8_BAR; PG8_SCHED;
        }
        if (wr == 0) PG8_BAR;
        epilogue(acc, C, cur, wr, wc, fr, fq, lane);
        if (!has_next) break;
#pragma unroll
        for (int a = 0; a < 2; ++a)
#pragma unroll
            for (int b = 0; b < 2; ++b)
#pragma unroll
                for (int m = 0; m < 4; ++m)
#pragma unroll
                    for (int n = 0; n < 2; ++n) acc[a][b][m][n] = (f32x4){0.f, 0.f, 0.f, 0.f};
        cur.pm = nxt.pm; cur.pn = nxt.pn; cur.kp0 = nxt.kp0; cur.np = nxt.np; cur.slice = nxt.slice; cA = nA; cB = nB; ++ui;
        if (wr == 1) PG8_BAR;
    }
    PG8_WAIT_V(0);
    PG8_BAR;
#undef PG8_SA
#undef PG8_SB
#undef PG8_STAGE
#undef PG8_LDA
#undef PG8_LDB
#undef PG8_MMA
#undef PG8_WAIT_V
#undef PG8_WAIT_L
#undef PG8_BAR
#undef PG8_SCHED
#undef PG8_APTR
#undef PG8_BPTR
}
}

__device__ __forceinline__ void tr_load(const float* src, int ldn, int lane, f32x4 (&v)[8]) {
    const int r8 = lane >> 3, c4 = lane & 7;
#pragma unroll
    for (int i = 0; i < 8; ++i) v[i] = *(const f32x4*)(src + (size_t)(8 * i + r8) * ldn + 4 * c4);
}
__device__ __forceinline__ void tr_finish(const f32x4 (&v)[8], bf16_t* dst, bf16_t* dst2, int ldk, LAS float* scr, int lane) {
    const int r8 = lane >> 3, c4 = lane & 7;
#pragma unroll
    for (int i = 0; i < 8; ++i) { LAS float* w = scr + (8 * i + r8) * 33 + 4 * c4; w[0] = v[i][0]; w[1] = v[i][1]; w[2] = v[i][2]; w[3] = v[i][3]; }
    LDS_WAIT(); asm volatile("" ::: "memory");
    const int c = lane & 7;
#pragma unroll
    for (int j = 0; j < 4; ++j) { const int n = (lane >> 3) + 8 * j; const LAS float* sp = scr + (8 * c) * 33 + n;
        u32x4 o; o.x = cvt_pk_bf16(sp[0 * 33], sp[1 * 33]); o.y = cvt_pk_bf16(sp[2 * 33], sp[3 * 33]); o.z = cvt_pk_bf16(sp[4 * 33], sp[5 * 33]); o.w = cvt_pk_bf16(sp[6 * 33], sp[7 * 33]);
        *(u32x4*)(dst + (size_t)n * ldk + 8 * c) = o; if (dst2) *(u32x4*)(dst2 + (size_t)n * ldk + 8 * c) = o; }
    LDS_WAIT(); asm volatile("" ::: "memory");
}

struct Args { const float* in[18]; float* out; unsigned char* ws; int ph_lo, ph_hi, dry, pad; };

__device__ __forceinline__ void mod_item(LAS unsigned char* lds, const Args& a, int item, int tid) {
    const int l = item >> 6, n0 = 96 * (item & 63);
    const float* cv = a.in[1]; const float* cc = a.in[3]; const float* mw = a.in[4] + (size_t)l * DM * 6144; const float* mb = a.in[5] + l * 6144;
    LAS float* sv = (LAS float*)lds; LAS float* red = (LAS float*)(lds + 40960);
    for (int i = tid; i < 9 * DM; i += NTHR) { const int r = i >> 10, k = i & 1023; const float v = r < 8 ? cv[r * DM + k] : cc[k]; sv[i] = v / (1.0f + __expf(-v)); }
    __syncthreads();
    const int col4 = tid % 24, kg = tid / 24;
    if (kg < 21) {
        f32x4 acc[9];
#pragma unroll
        for (int r = 0; r < 9; ++r) acc[r] = (f32x4){0.f, 0.f, 0.f, 0.f};
#pragma unroll 7
        for (int k = kg; k < DM; k += 21) {
            const f32x4 w = *(const f32x4*)(mw + (size_t)k * 6144 + n0 + 4 * col4);
#pragma unroll
            for (int r = 0; r < 9; ++r) acc[r] += w * sv[r * DM + k];
        }
#pragma unroll
        for (int r = 0; r < 9; ++r)
#pragma unroll
            for (int e = 0; e < 4; ++e) red[(kg * 9 + r) * 96 + 4 * col4 + e] = acc[r][e];
    }
    __syncthreads();
    float* modx = (float*)(a.ws + WS_MODX); float* modc = (float*)(a.ws + WS_MODC);
    for (int idx = tid; idx < 9 * 96; idx += NTHR) {
        const int r = idx / 96, n = idx % 96; float s = mb[n0 + n];
        for (int g = 0; g < 21; ++g) s += red[(g * 9 + r) * 96 + n];
        if (r < 8) modx[((size_t)(l * 8 + r)) * 6144 + n0 + n] = s; else modc[(size_t)l * 6144 + n0 + n] = s;
    }
    __syncthreads();
}

__device__ __forceinline__ void fold_in_item(LAS unsigned char* lds, const Args& a, int item, int tid) {
    const int o = item >> 6, g = (item >> 4) & 3, kc = item & 15;
    const float* W = a.in[11] + (size_t)o * DM * DM; bf16_t* WMI = (bf16_t*)(a.ws + WS_WMI + o * SZ_WMI);
    LAS float* Wl = (LAS float*)lds; const LAS float* tab = (const LAS float*)(lds + LDS_COSTAB);
    LAS float* tc = (LAS float*)(lds + 64 * 129 * 4); LAS float* ts = tc + 128;
    if (tid < 128) { tc[tid] = tab[16 * tid]; ts[tid] = tab[(16 * tid - 512) & 2047]; }
    {   f32x4 t[4];
#pragma unroll
        for (int i = 0; i < 4; ++i) { const int idx = tid + NTHR * i, kk = idx >> 5, j4 = idx & 31; t[i] = *(const f32x4*)(W + (size_t)(64 * kc + kk) * DM + 512 + 128 * g + 4 * j4); }
#pragma unroll
        for (int i = 0; i < 4; ++i) { const int idx = tid + NTHR * i, kk = idx >> 5, j4 = idx & 31; LAS float* w = Wl + kk * 129 + 4 * j4; w[0] = t[i][0]; w[1] = t[i][1]; w[2] = t[i][2]; w[3] = t[i][3]; } }
    __syncthreads();
    const int lane = tid & 63, wv = tid >> 6, i32 = lane & 31, hi = lane >> 5, kh = wv >> 2, jb = wv & 3, jp = 32 * jb + i32;
    f32x16 dc, ds;
#pragma unroll
    for (int r = 0; r < 16; ++r) { dc[r] = 0.f; ds[r] = 0.f; }
    const LAS float* arow = Wl + (32 * kh + i32) * 129 + hi;
#pragma unroll 8
    for (int st = 0; st < 64; ++st) {
        const float av = arow[2 * st]; const int ph = ((2 * st + hi) * jp) & 127;
        dc = __builtin_amdgcn_mfma_f32_32x32x2f32(av, tc[ph], dc, 0, 0, 0);
        ds = __builtin_amdgcn_mfma_f32_32x32x2f32(av, ts[ph], ds, 0, 0, 0);
    }
    bf16_t* oc = WMI + (size_t)(512 + 128 * g + jp) * DM + 64 * kc + 32 * kh + 4 * hi; bf16_t* os = oc + (size_t)512 * DM;
#pragma unroll
    for (int q = 0; q < 4; ++q) {
        u32x2 wc, ws_; wc.x = cvt_pk_bf16(dc[4 * q], dc[4 * q + 1]); wc.y = cvt_pk_bf16(dc[4 * q + 2], dc[4 * q + 3]); ws_.x = cvt_pk_bf16(ds[4 * q], ds[4 * q + 1]); ws_.y = cvt_pk_bf16(ds[4 * q + 2], ds[4 * q + 3]);
        *(u32x2*)(oc + 8 * q) = wc; *(u32x2*)(os + 8 * q) = ws_;
    }
    __syncthreads();
}
__device__ __forceinline__ void fold_out_item(LAS unsigned char* lds, const Args& a, int item, int tid) {
    const int o = item >> 6, g = (item >> 4) & 3, nc = item & 15;
    const float* WG = a.in[12] + (size_t)(o * 4 + g) * 128 * 128; const float* SC = a.in[13] + o * 512 + 128 * g; const float* WO = a.in[14] + (size_t)o * DM * DM + (size_t)(128 * g) * DM + 64 * nc;
    bf16_t* WMO = (bf16_t*)(a.ws + WS_WMO + o * SZ_WMO);
    LAS float* Wg = (LAS float*)lds; LAS float* Wo = (LAS float*)(lds + 66560);
    {   f32x4 t[8], u[4];
#pragma unroll
        for (int i = 0; i < 8; ++i) t[i] = *(const f32x4*)(WG + 4 * (tid + NTHR * i));
#pragma unroll
        for (int i = 0; i < 4; ++i) { const int idx = tid + NTHR * i, d = idx >> 4, n4 = idx & 15; u[i] = *(const f32x4*)(WO + (size_t)d * DM + 4 * n4) * SC[d]; }
#pragma unroll
        for (int i = 0; i < 8; ++i) { const int idx = 4 * (tid + NTHR * i), c = idx >> 7, d = idx & 127; LAS float* w = Wg + c * 129 + d; w[0] = t[i][0]; w[1] = t[i][1]; w[2] = t[i][2]; w[3] = t[i][3]; }
#pragma unroll
        for (int i = 0; i < 4; ++i) { const int idx = tid + NTHR * i, d = idx >> 4, n4 = idx & 15; LAS float* w = Wo + d * 65 + 4 * n4; w[0] = u[i][0]; w[1] = u[i][1]; w[2] = u[i][2]; w[3] = u[i][3]; } }
    __syncthreads();
    const int lane = tid & 63, wv = tid >> 6, i32 = lane & 31, hi = lane >> 5, cb = wv & 3, nb = wv >> 2;
    f32x16 dd;
#pragma unroll
    for (int r = 0; r < 16; ++r) dd[r] = 0.f;
    const LAS float* arow = Wg + (32 * cb + i32) * 129 + hi; const LAS float* bcol = Wo + hi * 65 + 32 * nb + i32;
#pragma unroll 8
    for (int st = 0; st < 64; ++st) dd = __builtin_amdgcn_mfma_f32_32x32x2f32(arow[2 * st], bcol[2 * st * 65], dd, 0, 0, 0);
    bf16_t* op = WMO + (size_t)(64 * nc + 32 * nb + i32) * WMOLD + 128 * g + 32 * cb + 4 * hi;
#pragma unroll
    for (int q = 0; q < 4; ++q) { u32x2 w; w.x = cvt_pk_bf16(dd[4 * q], dd[4 * q + 1]); w.y = cvt_pk_bf16(dd[4 * q + 2], dd[4 * q + 3]); *(u32x2*)(op + 8 * q) = w; }
    __syncthreads();
}

struct TrDesc { const float* src; bf16_t* dst; bf16_t* dst2; int ldn, ldk; };
__device__ __forceinline__ TrDesc tr_decode(const Args& a, int l, int it) {
    constexpr int I_WIN = 16 * 72, I_WOUT = 16 * 32, I_WMI = 16 * 16, I_WMO = 8 * 32, I_WUP = 16 * 176;
    const bool even = (l & 1) == 0; const int eo = l >> 1;
    const int n1 = even ? I_WIN : I_WMI, n2 = even ? I_WOUT : I_WMO;
    TrDesc d; d.dst2 = nullptr; int r = it;
    if (r < n1) {
        if (even) { const int kb = r / 72, nb = r % 72; d.src = a.in[7] + (size_t)eo * DM * ATT_IN + (size_t)(64 * kb) * ATT_IN + 32 * nb; d.ldn = ATT_IN; d.dst = (bf16_t*)(a.ws + WS_WIN + eo * SZ_WIN) + (size_t)(32 * nb) * DM + 64 * kb; d.ldk = DM; }
        else { const int kb = r / 16, nb = r % 16; d.src = a.in[11] + (size_t)eo * DM * DM + (size_t)(64 * kb) * DM + 32 * nb; d.ldn = DM; d.dst = (bf16_t*)(a.ws + WS_WMI + eo * SZ_WMI) + (size_t)(32 * nb) * DM + 64 * kb; d.ldk = DM; }
        return d; }
    r -= n1;
    if (r < n2) {
        const int kb = r / 32, nb = r % 32;
        if (even) { d.src = a.in[10] + (size_t)eo * DM * DM + (size_t)(64 * kb) * DM + 32 * nb; d.ldn = DM; d.dst = (bf16_t*)(a.ws + WS_WOUT + eo * SZ_WOUT) + (size_t)(32 * nb) * DM + 64 * kb; d.ldk = DM; }
        else { d.src = a.in[14] + (size_t)eo * DM * DM + (size_t)(512 + 64 * kb) * DM + 32 * nb; d.ldn = DM; d.dst = (bf16_t*)(a.ws + WS_WMO + eo * SZ_WMO) + (size_t)(32 * nb) * WMOLD + 512 + 64 * kb; d.ldk = WMOLD; }
        return d; }
    r -= n2;
    if (r < I_WUP) { const int kb = r / 176, nb = r % 176, j = nb >> 3, sub = nb & 7; const int scol = sub < 4 ? 128 * j + 32 * sub : DFF + 128 * j + 32 * (sub - 4);
        d.src = a.in[15] + (size_t)l * DM * NUP + (size_t)(64 * kb) * NUP + scol; d.ldn = NUP; d.dst = (bf16_t*)(a.ws + WS_WUP + l * SZ_WUP) + (size_t)(32 * nb) * DM + 64 * kb; d.ldk = DM; return d; }
    r -= I_WUP;
    { const int kb = r / 32, nb = r % 32; d.src = a.in[17] + (size_t)l * DFF * DM + (size_t)(64 * kb) * DM + 32 * nb; d.ldn = DM; d.dst = (bf16_t*)(a.ws + WS_WDN + l * SZ_WDN) + (size_t)(32 * nb) * DFF + 64 * kb; d.ldk = DFF; }
    return d;
}
__device__ __forceinline__ void tr_layer(LAS unsigned char* lds, const Args& a, int l, int wr, int nw, int lane, int wave) {
    LAS float* scr = (LAS float*)(lds + wave * 8448);
    const int NIT = ((l & 1) == 0 ? 16 * 72 + 16 * 32 : 16 * 16 + 8 * 32) + 16 * 176 + 44 * 32;
    for (int it = wr; it < NIT; it += 2 * nw) {
        const bool two = it + nw < NIT;
        const TrDesc d0 = tr_decode(a, l, it), d1 = tr_decode(a, l, two ? it + nw : it);
        f32x4 v0[8], v1[8];
        tr_load(d0.src, d0.ldn, lane, v0); tr_load(d1.src, d1.ldn, lane, v1);
        tr_finish(v0, d0.dst, d0.dst2, d0.ldk, scr, lane);
        if (two) tr_finish(v1, d1.dst, d1.dst2, d1.ldk, scr, lane);
    }
}
__device__ __forceinline__ void fold_layer(LAS unsigned char* lds, const Args& a, int o, int rk, int n, int tid) {
    { LAS float* tab = (LAS float*)(lds + LDS_COSTAB); for (int i = tid; i < 2048; i += NTHR) tab[i] = cospif((float)i * (1.0f / 1024.0f)); }
    __syncthreads();
    for (int it = rk; it < 64; it += n) fold_in_item(lds, a, o * 64 + it, tid);
    for (int it = rk; it < 64; it += n) fold_out_item(lds, a, o * 64 + (it + 64) % 64, tid);
    if (o == 0) {
        const LAS float* tab = (const LAS float*)(lds + LDS_COSTAB);
        const int gt = rk * NTHR + tid, NT = n * NTHR;
        bf16_t* FM = (bf16_t*)(a.ws + WS_FMAT);
        for (int idx = gt; idx < 2048 * 256; idx += NT) {
            const int k = idx >> 8, t0 = (idx & 255) * 8, ph0 = (k * t0) & 2047;
            float c = tab[ph0], sn = tab[(ph0 - 512) & 2047]; const float dc = tab[k], dsn = tab[(k - 512) & 2047];
            float vc[8], vs[8];
#pragma unroll
            for (int e = 0; e < 8; ++e) { vc[e] = c * (1.0f / 512.0f); vs[e] = sn * (-1.0f / 512.0f); const float c2 = c * dc - sn * dsn; sn = sn * dc + c * dsn; c = c2; }
            u32x4 w; w.x = cvt_pk_bf16(vc[0], vc[1]); w.y = cvt_pk_bf16(vc[2], vc[3]); w.z = cvt_pk_bf16(vc[4], vc[5]); w.w = cvt_pk_bf16(vc[6], vc[7]);
            *(u32x4*)(FM + (size_t)k * 4096 + t0) = w;
            w.x = cvt_pk_bf16(vs[0], vs[1]); w.y = cvt_pk_bf16(vs[2], vs[3]); w.z = cvt_pk_bf16(vs[4], vs[5]); w.w = cvt_pk_bf16(vs[6], vs[7]);
            *(u32x4*)(FM + (size_t)k * 4096 + 2048 + t0) = w;
        }
        bf16_t* FC = (bf16_t*)(a.ws + WS_FC); const float nc = 0.005524271728019903f;
        for (int idx = gt; idx < 256 * 64; idx += NT) {
            const int k = idx >> 6, ch = idx & 63, s = ch >> 5, t0 = (ch & 31) * 8; float v[8];
#pragma unroll
            for (int e = 0; e < 8; ++e) { const int ph = ((k * (t0 + e)) & 255) * 8; v[e] = s ? -tab[(ph - 512) & 2047] * nc : tab[ph] * nc; }
            u32x4 w; w.x = cvt_pk_bf16(v[0], v[1]); w.y = cvt_pk_bf16(v[2], v[3]); w.z = cvt_pk_bf16(v[4], v[5]); w.w = cvt_pk_bf16(v[6], v[7]);
            *(u32x4*)(FC + (size_t)k * 512 + ch * 8) = w;
        }
    }
    __syncthreads();
}
__device__ __forceinline__ void prologue_a(LAS unsigned char* lds, const Args& a, int tid, int lane, int wave, int G) {
    const int bx = blockIdx.x;
    for (int it = bx; it < 256; it += G) mod_item(lds, a, it, tid);
    tr_layer(lds, a, 0, bx * NWAVES + wave, G * NWAVES, lane, wave);
    { const int gt = bx * NTHR + tid, NT = G * NTHR; float* TC = (float*)(a.ws + WS_TAB); float* TS = TC + 1024;
      for (int idx = gt; idx < 1024; idx += NT) { const int pos = idx >> 4, j = idx & 15; const float inv = powf(10000.0f, -(float)j / 16.0f); const float ang = (float)pos * inv; TC[idx] = cosf(ang); TS[idx] = sinf(ang); } }
    __syncthreads();
}

__device__ __forceinline__ void ld_row_f32(const float* p, int lane, f32x4 (&v)[4]) {
#pragma unroll
    for (int j = 0; j < 4; ++j) v[j] = *(const f32x4*)(p + 4 * lane + 256 * j);
}
__device__ __forceinline__ float row_rs(const f32x4 (&v)[4]) {
    float s = 0.f;
#pragma unroll
    for (int j = 0; j < 4; ++j) s += (v[j][0] * v[j][0] + v[j][1] * v[j][1]) + (v[j][2] * v[j][2] + v[j][3] * v[j][3]);
    return __builtin_amdgcn_rsqf(wave_sum(s) * (1.0f / DM) + EPS);
}
__device__ __forceinline__ void norm_mod_store(const f32x4 (&x)[4], const float* gain, const float* sc, const float* sh, bf16_t* hrow, int lane) {
    const float rs = row_rs(x);
#pragma unroll
    for (int j = 0; j < 4; ++j) {
        const int c = 4 * lane + 256 * j;
        const f32x4 g = *(const f32x4*)(gain + c), s1 = *(const f32x4*)(sc + c), s0 = *(const f32x4*)(sh + c);
        const f32x4 h = (x[j] * rs * g) * (s1 + 1.0f) + s0;
        u32x2 w; w.x = cvt_pk_bf16(h[0], h[1]); w.y = cvt_pk_bf16(h[2], h[3]);
        *(u32x2*)(hrow + c) = w;
    }
}
typedef GAS const float* gcf;
struct RowRegs { f32x4 x[4], y[4], gt[4], sc[4], sh[4]; };
struct RowCtx { gcf xsX, xsC, modx, modc, slab; GAS const bf16_t* Y; int layer, which, ns, lane; bool do_norm; };
__device__ __forceinline__ void row_load(RowRegs& R, const RowCtx& c, int row) {
    const bool isx = row < MX; const int b = row >> 11, lane = c.lane;
    gcf xi = isx ? c.xsX + (size_t)row * DM : c.xsC + (size_t)(row - MX) * DM;
#pragma unroll
    for (int j = 0; j < 4; ++j) R.x[j] = *(const GAS f32x4*)(xi + 4 * lane + 256 * j);
    gcf mod = isx ? c.modx + (size_t)(c.layer * 8 + b) * 6144 : c.modc + (size_t)c.layer * 6144;
    gcf modn = (c.which == 2) ? mod + (isx ? 8 * 6144 : 6144) : mod;
    const int so = c.which == 1 ? 4096 : 1024, ho = c.which == 1 ? 3072 : 0;
    if (c.do_norm) {
#pragma unroll
        for (int j = 0; j < 4; ++j) { R.sc[j] = *(const GAS f32x4*)(modn + so + 4 * lane + 256 * j); R.sh[j] = *(const GAS f32x4*)(modn + ho + 4 * lane + 256 * j); }
    }
    if (c.which != 0) {
        gcf gate = mod + (c.which == 1 ? 2048 : 5120);
#pragma unroll
        for (int j = 0; j < 4; ++j) R.gt[j] = *(const GAS f32x4*)(gate + 4 * lane + 256 * j);
        if (isx) {
#pragma unroll
            for (int j = 0; j < 4; ++j) { const u32x2 w = *(const GAS u32x2*)(c.Y + (size_t)row * DM + 4 * lane + 256 * j); R.y[j] = (f32x4){bf_lo(w.x), bf_hi(w.x), bf_lo(w.y), bf_hi(w.y)}; }
        } else {
            gcf sl = c.slab + (size_t)(row - MX) * DM;
#pragma unroll
            for (int j = 0; j < 4; ++j) R.y[j] = *(const GAS f32x4*)(sl + 4 * lane + 256 * j);
            for (int k = 1; k < c.ns; ++k)
#pragma unroll
                for (int j = 0; j < 4; ++j) R.y[j] += *(const GAS f32x4*)(sl + (size_t)k * MC * DM + 4 * lane + 256 * j);
        }
    }
}
__device__ __forceinline__ void row_finish(RowRegs& R, const RowCtx& c, int row, const f32x4 (&gA)[4], const f32x4 (&gB)[4], GAS float* xo, GAS bf16_t* ho) {
    const int lane = c.lane;
    if (c.which != 0) {
        const float rsy = row_rs(R.y);
#pragma unroll
        for (int j = 0; j < 4; ++j) { R.x[j] = R.x[j] + R.gt[j] * (R.y[j] * rsy * gA[j]); *(GAS f32x4*)(xo + 4 * lane + 256 * j) = R.x[j]; }
    }
    if (c.do_norm) {
        const float rs = row_rs(R.x);
#pragma unroll
        for (int j = 0; j < 4; ++j) {
            const f32x4 h = (R.x[j] * rs * gB[j]) * (R.sc[j] + 1.0f) + R.sh[j];
            u32x2 w; w.x = cvt_pk_bf16(h[0], h[1]); w.y = cvt_pk_bf16(h[2], h[3]);
            *(GAS u32x2*)(ho + 4 * lane + 256 * j) = w;
        }
    }
}
__device__ __forceinline__ void row_phase(const Args& a, int layer, int which, int nrows, int lane, int gw, int NGW) {
    RowCtx c; c.layer = layer; c.which = which; c.lane = lane; c.do_norm = !(which == 2 && layer == DEPTH - 1);
    c.modx = (gcf)(a.ws + WS_MODX); c.modc = (gcf)(a.ws + WS_MODC); c.Y = (GAS const bf16_t*)(a.ws + WS_Y);
    c.slab = (gcf)(a.ws + (which == 1 ? WS_BIG : WS_MIX)); c.ns = which == 1 ? SL_OUT : SL_DN;
    GAS float* hctx = (GAS float*)(a.ws + WS_HCTX); GAS float* xoX = a.dry ? (GAS float*)(a.ws + WS_BIG) : (GAS float*)a.out; GAS bf16_t* HX = (GAS bf16_t*)(a.ws + WS_HX);
    const bool first = layer == 0 && which < 2;
    c.xsX = first ? (gcf)a.in[0] : (gcf)a.out; c.xsC = first ? (gcf)a.in[2] : (gcf)hctx;
    gcf gains = (gcf)a.in[6];
    f32x4 gA[4], gB[4];
    { gcf pa = gains + (layer * 4 + (which == 1 ? 1 : 3)) * DM; gcf pb = gains + ((which == 2 ? layer + 1 : layer) * 4 + (which == 1 ? 2 : 0)) * DM;
      if (!c.do_norm) pb = pa;
#pragma unroll
      for (int j = 0; j < 4; ++j) { gA[j] = *(const GAS f32x4*)(pa + 4 * lane + 256 * j); gB[j] = *(const GAS f32x4*)(pb + 4 * lane + 256 * j); } }
    const int nX = (MX + NGW - 1) / NGW, nC = nrows > MX ? (nrows - MX + NGW - 1) / NGW : 0;
    for (int i = 0; i < nX + nC; i += 2) {
        int rowA = i < nX ? gw * nX + i : MX + gw * nC + (i - nX); const int lim = i < nX ? MX : nrows;
        int rowB = i + 1 < nX ? gw * nX + i + 1 : MX + gw * nC + (i + 1 - nX); const int limB = i + 1 < nX ? MX : nrows;
        const bool okA = rowA < lim, two = okA && (i + 1 < nX + nC) && rowB < limB;
        if (!okA) { if (i + 1 < nX + nC && rowB < limB) { rowA = rowB; } else continue; }
        if (!two) rowB = rowA;
        RowRegs A, B;
        row_load(A, c, rowA); row_load(B, c, rowB);
        row_finish(A, c, rowA, gA, gB, rowA < MX ? xoX + (size_t)rowA * DM : hctx + (size_t)(rowA - MX) * DM, HX + (size_t)rowA * DM);
        if (two) row_finish(B, c, rowB, gA, gB, rowB < MX ? xoX + (size_t)rowB * DM : hctx + (size_t)(rowB - MX) * DM, HX + (size_t)rowB * DM);
    }
}

typedef short v4i16_t __attribute__((ext_vector_type(4)));
constexpr int AT_KP = 144, AT_VP = 192;
constexpr int AT_KB = 128 * AT_KP, AT_VB = 128 * AT_VP, AT_BUF = AT_KB + AT_VB, AT_STG = 2 * AT_BUF, AT_STGW = 32 * 144, AT_SCR = AT_STG + 8 * AT_STGW;
static_assert(AT_SCR + 8 * 256 <= RING_BYTES, "attention LDS map");
constexpr float AT_THR = 8.0f;
__device__ __forceinline__ int crow(int r, int hi) { return (r & 3) + 8 * (r >> 2) + 4 * hi; }

__device__ __forceinline__ void attn_unit(LAS unsigned char* lds, const bf16_t* U, bf16_t* MIXo, const float* sink8, int b, int hk, int qrow0, int qpos0, bool latent, int tid) {
    const int lane = tid & 63, r32 = lane & 31, hi = lane >> 5, wid = __builtin_amdgcn_readfirstlane(tid >> 6);
    const int hq = 4 * hk + (wid >> 1), rowoff = 32 * (wid & 1), qa = qpos0 + rowoff;
    const int ctxrow0 = MX + b * CTXL, nst = latent ? 5 : 2;
    bf16x8 qf[4];
#pragma unroll
    for (int d0 = 0; d0 < 4; ++d0) qf[d0] = *(const bf16x8*)(U + (size_t)(qrow0 + rowoff + r32) * ATT_IN + hq * 64 + 16 * d0 + 8 * hi);
    const float sink2 = sink8[hq] * LOG2E;
    float mref = sink2, lsum = hi == 0 ? 1.f : 0.f;
    f32x16 o0, o1, negm;
#pragma unroll
    for (int r = 0; r < 16; ++r) { o0[r] = 0.f; o1[r] = 0.f; negm[r] = -sink2; }
    volatile LAS float* scr = (volatile LAS float*)(lds + AT_SCR) + wid * 64;
    const int skey = tid >> 3, sch = tid & 7;
    u32x4 kr0, kr1, vr0, vr1;
#define AT_ROW(st, key) ((st) < 2 ? ctxrow0 + 128 * (st) + (key) : b * SEQ + min(max(qpos0 - 128 + 128 * ((st) - 2) + (key), 0), SEQ - 1))
#define AT_LOAD(st) do { const bf16_t* p0_ = U + (size_t)AT_ROW(st, skey) * ATT_IN + 512 + hk * 64 + 8 * sch; const bf16_t* p1_ = U + (size_t)AT_ROW(st, skey + 64) * ATT_IN + 512 + hk * 64 + 8 * sch; \
        kr0 = *(const u32x4*)p0_; vr0 = *(const u32x4*)(p0_ + 128); kr1 = *(const u32x4*)p1_; vr1 = *(const u32x4*)(p1_ + 128); } while (0)
#define AT_WRITE(bufi) do { LAS unsigned char* kb_ = lds + (bufi) * AT_BUF; LAS unsigned char* vb_ = kb_ + AT_KB; \
        *(LAS u32x4*)(kb_ + skey * AT_KP + sch * 16) = kr0; *(LAS u32x4*)(kb_ + (skey + 64) * AT_KP + sch * 16) = kr1; \
        *(LAS u32x4*)(vb_ + skey * AT_VP + sch * 16) = vr0; *(LAS u32x4*)(vb_ + (skey + 64) * AT_VP + sch * 16) = vr1; } while (0)
    AT_LOAD(0); AT_WRITE(0);
    __syncthreads();
    for (int st = 0; st < nst; ++st) {
        if (st + 1 < nst) AT_LOAD(st + 1);
        const LAS unsigned char* kbuf = lds + (st & 1) * AT_BUF; const LAS unsigned char* vbuf = kbuf + AT_KB;
        const bool win = st >= 2;
#pragma unroll
        for (int h = 0; h < 2; ++h) {
            const int kp = qpos0 - 128 + 128 * (st - 2) + 64 * h;
            if (win && (kp < 0 || kp >= SEQ || kp > qa + 159 || kp + 63 < qa - 128)) continue;
            const bool needmask = win && !(qa + 31 - kp <= 128 && kp + 63 - qa <= 128);
            const LAS unsigned char* kb = kbuf + (64 * h + r32) * AT_KP + 16 * hi;
            f32x16 p0 = negm, p1 = negm;
#pragma unroll
            for (int d0 = 0; d0 < 4; ++d0) {
                const bf16x8 k0 = *(const LAS bf16x8*)(kb + 32 * d0), k1 = *(const LAS bf16x8*)(kb + 32 * AT_KP + 32 * d0);
                p0 = __builtin_amdgcn_mfma_f32_32x32x16_bf16(k0, qf[d0], p0, 0, 0, 0); p1 = __builtin_amdgcn_mfma_f32_32x32x16_bf16(k1, qf[d0], p1, 0, 0, 0);
            }
            if (needmask) {
                const int qpos = qa + r32;
#pragma unroll
                for (int r = 0; r < 16; ++r) { const int kq = kp + crow(r, hi); int d0_ = qpos - kq; d0_ = d0_ < 0 ? -d0_ : d0_; int d1_ = qpos - (kq + 32); d1_ = d1_ < 0 ? -d1_ : d1_;
                    if (d0_ > 128) p0[r] = -INFINITY; if (d1_ > 128) p1[r] = -INFINITY; }
            }
            float mx = fmaxf(fmaxf(p0[0], p0[1]), p1[0]);
#pragma unroll
            for (int r = 2; r < 16; r += 2) mx = fmaxf(fmaxf(mx, p0[r]), p0[r + 1]);
#pragma unroll
            for (int r = 1; r < 15; r += 2) mx = fmaxf(fmaxf(mx, p1[r]), p1[r + 1]);
            mx = fmaxf(mx, p1[15]);
            mx = fmaxf(mx, __shfl_xor(mx, 32));
            if (__any(mx > AT_THR)) {
                const float dl = fmaxf(mx, 0.f), f = __builtin_amdgcn_exp2f(-dl);
                mref += dl; lsum *= f;
#pragma unroll
                for (int r = 0; r < 16; ++r) { p0[r] -= dl; p1[r] -= dl; negm[r] = -mref; }
                if (hi == 0) scr[r32] = f;
                LDS_WAIT();
#pragma unroll
                for (int r = 0; r < 16; ++r) { const float al = scr[crow(r, hi)]; o0[r] *= al; o1[r] *= al; }
                LDS_WAIT();
            }
            float rsum = 0.f;
#pragma unroll
            for (int r = 0; r < 16; ++r) { p0[r] = __builtin_amdgcn_exp2f(p0[r]); p1[r] = __builtin_amdgcn_exp2f(p1[r]); rsum += p0[r] + p1[r]; }
            lsum += rsum;
            bf16x8 pa[4];
#pragma unroll
            for (int s2 = 0; s2 < 2; ++s2) {
                u32x4 w0, w1;
                w0.x = cvt_pk_bf16(p0[8 * s2 + 0], p0[8 * s2 + 1]); w0.y = cvt_pk_bf16(p0[8 * s2 + 2], p0[8 * s2 + 3]); w0.z = cvt_pk_bf16(p0[8 * s2 + 4], p0[8 * s2 + 5]); w0.w = cvt_pk_bf16(p0[8 * s2 + 6], p0[8 * s2 + 7]);
                w1.x = cvt_pk_bf16(p1[8 * s2 + 0], p1[8 * s2 + 1]); w1.y = cvt_pk_bf16(p1[8 * s2 + 2], p1[8 * s2 + 3]); w1.z = cvt_pk_bf16(p1[8 * s2 + 4], p1[8 * s2 + 5]); w1.w = cvt_pk_bf16(p1[8 * s2 + 6], p1[8 * s2 + 7]);
                pa[s2] = __builtin_bit_cast(bf16x8, w0); pa[2 + s2] = __builtin_bit_cast(bf16x8, w1);
            }
            const LAS unsigned char* vb = vbuf + (64 * h + 4 * hi + ((lane & 15) >> 2)) * AT_VP + ((lane >> 4) & 1) * 32 + (lane & 3) * 8;
#pragma unroll
            for (int s = 0; s < 4; ++s) {
#pragma unroll
                for (int d = 0; d < 2; ++d) {
                    const v4i16_t lo = __builtin_amdgcn_ds_read_tr16_b64_v4i16((LAS v4i16_t*)(vb + 16 * s * AT_VP + 64 * d));
                    const v4i16_t hh = __builtin_amdgcn_ds_read_tr16_b64_v4i16((LAS v4i16_t*)(vb + (16 * s + 8) * AT_VP + 64 * d));
                    const bf16x8 vf = (bf16x8){lo[0], lo[1], lo[2], lo[3], hh[0], hh[1], hh[2], hh[3]};
                    if (d == 0) o0 = __builtin_amdgcn_mfma_f32_32x32x16_bf16(pa[s], vf, o0, 0, 0, 0); else o1 = __builtin_amdgcn_mfma_f32_32x32x16_bf16(pa[s], vf, o1, 0, 0, 0);
                }
            }
        }
        if (st + 1 < nst) AT_WRITE((st + 1) & 1);
        __syncthreads();
    }
    {
        const float lt = lsum + __shfl_xor(lsum, 32);
        if (hi == 0) scr[r32] = 1.0f / lt;
        LDS_WAIT();
        LAS unsigned short* stg = (LAS unsigned short*)(lds + AT_STG + wid * AT_STGW);
#pragma unroll
        for (int r = 0; r < 16; ++r) { const int q = crow(r, hi); const float il = scr[q];
            stg[q * 72 + r32] = (unsigned short)(cvt_pk_bf16(o0[r] * il, 0.f) & 0xffffu); stg[q * 72 + 32 + r32] = (unsigned short)(cvt_pk_bf16(o1[r] * il, 0.f) & 0xffffu); }
        LDS_WAIT();
#pragma unroll
        for (int i = 0; i < 4; ++i) { const int row = i * 8 + (lane >> 3), ch = lane & 7; const u32x4 v = *(const LAS u32x4*)((const LAS unsigned char*)stg + row * 144 + ch * 16);
            *(u32x4*)(MIXo + (size_t)(qrow0 + rowoff + row) * KMO + hq * 64 + 8 * ch) = v; }
        LDS_WAIT();
    }
#undef AT_ROW
#undef AT_LOAD
#undef AT_WRITE
}

__device__ __forceinline__ u32x4 ld16(const bf16_t* p) { return *(const u32x4*)p; }
__device__ __forceinline__ void unpack8(const u32x4& w, float (&f)[8]) { f[0] = bf_lo(w.x); f[1] = bf_hi(w.x); f[2] = bf_lo(w.y); f[3] = bf_hi(w.y); f[4] = bf_lo(w.z); f[5] = bf_hi(w.z); f[6] = bf_lo(w.w); f[7] = bf_hi(w.w); }

__device__ __forceinline__ void sconv_pass(const Args& a, int e, int nrows, int gt, int NT) {
    const bf16_t* U = (const bf16_t*)(a.ws + WS_BIG); bf16_t* MIXo = (bf16_t*)(a.ws + WS_MIX); const float* cw = a.in[9] + (size_t)e * 3 * 512;
    for (int idx = gt; idx < nrows * 64; idx += NT) {
        const int row = idx >> 6, ch = idx & 63;
        const int t = row < MX ? (row & (SEQ - 1)) : ((row - MX) & (CTXL - 1)), T = row < MX ? SEQ : CTXL;
        const bf16_t* up = U + (size_t)row * ATT_IN + 8 * ch;
        float bv[8], acc[8];
        unpack8(ld16(up + 768), bv);
#pragma unroll
        for (int q = 0; q < 8; ++q) acc[q] = 0.f;
#pragma unroll
        for (int j = 0; j < 3; ++j) {
            const int tt = t + j - 1;
            if (tt >= 0 && tt < T) {
                float cvv[8], zv[8];
                unpack8(ld16(up + (ptrdiff_t)(j - 1) * ATT_IN + 1280), cvv); unpack8(ld16(up + (ptrdiff_t)(j - 1) * ATT_IN + 1792), zv);
                const f32x4 w0 = *(const f32x4*)(cw + j * 512 + 8 * ch), w1 = *(const f32x4*)(cw + j * 512 + 8 * ch + 4);
#pragma unroll
                for (int q = 0; q < 4; ++q) { acc[q] += w0[q] * (cvv[q] * zv[q]); acc[4 + q] += w1[q] * (cvv[4 + q] * zv[4 + q]); }
            }
        }
        u32x4 w; w.x = cvt_pk_bf16(bv[0] * acc[0], bv[1] * acc[1]); w.y = cvt_pk_bf16(bv[2] * acc[2], bv[3] * acc[3]); w.z = cvt_pk_bf16(bv[4] * acc[4], bv[5] * acc[5]); w.w = cvt_pk_bf16(bv[6] * acc[6], bv[7] * acc[7]);
        *(u32x4*)(MIXo + (size_t)row * KMO + 512 + 8 * ch) = w;
    }
}
template <int HW> __device__ __forceinline__ void pool_item(const bf16_t* UP, bf16_t* MIXo, int row, int c8, int g) {
    const int t = row < MX ? (row & (SEQ - 1)) : ((row - MX) & (CTXL - 1)), T = row < MX ? SEQ : CTXL;
    const bf16_t* up = UP + (size_t)row * 512 + 128 * g + c8;
    u32x4 w[2 * HW];
#pragma unroll
    for (int j = 0; j < 2 * HW; ++j) { const int s = t - HW + j; const int sc = s < 0 ? 0 : (s >= T ? T - 1 : s); w[j] = ld16(up + (ptrdiff_t)(sc - t) * 512); }
    float acc[8], f[8];
#pragma unroll
    for (int q = 0; q < 8; ++q) acc[q] = 0.f;
    int cnt = 0;
#pragma unroll
    for (int j = 0; j < 2 * HW; ++j) { const int s = t - HW + j; const bool ok = s >= 0 && s < T; cnt += ok ? 1 : 0; unpack8(w[j], f);
#pragma unroll
        for (int q = 0; q < 8; ++q) acc[q] += ok ? f[q] : 0.f; }
    unpack8(w[HW], f);
    const float inv = 1.0f / (float)cnt;
#pragma unroll
    for (int q = 0; q < 8; ++q) acc[q] = acc[q] * inv - f[q];
    u32x4 o; o.x = cvt_pk_bf16(acc[0], acc[1]); o.y = cvt_pk_bf16(acc[2], acc[3]); o.z = cvt_pk_bf16(acc[4], acc[5]); o.w = cvt_pk_bf16(acc[6], acc[7]);
    *(u32x4*)(MIXo + (size_t)row * KMO + 128 * g + c8) = o;
}
__device__ __forceinline__ void pool_pass(const Args& a, int nrows, int lane, int gw, int NGW) {
    const bf16_t* UP = (const bf16_t*)(a.ws + WS_UPOOL); bf16_t* MIXo = (bf16_t*)(a.ws + WS_MIX);
    for (int wi = gw; wi < nrows; wi += NGW) {
        const int g = wi & 3, row = 4 * (wi >> 2) + (lane >> 4), c8 = 8 * (lane & 15);
        if (g == 0) pool_item<1>(UP, MIXo, row, c8, 0); else if (g == 1) pool_item<2>(UP, MIXo, row, c8, 1); else if (g == 2) pool_item<4>(UP, MIXo, row, c8, 2); else pool_item<8>(UP, MIXo, row, c8, 3);
    }
}
__device__ __forceinline__ void dft_combine(const Args& a, int gt, int NT, int lane, int gw, int NGW) {
    const float* SL = (const float*)(a.ws + WS_DSLAB); bf16_t* MIXo = (bf16_t*)(a.ws + WS_MIX); const size_t SS = (size_t)1024 * 4096;
    for (int idx0 = gt; idx0 < 1024 * 512; idx0 += 2 * NT) {
        f32x4 v[2][8]; int kk[2], bb[2], cc8[2]; bool okk[2];
#pragma unroll
        for (int u = 0; u < 2; ++u) {
            const int idx = idx0 + u * NT; okk[u] = idx < 1024 * 512; const int id = okk[u] ? idx : idx0;
            kk[u] = id >> 9; const int cc = id & 511; bb[u] = cc >> 6; cc8[u] = (cc & 63) * 8;
            const float* p = SL + (size_t)kk[u] * 4096 + bb[u] * 512 + cc8[u];
#pragma unroll
            for (int q = 0; q < 4; ++q) { v[u][2 * q] = *(const f32x4*)(p + q * SS); v[u][2 * q + 1] = *(const f32x4*)(p + q * SS + 4); }
        }
#pragma unroll
        for (int u = 0; u < 2; ++u) {
            if (!okk[u]) continue;
            const f32x4 P0 = v[u][0] + v[u][2], P1 = v[u][1] + v[u][3], Q0 = v[u][4] + v[u][6], Q1 = v[u][5] + v[u][7];
            *(u32x4*)(MIXo + (size_t)(bb[u] * SEQ + kk[u]) * KMO + 512 + cc8[u]) = gm::pack8(P0 + Q0, P1 + Q1);
            if (kk[u] > 0) *(u32x4*)(MIXo + (size_t)(bb[u] * SEQ + SEQ - kk[u]) * KMO + 512 + cc8[u]) = gm::pack8(P0 - Q0, P1 - Q1);
        }
    }
    const bf16_t* VT = (const bf16_t*)(a.ws + WS_VT);
    for (int r = gw; r < NBATCH * 512; r += NGW) {
        const bf16_t* v = VT + (size_t)r * 2 * SEQ + 8 * lane; float s = 0.f;
#pragma unroll
        for (int j = 0; j < 4; ++j) { float f[8]; unpack8(ld16(v + 512 * j), f); s += (f[0] - f[1]) + (f[2] - f[3]) + (f[4] - f[5]) + (f[6] - f[7]); }
        s = wave_sum(s) * (1.0f / 512.0f);
        if (lane == 0) MIXo[(size_t)((r >> 9) * SEQ + 1024) * KMO + 512 + (r & 511)] = (bf16_t)(cvt_pk_bf16(s, 0.f) & 0xffffu);
    }
}
__device__ __forceinline__ void ffn_fixup(const Args& a, int layer, int nrows, int gt, int NT) {
    const float* SIDE = (const float*)(a.ws + WS_SIDE); bf16_t* ACT = (bf16_t*)(a.ws + WS_BIG); const float* cw = a.in[16] + (size_t)layer * 3 * DFF;
    const int nblk = nrows >> 6;
    for (int idx = gt; idx < nblk * 2 * (DFF / 4); idx += NT) {
        const int c4 = idx % (DFF / 4), bw = idx / (DFF / 4), blk = bw >> 1, which = bw & 1, col = 4 * c4;
        const int row = blk * 64 + (which ? 63 : 0);
        const int sb = row < MX ? (blk & 31) : ((blk - MX / 64) & 3), nsb = row < MX ? 32 : 4;
        const float* sp = SIDE + ((size_t)(blk * 2 + which) * 3) * DFF + col;
        f32x4 cv = *(const f32x4*)sp; const f32x4 vv = *(const f32x4*)(sp + 2 * DFF);
        if (which == 0 && sb > 0) { const f32x4 gl = *(const f32x4*)(SIDE + ((size_t)((blk - 1) * 2 + 1) * 3 + 1) * DFF + col); cv += *(const f32x4*)(cw + col) * gl; }
        if (which == 1 && sb < nsb - 1) { const f32x4 gf = *(const f32x4*)(SIDE + ((size_t)((blk + 1) * 2 + 0) * 3 + 1) * DFF + col); cv += *(const f32x4*)(cw + 2 * DFF + col) * gf; }
        u32x2 w; w.x = cvt_pk_bf16(silu_f(cv[0]) * vv[0], silu_f(cv[1]) * vv[1]); w.y = cvt_pk_bf16(silu_f(cv[2]) * vv[2], silu_f(cv[3]) * vv[3]);
        *(u32x2*)(ACT + (size_t)row * DFF + col) = w;
    }
}

constexpr int STEPS_PER_LAYER = 13, N_STEPS = 2 + STEPS_PER_LAYER * DEPTH;
enum { ST_NOP = 0, ST_PRO, ST_ROW, ST_GEMM, ST_ATT, ST_POOL, ST_FIX };

__global__ void __launch_bounds__(NTHR, 2) dit_fwd(Args args) {
    extern __shared__ __attribute__((aligned(16))) unsigned char lds_raw[];
    LAS unsigned char* lds = (LAS unsigned char*)lds_raw;
    for (int u = threadIdx.x; u < (LDS_BYTES - LDSCTL_OFF) / 4; u += NTHR) ((LAS unsigned*)(lds + LDSCTL_OFF))[u] = 0u;
    __syncthreads();
    XcdBarrier bar; bar.bar = (unsigned*)(args.ws + WS_CTL) + CW_BAR; bar.x = 0; bar.st = nullptr;
    if (!MK_PER_PHASE) bar = xcd_barrier_post((unsigned*)(args.ws + WS_CTL) + CW_BAR, (volatile LAS unsigned*)(lds + MISC_OFF) + 8);

    for (int st = args.ph_lo; st < args.ph_hi; ++st) {
        int tid = threadIdx.x; asm volatile("" : "+v"(tid));
        int G = gridDim.x, bx = blockIdx.x; asm volatile("" : "+s"(G), "+s"(bx));
        size_t wso = 0; asm volatile("" : "+s"(wso));
        unsigned char* ws = args.ws + wso;
        const int lane = tid & 63, wave = __builtin_amdgcn_readfirstlane(tid >> 6);
        bf16_t* HX = (bf16_t*)(ws + WS_HX); bf16_t* Yb = (bf16_t*)(ws + WS_Y); bf16_t* MIXb = (bf16_t*)(ws + WS_MIX); bf16_t* BIG = (bf16_t*)(ws + WS_BIG);
        int kind = ST_NOP, l = 0, sub = -1, rw = 0, coff = 0; bool seam = false;
        if (st == 0) { kind = ST_PRO; seam = true; }
        else if (st == 1) { kind = ST_ROW; rw = 0; seam = true; }
        else if (st >= N_STEPS) { seam = true; }
        else { l = (st - 2) / STEPS_PER_LAYER; sub = (st - 2) % STEPS_PER_LAYER; }
        const bool even = (l & 1) == 0; const int eo = l >> 1;
        const bool ctx_live = l < 2;
        const int nrows = ctx_live ? MT : MX, nMt = nrows / 256;
        gm::Call C{}; C.G = G;
        if (sub == 0) {
            kind = ST_GEMM; C.K = DM; C.lda = DM; C.ldb = DM;
            if (even) C.j0 = gm::Job{HX, (const bf16_t*)(ws + WS_WIN + eo * SZ_WIN), BIG, (const float*)(ws + WS_TAB), nullptr, nMt, ATT_IN / 256, gm::K_ROPE, ATT_IN, 0, 0, 0, 0, 1, nullptr};
            else C.j0 = gm::Job{(const bf16_t*)(ws + WS_WMI + eo * SZ_WMI) + (size_t)512 * DM, HX, ws + WS_VT, nullptr, ws + WS_VTC, 4, nMt, gm::K_VT, 0, 0, 0, 0, 0, 1, nullptr};
        } else if (sub == 1) {
            seam = true; C.K = DM; C.lda = DM; C.ldb = DM;
            if (!even) { kind = ST_GEMM; coff = (4 * nMt) % G; C.j0 = gm::Job{HX, (const bf16_t*)(ws + WS_WMI + eo * SZ_WMI), ws + WS_UPOOL, nullptr, nullptr, nMt, 2, gm::K_PLAIN, 512, 0, 0, 0, 0, 1, nullptr}; }
            else if (l == 2) { kind = ST_GEMM; coff = (64 * 9) % G;
                C.j0 = gm::Job{HX + (size_t)MX * DM, (const bf16_t*)(ws + WS_WIN + eo * SZ_WIN) + (size_t)512 * DM, BIG, (const float*)(ws + WS_TAB), nullptr, MC / 256, 1, gm::K_ROPE, ATT_IN, MX, 512, 0, 0, 1, nullptr}; }
        } else if (sub == 2) {
            if (even) { kind = ST_ATT; seam = true; }
            else { kind = ST_GEMM; C.K = SEQ; C.lda = 2 * SEQ; C.ldb = 2 * SEQ;
                C.j0 = gm::Job{(const bf16_t*)(ws + WS_FMAT), (const bf16_t*)(ws + WS_VT), nullptr, nullptr, nullptr, 0, 16, gm::K_PLAIN, 0, 0, 0, 0, 4, 2, (float*)(ws + WS_DSLAB)}; }
        } else if (sub == 3) {
            if (!even) { kind = ST_GEMM; coff = 128 % G; C.K = SEQ; C.lda = 2 * SEQ; C.ldb = 2 * SEQ;
                C.j0 = gm::Job{(const bf16_t*)(ws + WS_FMAT) + SEQ, (const bf16_t*)(ws + WS_VT) + SEQ, nullptr, nullptr, nullptr, 0, 16, gm::K_PLAIN, 0, 0, 0, 0, 4, 2, (float*)(ws + WS_DSLAB) + (size_t)2 * 1024 * 4096}; }
        } else if (sub == 4) {
            if (!even && ctx_live) { kind = ST_GEMM; C.K = 2 * CTXL; C.lda = 2 * CTXL; C.ldb = 2 * CTXL;
                C.j0 = gm::Job{(const bf16_t*)(ws + WS_FC), (const bf16_t*)(ws + WS_VTC), MIXb, nullptr, nullptr, 1, 16, gm::K_DFT, KMO, MX, 512, 1, 0, 1, nullptr}; }
        } else if (sub == 5) {
            if (!even) seam = true;
        } else if (sub == 6) {
            if (!even) { kind = ST_POOL; seam = true; }
        } else if (sub == 7) {
            kind = ST_GEMM; seam = true; C.lda = KMO;
            if (even) { C.K = DM; C.ldb = DM; C.j0 = gm::Job{MIXb, (const bf16_t*)(ws + WS_WOUT + eo * SZ_WOUT), Yb, nullptr, nullptr, MX / 256, 4, gm::K_PLAIN, DM, 0, 0, 0, nMt - MX / 256, SL_OUT, (float*)(ws + WS_BIG)}; }
            else { C.K = WMOLD; C.ldb = WMOLD; C.j0 = gm::Job{MIXb, (const bf16_t*)(ws + WS_WMO + eo * SZ_WMO), Yb, nullptr, nullptr, MX / 256, 4, gm::K_PLAIN, DM, 0, 0, 0, nMt - MX / 256, SL_OUT, (float*)(ws + WS_BIG)}; }
        } else if (sub == 8) { kind = ST_ROW; rw = 1; seam = true; }
        else if (sub == 9) {
            kind = ST_GEMM; seam = true; C.K = DM; C.lda = DM; C.ldb = DM;
            C.j0 = gm::Job{HX, (const bf16_t*)(ws + WS_WUP + l * SZ_WUP), BIG, args.in[16] + (size_t)l * 3 * DFF, ws + WS_SIDE, nMt, NUP / 256, gm::K_FFN, DFF, 0, 0, 0, 0, 1, nullptr};
        } else if (sub == 10) { kind = ST_FIX; seam = true; }
        else if (sub == 11) {
            kind = ST_GEMM; seam = true; C.K = DFF; C.lda = DFF; C.ldb = DFF;
            C.j0 = gm::Job{BIG, (const bf16_t*)(ws + WS_WDN + l * SZ_WDN), Yb, nullptr, nullptr, MX / 256, 4, gm::K_PLAIN, DM, 0, 0, 0, nMt - MX / 256, SL_DN, (float*)(ws + WS_MIX)};
        } else if (sub == 12) { kind = ST_ROW; rw = 2; seam = true; }
        C.c = bx >= coff ? bx - coff : bx - coff + G;

        if (kind == ST_GEMM) {
            gm::gemm_phase(lds, C, tid);
            const bool hostA = (sub == 0 && even && l + 1 < DEPTH), hostB = (sub == 9 && l + 1 < DEPTH);
            if (hostA || hostB) {
                const int total = C.j0.nM * C.j0.nN, rem = total % G;
                const int rk = rem ? C.c - rem : C.c, n = rem ? G - rem : G;
                if (rk >= 0) { if (hostA) fold_layer(lds, args, l >> 1, rk, n, tid); else tr_layer(lds, args, l + 1, rk * NWAVES + wave, n * NWAVES, lane, wave); __syncthreads(); }
            }
        }
        else if (kind == ST_PRO) prologue_a(lds, args, tid, lane, wave, G);
        else if (kind == ST_ROW) row_phase(args, l, rw, rw == 0 ? MT : nrows, lane, bx * NWAVES + wave, G * NWAVES);
        else if (kind == ST_ATT) {
            const float* sink = args.in[8] + eo * 8;
            for (int u = bx; u < 512 + (l == 0 ? 64 : 0); u += G) {
                if (u < 512) { const int bh = u >> 5, i = u & 31, b = bh >> 1, hk = bh & 1; attn_unit(lds, BIG, MIXb, sink, b, hk, b * SEQ + 64 * i, 64 * i, true, tid); }
                else { const int v = u - 512, bh = v >> 2, i = v & 3, b = bh >> 1, hk = bh & 1; attn_unit(lds, BIG, MIXb, sink, b, hk, MX + b * CTXL + 64 * i, 0, false, tid); }
            }
            sconv_pass(args, eo, nrows, bx * NTHR + tid, G * NTHR);
        }
        else if (kind == ST_POOL) { pool_pass(args, nrows, lane, bx * NWAVES + wave, G * NWAVES); dft_combine(args, bx * NTHR + tid, G * NTHR, lane, bx * NWAVES + wave, G * NWAVES); }
        else if (kind == ST_FIX) ffn_fixup(args, l, nrows, bx * NTHR + tid, G * NTHR);
        if (!MK_PER_PHASE && seam && st + 1 < args.ph_hi) xcd_barrier(bar);
    }
}

extern "C" void kernel_launch(void* const* d_in, const int* in_sizes, int n_in, void* d_out, int out_size, void* d_ws, size_t ws_size, hipStream_t stream) {
    static int grid = 0;
    if (grid == 0) {
        if (n_in != 18 || out_size != MX * DM || ws_size < WS_END) { fprintf(stderr, "kernel_launch: unexpected shapes (n_in %d, out %d, ws %zu)\n", n_in, out_size, ws_size); grid = -1; return; }
        int dev = 0, cus = 0;
        if (hipGetDevice(&dev) != hipSuccess || hipDeviceGetAttribute(&cus, hipDeviceAttributeMultiprocessorCount, dev) != hipSuccess) { grid = -1; return; }
        if (hipFuncSetAttribute((const void*)dit_fwd, hipFuncAttributeMaxDynamicSharedMemorySize, LDS_BYTES) != hipSuccess) { grid = -1; return; }
        (void)hipGetLastError();
        grid = cus;
    }
    if (grid < 0) return;
    if (hipMemsetAsync((char*)d_ws + WS_CTL, 0, CTL_ZERO_BYTES, stream) != hipSuccess) return;
    Args a{};
    for (int i = 0; i < 18; ++i) a.in[i] = (const float*)d_in[i];
    a.out = (float*)d_out; a.ws = (unsigned char*)d_ws;
#if MK_PER_PHASE
    for (int p = 0; p < N_STEPS; ++p) { a.ph_lo = p; a.ph_hi = p + 1; hipLaunchKernelGGL(dit_fwd, dim3(grid), dim3(NTHR), LDS_BYTES, stream, a); }
#else
    a.ph_lo = 0; a.ph_hi = N_STEPS;
    hipLaunchKernelGGL(dit_fwd, dim3(grid), dim3(NTHR), LDS_BYTES, stream, a);
#if PROBE_CLASS
    for (int r = 0; r < PROBE_REPS; ++r)
        for (int l = 0; l < DEPTH; ++l) {
            const int base = 2 + STEPS_PER_LAYER * l; const bool ev = (l & 1) == 0;
            int lo = -1, hi = -1;
            switch (PROBE_CLASS) {
                case 1: lo = base + 9; hi = lo + 1; break;
                case 2: lo = base + 11; hi = lo + 1; break;
                case 3: lo = base + 0; hi = base + 2; break;
                case 4: lo = base + 7; hi = lo + 1; break;
                case 5: if (ev) { lo = base + 2; hi = lo + 1; } break;
                case 6: if (!ev) { lo = base + 2; hi = base + 5; } break;
                case 14: if (!ev) { lo = base + 6; hi = base + 7; } break;
                case 7: if (l == 0) { lo = 0; hi = 1; } break;
                case 8: lo = 1; hi = 2; break;
                case 9: lo = base + 10; hi = lo + 1; break;
                case 10: lo = 2 + 3; hi = lo + 1; break;
                case 11: lo = base + 8; hi = lo + 1; a.dry = 1; break;
                case 12: lo = base + 12; hi = lo + 1; a.dry = 1; break;
                case 13: lo = N_STEPS; hi = N_STEPS + 9; break;
            }
            if (lo >= 0) { a.ph_lo = lo; a.ph_hi = hi; hipLaunchKernelGGL(dit_fwd, dim3(grid), dim3(NTHR), LDS_BYTES, stream, a); }
        }
#endif
#endif
}
```
